# Optimizing an MI355X kernel written in HIP

```python
import jax, jax.numpy as jnp
from jax import lax
import numpy as np

D_MODEL = 2048
BATCH = 8
SEQ = 2048
DEPTH = 1

MEM_LEN = 256
EPS = 1e-6
GN_EPS = 1e-5
ROPE_THETA = 10000.0
HEAD_DIM = 64
ATT_Q_HEADS = 16
ATT_KV_HEADS = 2
ATT_WIDTH = ATT_Q_HEADS * HEAD_DIM
WINDOW = 128
BLOCK = 128
RET_HEADS = 4
RET_HEAD_DIM = 256
RET_WIDTH = RET_HEADS * RET_HEAD_DIM
RET_CHUNK = 128
MIX_WIDTH = ATT_WIDTH + RET_WIDTH
ATT_KV_WIDTH = ATT_KV_HEADS * HEAD_DIM
IN_COLS = ATT_WIDTH + 2 * ATT_KV_WIDTH + 4 * RET_WIDTH
XATT_HEADS = 4
XATT_HEAD_DIM = 128
XATT_WIDTH = XATT_HEADS * XATT_HEAD_DIM
PEER_HEADS = 8
PEER_N_KEYS = 128
PEER_N_EXPERTS = PEER_N_KEYS * PEER_N_KEYS
PEER_QUERY_DIM = 256
PEER_HALF_DIM = PEER_QUERY_DIM // 2
PEER_TOPK = 16
PEER_TOKEN_BLOCK = 128

kernel_name = "hymba_swa_retnet_peer_hybrid"


def rmsnorm(x, g):
    xf = x.astype(jnp.float32)
    y = xf * lax.rsqrt(jnp.mean(xf * xf, axis=-1, keepdims=True) + EPS)
    return (y * g.astype(jnp.float32)).astype(x.dtype)


def rope(x, positions):
    dh = x.shape[-1]
    inv_freq = ROPE_THETA ** (-jnp.arange(0, dh, 2, dtype=jnp.float32) / dh)
    ang = positions.astype(jnp.float32)[..., None] * inv_freq
    cos = jnp.cos(ang)[:, :, None, :]
    sin = jnp.sin(ang)[:, :, None, :]
    xf = x.astype(jnp.float32)
    x1, x2 = xf[..., : dh // 2], xf[..., dh // 2:]
    out = jnp.concatenate([x1 * cos - x2 * sin, x2 * cos + x1 * sin], axis=-1)
    return out.astype(x.dtype)


def sliding_window_attention(q, k, v, sinks):
    B, S = q.shape[0], q.shape[1]
    nb = S // BLOCK
    G = ATT_Q_HEADS // ATT_KV_HEADS
    qb = q.reshape(B, nb, BLOCK, ATT_KV_HEADS, G, HEAD_DIM)
    kb = k.reshape(B, nb, BLOCK, ATT_KV_HEADS, HEAD_DIM)
    vb = v.reshape(B, nb, BLOCK, ATT_KV_HEADS, HEAD_DIM)
    pad = ((0, 0), (1, 0), (0, 0), (0, 0), (0, 0))
    kk = jnp.concatenate([jnp.pad(kb, pad)[:, :-1], kb], axis=2)
    vv = jnp.concatenate([jnp.pad(vb, pad)[:, :-1], vb], axis=2)
    scores = jnp.einsum('bnqhgd,bnkhd->bnhgqk', qb, kk).astype(jnp.float32) * (HEAD_DIM ** -0.5)
    qi = jnp.arange(BLOCK)[:, None] + BLOCK
    ki = jnp.arange(2 * BLOCK)[None, :]
    band = (qi - ki >= 0) & (qi - ki < WINDOW)
    blk = jnp.arange(nb)[:, None, None]
    valid = band[None] & ((blk > 0) | (ki[None] >= BLOCK))
    scores = jnp.where(valid[None, :, None, None], scores, -jnp.inf)
    sink = sinks.astype(jnp.float32).reshape(ATT_KV_HEADS, G)[None, None, :, :, None, None]
    sink = jnp.broadcast_to(sink, scores.shape[:-1] + (1,))
    probs = jax.nn.softmax(jnp.concatenate([scores, sink], axis=-1), axis=-1)[..., :-1]
    out = jnp.einsum('bnhgqk,bnkhd->bnqhgd', probs.astype(v.dtype), vv)
    return out.reshape(B, S, ATT_Q_HEADS, HEAD_DIM)


def retention(q, k, v):
    B, S = q.shape[0], q.shape[1]
    C = RET_CHUNK
    nc = S // C
    qc = q.astype(jnp.float32).reshape(B, nc, C, RET_HEADS, RET_HEAD_DIM)
    kc = k.astype(jnp.float32).reshape(B, nc, C, RET_HEADS, RET_HEAD_DIM) * (RET_HEAD_DIM ** -0.5)
    vc = v.astype(jnp.float32).reshape(B, nc, C, RET_HEADS, RET_HEAD_DIM)
    log_gamma = jnp.log1p(-jnp.exp2(-5.0 - jnp.arange(RET_HEADS, dtype=jnp.float32)))
    idx = jnp.arange(C, dtype=jnp.float32)
    diff = idx[:, None] - idx[None, :]
    decay = jnp.where(diff[None] >= 0, jnp.exp(jnp.maximum(diff, 0.0)[None] * log_gamma[:, None, None]), 0.0)
    inner = jnp.einsum('bnihd,bnjhd->bnhij', qc, kc) * decay[None, None]
    inner_out = jnp.einsum('bnhij,bnjhe->bnihe', inner, vc)
    zeta = jnp.exp((C - 1 - idx)[None, :] * log_gamma[:, None])
    xi = jnp.exp((idx + 1)[None, :] * log_gamma[:, None])
    kv = jnp.einsum('bnjhd,hj,bnjhe->bnhde', kc, zeta, vc)
    chunk_decay = jnp.exp(C * log_gamma)[None, :, None, None]

    def step(state, kv_n):
        return state * chunk_decay + kv_n, state

    init = jnp.zeros((B, RET_HEADS, RET_HEAD_DIM, RET_HEAD_DIM), jnp.float32)
    _, states = lax.scan(step, init, jnp.moveaxis(kv, 1, 0))
    states = jnp.moveaxis(states, 0, 1)
    cross = jnp.einsum('bnihd,hi,bnhde->bnihe', qc, xi, states)
    return (inner_out + cross).reshape(B, S, RET_HEADS, RET_HEAD_DIM)


def hybrid_mixer(xn, positions, w_in, sinks, att_gain, ret_gain, w_out):
    B, S, _ = xn.shape
    dt = xn.dtype
    h = xn @ w_in
    splits = [ATT_WIDTH, ATT_WIDTH + ATT_KV_WIDTH, ATT_WIDTH + 2 * ATT_KV_WIDTH]
    base = ATT_WIDTH + 2 * ATT_KV_WIDTH
    splits += [base + RET_WIDTH, base + 2 * RET_WIDTH, base + 3 * RET_WIDTH]
    qa, ka, va, qr, kr, vr, gr = jnp.split(h, splits, axis=-1)
    qa = rope(qa.reshape(B, S, ATT_Q_HEADS, HEAD_DIM), positions)
    ka = rope(ka.reshape(B, S, ATT_KV_HEADS, HEAD_DIM), positions)
    va = va.reshape(B, S, ATT_KV_HEADS, HEAD_DIM)
    oa = sliding_window_attention(qa, ka, va, sinks).astype(jnp.float32)
    oa = oa * lax.rsqrt(jnp.mean(oa * oa, axis=-1, keepdims=True) + EPS)
    oa = oa.reshape(B, S, ATT_WIDTH) * att_gain.astype(jnp.float32)
    qr = rope(qr.reshape(B, S, RET_HEADS, RET_HEAD_DIM), positions)
    kr = rope(kr.reshape(B, S, RET_HEADS, RET_HEAD_DIM), positions)
    vr = vr.reshape(B, S, RET_HEADS, RET_HEAD_DIM)
    orr = retention(qr, kr, vr)
    mu = jnp.mean(orr, axis=-1, keepdims=True)
    var = jnp.mean(jnp.square(orr - mu), axis=-1, keepdims=True)
    orr = ((orr - mu) * lax.rsqrt(var + GN_EPS)).reshape(B, S, RET_WIDTH) * ret_gain.astype(jnp.float32)
    orr = orr * jax.nn.silu(gr.astype(jnp.float32))
    y = jnp.concatenate([oa, orr], axis=-1).astype(dt)
    return y @ w_out


def memory_cross_attention(xn, memn, w_xq, w_xk, w_xv, w_xo):
    B, S, _ = xn.shape
    M = memn.shape[1]
    q = (xn @ w_xq).reshape(B, S, XATT_HEADS, XATT_HEAD_DIM)
    k = (memn @ w_xk).reshape(B, M, XATT_HEADS, XATT_HEAD_DIM)
    v = (memn @ w_xv).reshape(B, M, XATT_HEADS, XATT_HEAD_DIM)
    s = jnp.einsum('bshd,bmhd->bhsm', q, k).astype(jnp.float32) * (XATT_HEAD_DIM ** -0.5)
    p = jax.nn.softmax(s, axis=-1).astype(v.dtype)
    o = jnp.einsum('bhsm,bmhd->bshd', p, v).reshape(B, S, XATT_WIDTH)
    return o @ w_xo


def peer_ffn(xn, w_pq, sub_keys, expert_u, expert_v):
    B, S, D = xn.shape
    T = B * S
    xt = xn.reshape(T, D)
    q = (xt @ w_pq).reshape(T, PEER_HEADS, 2, PEER_HALF_DIM)
    s = jnp.einsum('thpd,hpkd->thpk', q, sub_keys).astype(jnp.float32)
    s1, i1 = lax.top_k(s[:, :, 0], PEER_TOPK)
    s2, i2 = lax.top_k(s[:, :, 1], PEER_TOPK)
    cand_s = (s1[..., :, None] + s2[..., None, :]).reshape(T, PEER_HEADS, PEER_TOPK * PEER_TOPK)
    cand_i = (i1[..., :, None] * PEER_N_KEYS + i2[..., None, :]).reshape(T, PEER_HEADS, PEER_TOPK * PEER_TOPK)
    top_s, top_pos = lax.top_k(cand_s, PEER_TOPK)
    experts = jnp.take_along_axis(cand_i, top_pos, axis=-1)
    gates = jax.nn.softmax(top_s, axis=-1).astype(xn.dtype)
    nblk = T // PEER_TOKEN_BLOCK
    hk = PEER_HEADS * PEER_TOPK

    def block(args):
        xb, eb, gb = args
        u = jnp.take(expert_u, eb, axis=0)
        act = jax.nn.gelu(jnp.einsum('tkd,td->tk', u, xb), approximate=False)
        v = jnp.take(expert_v, eb, axis=0)
        return jnp.einsum('tk,tkd->td', gb * act, v)

    y = lax.map(block, (xt.reshape(nblk, PEER_TOKEN_BLOCK, D),
                        experts.reshape(nblk, PEER_TOKEN_BLOCK, hk),
                        gates.reshape(nblk, PEER_TOKEN_BLOCK, hk)))
    return y.reshape(B, S, D)


def setup_inputs(seed: int = 0) -> dict:
    key = jax.random.key(seed)
    ks = jax.random.split(key, 24)
    nrm = jax.random.normal
    f32 = jnp.float32

    def gain(k, n):
        return 1.0 + 0.02 * nrm(k, (DEPTH, n), f32)

    x = nrm(ks[0], (BATCH, SEQ, D_MODEL), f32)
    mem = nrm(ks[1], (BATCH, MEM_LEN, D_MODEL), f32)
    offsets = jax.random.randint(ks[2], (BATCH, 1), 0, 4096, dtype=jnp.int32)
    positions = offsets + jnp.arange(SEQ, dtype=jnp.int32)[None, :]
    return {
        "x": x,
        "mem": mem,
        "positions": positions,
        "mix_norm_gain": gain(ks[3], D_MODEL),
        "w_in": nrm(ks[4], (DEPTH, D_MODEL, IN_COLS), f32) * D_MODEL ** -0.5,
        "att_sinks": nrm(ks[5], (DEPTH, ATT_Q_HEADS), f32),
        "att_out_gain": gain(ks[6], ATT_WIDTH),
        "ret_out_gain": gain(ks[7], RET_WIDTH),
        "w_out": nrm(ks[8], (DEPTH, MIX_WIDTH, D_MODEL), f32) * MIX_WIDTH ** -0.5,
        "cross_norm_gain": gain(ks[9], D_MODEL),
        "mem_norm_gain": gain(ks[10], D_MODEL),
        "w_xq": nrm(ks[11], (DEPTH, D_MODEL, XATT_WIDTH), f32) * D_MODEL ** -0.5,
        "w_xk": nrm(ks[12], (DEPTH, D_MODEL, XATT_WIDTH), f32) * D_MODEL ** -0.5,
        "w_xv": nrm(ks[13], (DEPTH, D_MODEL, XATT_WIDTH), f32) * D_MODEL ** -0.5,
        "w_xo": nrm(ks[14], (DEPTH, XATT_WIDTH, D_MODEL), f32) * XATT_WIDTH ** -0.5,
        "ffn_norm_gain": gain(ks[15], D_MODEL),
        "w_peer_q": nrm(ks[16], (DEPTH, D_MODEL, PEER_HEADS * PEER_QUERY_DIM), f32) * D_MODEL ** -0.5,
        "peer_sub_keys": nrm(ks[17], (DEPTH, PEER_HEADS, 2, PEER_N_KEYS, PEER_HALF_DIM), f32) * PEER_HALF_DIM ** -0.5,
        "peer_u": nrm(ks[18], (DEPTH, PEER_N_EXPERTS, D_MODEL), f32) * D_MODEL ** -0.5,
        "peer_v": nrm(ks[19], (DEPTH, PEER_N_EXPERTS, D_MODEL), f32) * (PEER_HEADS * PEER_TOPK) ** -0.5,
        "final_norm_gain": 1.0 + 0.02 * nrm(ks[20], (D_MODEL,), f32),
    }


def reference(x, mem, positions, mix_norm_gain, w_in, att_sinks, att_out_gain, ret_out_gain, w_out,
              cross_norm_gain, mem_norm_gain, w_xq, w_xk, w_xv, w_xo, ffn_norm_gain,
              w_peer_q, peer_sub_keys, peer_u, peer_v, final_norm_gain):
    for l in range(DEPTH):
        x = x + hybrid_mixer(rmsnorm(x, mix_norm_gain[l]), positions, w_in[l], att_sinks[l],
                             att_out_gain[l], ret_out_gain[l], w_out[l])
        x = x + memory_cross_attention(rmsnorm(x, cross_norm_gain[l]), rmsnorm(mem, mem_norm_gain[l]),
                                       w_xq[l], w_xk[l], w_xv[l], w_xo[l])
        x = x + peer_ffn(rmsnorm(x, ffn_norm_gain[l]), w_peer_q[l], peer_sub_keys[l], peer_u[l], peer_v[l])
    return rmsnorm(x, final_norm_gain)
```

```cpp
#include <hip/hip_runtime.h>
#include <cstdio>
#include <cstdint>
#include <cmath>
#ifndef WGM_P1
#define WGM_P1 4
#endif
#ifndef WGM_P3
#define WGM_P3 4
#endif
#ifndef WGM_P4
#define WGM_P4 4
#endif
#ifndef WGM_P6
#define WGM_P6 4
#endif
#ifndef WGM_P7
#define WGM_P7 4
#endif
namespace pg8 {
#define PG8_LAS __attribute__((address_space(3)))
typedef unsigned short bf16_t;
typedef short bf16x8 __attribute__((ext_vector_type(8)));
typedef float f32x4 __attribute__((ext_vector_type(4)));
typedef unsigned u32x4 __attribute__((ext_vector_type(4)));
typedef unsigned u32x2 __attribute__((ext_vector_type(2)));
constexpr int BM = 256, BK = 64, HALF = 128, HTB = HALF * BK * 2  , STAGE_BYTES = 8 * HTB, NXCD = 8;

__host__ __device__ __forceinline__ int lds_byte(int r, int c) { const int st = (r >> 4) * 2 + (c >> 5), rr = r & 15, cc = c & 31, ob = rr * 64 + cc * 2; return st * 1024 + (ob ^ (((ob >> 9) & 1) << 5)); }
__host__ __device__ __forceinline__ void stage_rc(int b, int& R, int& C) { const int st = b / 1024, sb = b % 1024, swz = sb ^ (((sb >> 9) & 1) << 5); R = (st >> 1) * 16 + swz / 64; C = (st & 1) * 32 + (swz % 64) / 2; }
__host__ __device__ __forceinline__ int perm32(int rho) { const int n = rho >> 4, i = rho & 15; return 8 * (i >> 2) + 4 * n + (i & 3); }

struct Unit { int pm, pn, kind; const char* a; const char* b; };

struct Sched {
    const char *A, *B, *A2, *B2; int nM, nN, nwg, nM2, nwg2, G, c, WGM; size_t tstep;
    __device__ __forceinline__ bool next(int i, Unit& u) const {
        const long L = (long)i * G + c;
        if (L < nwg) {
            int wgid = (int)L; { const int q = nwg / NXCD, r = nwg % NXCD, xcd = wgid % NXCD, off = wgid / NXCD; wgid = (xcd < r ? xcd * (q + 1) : r * (q + 1) + (xcd - r) * q) + off; }
            const int nig = WGM * nN, gid = wgid / nig, fm = gid * WGM, gsz = (nM - fm) < WGM ? (nM - fm) : WGM;
            u.pm = fm + ((wgid % nig) % gsz); u.pn = (wgid % nig) / gsz; u.kind = 0; u.a = A + (size_t)u.pm * tstep; u.b = B + (size_t)u.pn * tstep; return true;
        }
        const long L2 = L - nwg; if (L2 >= nwg2) return false;
        u.pm = (int)(L2 % nM2); u.pn = (int)(L2 / nM2); u.kind = 1; u.a = A2 + (size_t)u.pm * tstep; u.b = B2 + (size_t)u.pn * tstep; return true;
    }
};

__device__ __forceinline__ unsigned cvt_pk_bf16(float lo, float hi) { unsigned r; asm volatile("v_cvt_pk_bf16_f32 %0, %1, %2" : "=v"(r) : "v"(lo), "v"(hi)); return r; }

template <class Epi, bool ALIGN_EPI = true, bool SP2 = true>
__device__ __forceinline__ void gemm_phase(PG8_LAS unsigned char* lds, const int K, const Sched& S, const Epi& E) {
    const int tid = threadIdx.x, wid = __builtin_amdgcn_readfirstlane(tid >> 6), lane = tid & 63, wr = wid >> 2, wc = wid & 3, fr = lane & 15, fq = lane >> 4;
    const int nt = K / BK;
    unsigned voffA[2], voffB[2];
#pragma unroll
    for (int i = 0; i < 2; ++i) { int R, C; stage_rc(tid * 16 + i * 8192, R, C); const int Rb = Epi::PERM ? ((R & ~31) + perm32(R & 31)) : R;
        voffA[i] = (unsigned)(R * K + C) * 2u; voffB[i] = (unsigned)(Rb * K + C) * 2u; }
    const size_t kstep = (size_t)(BK * 2);
    const size_t hstep = (size_t)HALF * K * 2;
    const unsigned ldsw = (unsigned)wid * 1024u;
    const int aoff = lds_byte(wr * 64 + fr, fq * 8), boff = lds_byte(wc * 32 + fr, fq * 8);
#define PG8_SA(b, h) (((b) * 2 + (h)) * HTB)
#define PG8_SB(b, h) ((4 + (b) * 2 + (h)) * HTB)
#define PG8_STAGE(bufoff, gbase, voff) do { _Pragma("unroll") for (int _i = 0; _i < 2; ++_i) \
        __builtin_amdgcn_global_load_lds((const unsigned*)((const char*)(gbase) + (voff)[_i]), (PG8_LAS unsigned*)(lds + (bufoff) + ldsw + _i * 8192), 16, 0, 0); } while (0)
#define PG8_LDA(dst, b, h) do { _Pragma("unroll") for (int m = 0; m < 4; ++m) _Pragma("unroll") for (int k = 0; k < 2; ++k) dst[m][k] = *(const PG8_LAS bf16x8*)(lds + PG8_SA(b, h) + aoff + m * 2048 + k * 1024); } while (0)
#define PG8_LDB(dst, b, h) do { _Pragma("unroll") for (int n = 0; n < 2; ++n) _Pragma("unroll") for (int k = 0; k < 2; ++k) dst[n][k] = *(const PG8_LAS bf16x8*)(lds + PG8_SB(b, h) + boff + n * 2048 + k * 1024); } while (0)
#define PG8_MMA(ai, bj, At, Bt) do { __builtin_amdgcn_s_setprio(1); _Pragma("unroll") for (int m = 0; m < 4; ++m) _Pragma("unroll") for (int n = 0; n < 2; ++n) _Pragma("unroll") for (int k = 0; k < 2; ++k) \
        acc[ai][bj][m][n] = __builtin_amdgcn_mfma_f32_16x16x32_bf16(Bt[n][k], At[m][k], acc[ai][bj][m][n], 0, 0, 0); __builtin_amdgcn_s_setprio(0); } while (0)
#define PG8_WAIT_V(n) asm volatile("s_waitcnt vmcnt(" #n ")" ::: "memory")
#define PG8_WAIT_L(n) asm volatile("s_waitcnt lgkmcnt(" #n ")" ::: "memory")
#define PG8_BAR __builtin_amdgcn_s_barrier()
#define PG8_SCHED __builtin_amdgcn_sched_barrier(0)
    Unit cur, nxt; int ui = 0;
    if (!S.next(0, cur)) return;
    f32x4 acc[2][2][4][2];
#pragma unroll
    for (int a = 0; a < 2; ++a)
#pragma unroll
        for (int b = 0; b < 2; ++b)
#pragma unroll
            for (int m = 0; m < 4; ++m)
#pragma unroll
                for (int n = 0; n < 2; ++n) acc[a][b][m][n] = (f32x4){0.f, 0.f, 0.f, 0.f};
    bf16x8 At[4][2], B0[2][2], B1[2][2];
    const char* cA = cur.a; const char* cB = cur.b;
    if constexpr (SP2) {
        PG8_STAGE(PG8_SB(0, 0), cB, voffB); PG8_STAGE(PG8_SB(0, 1), cB + hstep, voffB); PG8_STAGE(PG8_SA(0, 0), cA, voffA); PG8_STAGE(PG8_SA(0, 1), cA + hstep, voffA);
        if (wr == 1) PG8_BAR;
        PG8_WAIT_V(2); PG8_BAR;
        PG8_STAGE(PG8_SB(1, 0), cB + kstep, voffB); PG8_STAGE(PG8_SA(1, 0), cA + kstep, voffA); PG8_STAGE(PG8_SB(1, 1), cB + hstep + kstep, voffB);
        PG8_WAIT_V(6); PG8_BAR;
    } else {
        PG8_STAGE(PG8_SB(0, 0), cB, voffB); PG8_STAGE(PG8_SA(0, 0), cA, voffA); PG8_STAGE(PG8_SB(0, 1), cB + hstep, voffB); PG8_STAGE(PG8_SA(0, 1), cA + hstep, voffA);
        if (wr == 1) PG8_BAR;
        PG8_WAIT_V(4); PG8_BAR;
        PG8_STAGE(PG8_SB(1, 0), cB + kstep, voffB); PG8_STAGE(PG8_SA(1, 0), cA + kstep, voffA); PG8_STAGE(PG8_SB(1, 1), cB + hstep + kstep, voffB);
        PG8_WAIT_V(6); PG8_BAR;
    }
    for (;;) {
        const bool has_next = S.next(ui + 1, nxt);
        const char* nA = has_next ? nxt.a : cA; const char* nB = has_next ? nxt.b : cB;
        for (int t = 0; t < nt; t += 2) {
            const bool last = (t == nt - 2);
            const char* a1 = cA + (size_t)(t + 1) * kstep;
            const char* a2 = last ? nA : cA + (size_t)(t + 2) * kstep; const char* b2 = last ? nB : cB + (size_t)(t + 2) * kstep;
            const char* a3 = a2 + kstep; const char* b3 = b2 + kstep;
            if constexpr (SP2) {
            PG8_LDB(B0, 0, 0); PG8_LDB(B1, 0, 1); PG8_SCHED; PG8_LDA(At, 0, 0); PG8_STAGE(PG8_SA(1, 1), a1 + hstep, voffA);
            PG8_WAIT_V(8); PG8_WAIT_L(0); PG8_BAR; PG8_MMA(0, 0, At, B0); PG8_MMA(0, 1, At, B1); PG8_BAR; PG8_SCHED;
            PG8_LDA(At, 0, 1); PG8_STAGE(PG8_SB(0, 0), b2, voffB); PG8_STAGE(PG8_SB(0, 1), b2 + hstep, voffB); PG8_STAGE(PG8_SA(0, 0), a2, voffA);
            PG8_WAIT_V(8); PG8_WAIT_L(0); PG8_BAR; PG8_MMA(1, 0, At, B0); PG8_MMA(1, 1, At, B1); PG8_BAR; PG8_SCHED;
            PG8_LDB(B0, 1, 0); PG8_LDB(B1, 1, 1); PG8_SCHED; PG8_LDA(At, 1, 0); PG8_STAGE(PG8_SA(0, 1), a2 + hstep, voffA);
            PG8_WAIT_V(8); PG8_WAIT_L(0); PG8_BAR; PG8_MMA(0, 0, At, B0); PG8_MMA(0, 1, At, B1); PG8_BAR; PG8_SCHED;
            PG8_LDA(At, 1, 1); PG8_STAGE(PG8_SB(1, 0), b3, voffB); PG8_STAGE(PG8_SB(1, 1), b3 + hstep, voffB); PG8_STAGE(PG8_SA(1, 0), a3, voffA);
            PG8_WAIT_V(8); PG8_WAIT_L(0); PG8_BAR; PG8_MMA(1, 0, At, B0); PG8_MMA(1, 1, At, B1); PG8_BAR; PG8_SCHED;
            } else {
            PG8_LDB(B0, 0, 0); PG8_SCHED; PG8_LDA(At, 0, 0); PG8_STAGE(PG8_SA(1, 1), a1 + hstep, voffA);
            PG8_WAIT_L(8); PG8_BAR; PG8_WAIT_L(0); PG8_MMA(0, 0, At, B0); PG8_BAR; PG8_SCHED;
            PG8_LDB(B1, 0, 1); PG8_STAGE(PG8_SB(0, 0), b2, voffB);
            PG8_BAR; PG8_WAIT_L(0); PG8_MMA(0, 1, At, B1); PG8_BAR;
            PG8_LDA(At, 0, 1); PG8_STAGE(PG8_SA(0, 0), a2, voffA);
            PG8_BAR; PG8_WAIT_L(0); PG8_MMA(1, 0, At, B0); PG8_BAR; PG8_SCHED;
            PG8_STAGE(PG8_SB(0, 1), b2 + hstep, voffB);
            PG8_WAIT_V(6); PG8_BAR; PG8_MMA(1, 1, At, B1); PG8_BAR;
            PG8_LDB(B0, 1, 0); PG8_SCHED; PG8_LDA(At, 1, 0); PG8_STAGE(PG8_SA(0, 1), a2 + hstep, voffA);
            PG8_WAIT_L(8); PG8_BAR; PG8_WAIT_L(0); PG8_MMA(0, 0, At, B0); PG8_BAR; PG8_SCHED;
            PG8_LDB(B1, 1, 1); PG8_STAGE(PG8_SB(1, 0), b3, voffB);
            PG8_BAR; PG8_WAIT_L(0); PG8_MMA(0, 1, At, B1); PG8_BAR;
            PG8_LDA(At, 1, 1); PG8_STAGE(PG8_SA(1, 0), a3, voffA);
            PG8_BAR; PG8_WAIT_L(0); PG8_MMA(1, 0, At, B0); PG8_BAR; PG8_SCHED;
            PG8_STAGE(PG8_SB(1, 1), b3 + hstep, voffB);
            PG8_WAIT_V(6); PG8_BAR; PG8_MMA(1, 1, At, B1); PG8_BAR;
            }
        }
        if constexpr (ALIGN_EPI) { if (wr == 0) PG8_BAR; }
        E(acc, cur, wr, wc, fr, fq);
        if (!has_next) break;
#pragma unroll
        for (int a = 0; a < 2; ++a)
#pragma unroll
            for (int b = 0; b < 2; ++b)
#pragma unroll
                for (int m = 0; m < 4; ++m)
#pragma unroll
                    for (int n = 0; n < 2; ++n) acc[a][b][m][n] = (f32x4){0.f, 0.f, 0.f, 0.f};
        cur = nxt; cA = nA; cB = nB; ++ui;
        if constexpr (ALIGN_EPI) { if (wr == 1) PG8_BAR; }
    }
    PG8_WAIT_V(0);
    if constexpr (!ALIGN_EPI) { if (wr == 0) PG8_BAR; }
    PG8_BAR;
#undef PG8_SA
#undef PG8_SB
#undef PG8_STAGE
#undef PG8_LDA
#undef PG8_LDB
#undef PG8_MMA
#undef PG8_WAIT_V
#undef PG8_WAIT_L
#undef PG8_BAR
#undef PG8_SCHED
}
}
constexpr int T_TOK = 16384, DM = 2048, SEQ = 2048, NBATCH = 8, MEML = 256, MT = NBATCH * MEML, IN_COLS = 5376;
constexpr float EPS = 1e-6f, GN_EPS = 1e-5f, LOG2E = 1.4426950408889634f;
constexpr float C2Q = 0.125f * LOG2E;
constexpr float C3Q = 0.08838834764831845f * LOG2E;
constexpr size_t MiB = 1u << 20;
constexpr size_t WS_CTL = 0, CTL_ZERO_BYTES = 64 * 1024;
constexpr size_t WS_WIN = 2 * MiB, WS_WOUT = 23 * MiB, WS_WXQ = 31 * MiB, WS_WXKV = 33 * MiB, WS_WXO = 37 * MiB, WS_WPQ = 39 * MiB;
constexpr size_t WS_XB = 48 * MiB, WS_MEMB = 112 * MiB;
constexpr size_t WS_COSA = 120 * MiB, WS_SINA = 122 * MiB, WS_COSR = 124 * MiB, WS_SINR = 132 * MiB;
constexpr size_t WS_SS0 = 140 * MiB, WS_SS1 = WS_SS0 + 65536, WS_SS2 = WS_SS1 + 65536, WS_SSM = WS_SS2 + 65536;
constexpr size_t WS_KX = 141 * MiB, WS_VX = 143 * MiB, WS_QX = 145 * MiB, WS_OX = 161 * MiB, WS_EXP = 177 * MiB, WS_GATE = 185 * MiB;
constexpr size_t WS_Y = 193 * MiB;
constexpr size_t WS_QA = 257 * MiB, WS_KA = 289 * MiB, WS_VA = 293 * MiB, WS_QR = 297 * MiB, WS_KR = 329 * MiB, WS_VR = 361 * MiB, WS_GR = 393 * MiB;
constexpr size_t WS_UB = 425 * MiB, WS_VB = 457 * MiB, WS_SU = 489 * MiB, WS_SV = WS_SU + 65536;
constexpr size_t WS_END = 490 * MiB;

#define GAS __attribute__((address_space(1)))
#define LAS __attribute__((address_space(3)))
typedef unsigned short bf16_t;
typedef short bf16x8 __attribute__((ext_vector_type(8)));
typedef short v4i16 __attribute__((ext_vector_type(4)));
typedef float f32x4 __attribute__((ext_vector_type(4)));
typedef float f32x2 __attribute__((ext_vector_type(2)));
typedef unsigned u32x4 __attribute__((ext_vector_type(4)));
typedef unsigned u32x2 __attribute__((ext_vector_type(2)));
typedef __bf16 bf16x2_t __attribute__((ext_vector_type(2)));

__device__ __forceinline__ unsigned pk2(float lo, float hi) { f32x2 v = {lo, hi}; bf16x2_t b = __builtin_convertvector(v, bf16x2_t); return __builtin_bit_cast(unsigned, b); }
__device__ __forceinline__ float bf_lo(unsigned w) { return __uint_as_float(w << 16); }
__device__ __forceinline__ float bf_hi(unsigned w) { return __uint_as_float(w & 0xffff0000u); }
__device__ __forceinline__ float wave_sum(float v) {
#pragma unroll
    for (int o = 1; o < 64; o <<= 1) v += __shfl_xor(v, o);
    return v;
}

struct EpiP1 {
    static constexpr bool PERM = true;
    unsigned char* ws;
    __device__ __forceinline__ void operator()(const pg8::f32x4 (&acc)[2][2][4][2], const pg8::Unit& u, int wr, int wc, int fr, int fq) const {
        if (u.kind == 1) {
            const float* ssm = (const float*)(ws + WS_SSM);
            bf16_t* O = (bf16_t*)(ws + ((u.pn < 2) ? WS_KX : WS_VX)); const int cb = (u.pn & 1) * 256 + wc * 32 + 8 * fq;
#pragma unroll
            for (int ai = 0; ai < 2; ++ai)
#pragma unroll
                for (int m = 0; m < 4; ++m) { const int row = u.pm * 256 + ai * 128 + wr * 64 + m * 16 + fr; const float rs = rsqrtf(ssm[row] * (1.f / DM) + EPS);
#pragma unroll
                    for (int bj = 0; bj < 2; ++bj) { const f32x4 v0 = acc[ai][bj][m][0] * rs, v1 = acc[ai][bj][m][1] * rs;
                        u32x4 w; w.x = pk2(v0[0], v0[1]); w.y = pk2(v0[2], v0[3]); w.z = pk2(v1[0], v1[1]); w.w = pk2(v1[2], v1[3]);
                        *(u32x4*)(O + (size_t)row * 512 + cb + bj * 128) = w; } }
            return;
        }
        const float* ss0 = (const float*)(ws + WS_SS0);
        const int pn = u.pn;
        size_t ooff, ctoff, stoff; int pitch, colbase, i0, half, tw; float sc; bool rope;
        if (pn < 4)        { ooff = WS_QA; pitch = 1024; colbase = (4 * pn + wc) * 64; i0 = 8 * fq; half = 32; tw = 32; ctoff = WS_COSA; stoff = WS_SINA; sc = C2Q; rope = true; }
        else if (pn == 4)  { if (wc < 2) { ooff = WS_KA; colbase = wc * 64; rope = true; } else { ooff = WS_VA; colbase = (wc - 2) * 64; rope = false; }
                             pitch = 128; i0 = 8 * fq; half = 32; tw = 32; ctoff = WS_COSA; stoff = WS_SINA; sc = 1.f; }
        else { const int q = (pn - 5) >> 2, h = (pn - 5) & 3; ooff = WS_QR + (size_t)q * (32 * MiB); pitch = 1024; colbase = h * 256; i0 = 32 * wc + 8 * fq; half = 128; tw = 128; ctoff = WS_COSR; stoff = WS_SINR;
               sc = (q == 1) ? 0.0625f : 1.f; rope = (q < 2); }
        bf16_t* O = (bf16_t*)(ws + ooff); const float* ct = (const float*)(ws + ctoff); const float* st = (const float*)(ws + stoff);
#pragma unroll
        for (int ai = 0; ai < 2; ++ai)
#pragma unroll
            for (int m = 0; m < 4; ++m) { const int row = u.pm * 256 + ai * 128 + wr * 64 + m * 16 + fr; const float rs = rsqrtf(ss0[row] * (1.f / DM) + EPS) * sc;
                f32x4 a0 = acc[ai][0][m][0] * rs, a1 = acc[ai][0][m][1] * rs, b0 = acc[ai][1][m][0] * rs, b1 = acc[ai][1][m][1] * rs;
                if (rope) { const f32x4 c0 = *(const f32x4*)(ct + (size_t)row * tw + i0), c1 = *(const f32x4*)(ct + (size_t)row * tw + i0 + 4);
                            const f32x4 s0 = *(const f32x4*)(st + (size_t)row * tw + i0), s1 = *(const f32x4*)(st + (size_t)row * tw + i0 + 4);
                            const f32x4 o0 = a0 * c0 - b0 * s0, o1 = a1 * c1 - b1 * s1, p0 = b0 * c0 + a0 * s0, p1 = b1 * c1 + a1 * s1; a0 = o0; a1 = o1; b0 = p0; b1 = p1; }
                bf16_t* rp = O + (size_t)row * pitch + colbase + i0;
                u32x4 w; w.x = pk2(a0[0], a0[1]); w.y = pk2(a0[2], a0[3]); w.z = pk2(a1[0], a1[1]); w.w = pk2(a1[2], a1[3]); *(u32x4*)rp = w;
                w.x = pk2(b0[0], b0[1]); w.y = pk2(b0[2], b0[3]); w.z = pk2(b1[0], b1[1]); w.w = pk2(b1[2], b1[3]); *(u32x4*)(rp + half) = w; }
    }
};
struct EpiRes1 {
    static constexpr bool PERM = true;
    const float* res; bf16_t* XB; float* ss;
    __device__ __forceinline__ void operator()(const pg8::f32x4 (&acc)[2][2][4][2], const pg8::Unit& u, int wr, int wc, int fr, int fq) const {
        const int col0 = u.pn * 256 + wc * 32 + 8 * fq;
#pragma unroll
        for (int ai = 0; ai < 2; ++ai) {
            f32x4 r[4][2][2];
#pragma unroll
            for (int m = 0; m < 4; ++m) { const size_t off = (size_t)(u.pm * 256 + ai * 128 + wr * 64 + m * 16 + fr) * DM + col0;
#pragma unroll
                for (int bj = 0; bj < 2; ++bj) { r[m][bj][0] = *(const f32x4*)(res + off + bj * 128); r[m][bj][1] = *(const f32x4*)(res + off + bj * 128 + 4); } }
#pragma unroll
            for (int m = 0; m < 4; ++m) { const int row = u.pm * 256 + ai * 128 + wr * 64 + m * 16 + fr; const size_t off = (size_t)row * DM + col0; float s = 0.f;
#pragma unroll
                for (int bj = 0; bj < 2; ++bj) { const size_t o = off + bj * 128;
                    const f32x4 v0 = r[m][bj][0] + acc[ai][bj][m][0], v1 = r[m][bj][1] + acc[ai][bj][m][1];
                    u32x4 w; w.x = pk2(v0[0], v0[1]); w.y = pk2(v0[2], v0[3]); w.z = pk2(v1[0], v1[1]); w.w = pk2(v1[2], v1[3]); *(u32x4*)(XB + o) = w;
                    s += ((v0[0] * v0[0] + v0[1] * v0[1]) + (v0[2] * v0[2] + v0[3] * v0[3])) + ((v1[0] * v1[0] + v1[1] * v1[1]) + (v1[2] * v1[2] + v1[3] * v1[3])); }
                s += __shfl_xor(s, 16); s += __shfl_xor(s, 32);
                if (fq == 0) atomicAdd(ss + row, s); }
            asm volatile("" ::: "memory");
        }
    }
};
struct EpiRes2 {
    static constexpr bool PERM = true;
    float* X; bf16_t* XB; float* ss;
    __device__ __forceinline__ void operator()(const pg8::f32x4 (&acc)[2][2][4][2], const pg8::Unit& u, int wr, int wc, int fr, int fq) const {
        const int col0 = u.pn * 256 + wc * 32 + 8 * fq;
        u32x4 r[2][4][2];
#pragma unroll
        for (int ai = 0; ai < 2; ++ai)
#pragma unroll
            for (int m = 0; m < 4; ++m) { const size_t off = (size_t)(u.pm * 256 + ai * 128 + wr * 64 + m * 16 + fr) * DM + col0;
#pragma unroll
                for (int bj = 0; bj < 2; ++bj) r[ai][m][bj] = *(const u32x4*)(XB + off + bj * 128); }
#pragma unroll
        for (int ai = 0; ai < 2; ++ai)
#pragma unroll
            for (int m = 0; m < 4; ++m) { const int row = u.pm * 256 + ai * 128 + wr * 64 + m * 16 + fr; const size_t off = (size_t)row * DM + col0; float s = 0.f;
#pragma unroll
                for (int bj = 0; bj < 2; ++bj) { const size_t o = off + bj * 128; const u32x4 q = r[ai][m][bj];
                    const f32x4 v0 = (f32x4){bf_lo(q.x), bf_hi(q.x), bf_lo(q.y), bf_hi(q.y)} + acc[ai][bj][m][0], v1 = (f32x4){bf_lo(q.z), bf_hi(q.z), bf_lo(q.w), bf_hi(q.w)} + acc[ai][bj][m][1];
                    *(f32x4*)(X + o) = v0; *(f32x4*)(X + o + 4) = v1;
                    u32x4 w; w.x = pk2(v0[0], v0[1]); w.y = pk2(v0[2], v0[3]); w.z = pk2(v1[0], v1[1]); w.w = pk2(v1[2], v1[3]); *(u32x4*)(XB + o) = w;
                    s += ((v0[0] * v0[0] + v0[1] * v0[1]) + (v0[2] * v0[2] + v0[3] * v0[3])) + ((v1[0] * v1[0] + v1[1] * v1[1]) + (v1[2] * v1[2] + v1[3] * v1[3])); }
                s += __shfl_xor(s, 16); s += __shfl_xor(s, 32);
                if (fq == 0) atomicAdd(ss + row, s); }
    }
};
struct EpiScale {
    static constexpr bool PERM = true;
    bf16_t* O; int ldc; const float* ss; float scale;
    __device__ __forceinline__ void operator()(const pg8::f32x4 (&acc)[2][2][4][2], const pg8::Unit& u, int wr, int wc, int fr, int fq) const {
        const int col0 = u.pn * 256 + wc * 32 + 8 * fq;
#pragma unroll
        for (int ai = 0; ai < 2; ++ai)
#pragma unroll
            for (int m = 0; m < 4; ++m) { const int row = u.pm * 256 + ai * 128 + wr * 64 + m * 16 + fr; const float rs = rsqrtf(ss[row] * (1.f / DM) + EPS) * scale;
#pragma unroll
                for (int bj = 0; bj < 2; ++bj) { const f32x4 v0 = acc[ai][bj][m][0] * rs, v1 = acc[ai][bj][m][1] * rs;
                    u32x4 w; w.x = pk2(v0[0], v0[1]); w.y = pk2(v0[2], v0[3]); w.z = pk2(v1[0], v1[1]); w.w = pk2(v1[2], v1[3]);
                    *(u32x4*)(O + (size_t)row * ldc + col0 + bj * 128) = w; } }
    }
};
#define XB_TMO      128
#define XB_XCNT(j)  (256  + 64 * (j))
#define XB_XSUB(j)  (1280 + 64 * (j))
#define XB_XGEN(j)  (2304 + 64 * (j))
#define XB_TOP      3328
#define XB_TOPGEN   3392
#define XCD_BAR_WORDS 3456
#define XB_SPIN_CAP (1u << 18)
__device__ __forceinline__ unsigned xb_ld(unsigned* p)              { return __hip_atomic_load(p, __ATOMIC_RELAXED, __HIP_MEMORY_SCOPE_AGENT); }
__device__ __forceinline__ unsigned xb_add(unsigned* p, unsigned v) { return __hip_atomic_fetch_add(p, v, __ATOMIC_RELAXED, __HIP_MEMORY_SCOPE_AGENT); }
__device__ __forceinline__ unsigned xb_xcc_id() { return (unsigned)__builtin_amdgcn_s_getreg((3 << 11) | 20) & 0xFu; }
#define XB_SPIN(cond, bar) do { unsigned _sp = 0; while (cond) { __builtin_amdgcn_s_sleep(1); \
    if ((++_sp & 255u) == 0u) { if (xb_ld(&(bar)[XB_TMO])) break; if (_sp > XB_SPIN_CAP) { atomicAdd(&(bar)[XB_TMO], 1u); break; } } } } while (0)
struct XcdBarrier { unsigned* bar; unsigned x; volatile LAS unsigned* st; };
__device__ __forceinline__ XcdBarrier xcd_barrier_post(unsigned* bar, volatile LAS unsigned* st) {
    XcdBarrier b; b.bar = bar; b.x = xb_xcc_id(); b.st = st;
    if (threadIdx.x == 0) (void)xb_add(&bar[XB_XCNT(b.x)], 1u);
    return b;
}
__device__ __forceinline__ void xcd_barrier_complete(unsigned* bar, unsigned x, unsigned& nloc, unsigned& nx) {
    const unsigned G = gridDim.x * gridDim.y * gridDim.z;
    unsigned sum, cnt, mine, sp = 0u;
    for (;;) {
        sum = 0u; cnt = 0u; mine = 0u;
#pragma unroll
        for (unsigned j = 0; j < 16; ++j) { const unsigned c = xb_ld(&bar[XB_XCNT(j)]); sum += c; cnt += (c > 0u) ? 1u : 0u; mine = (j == x) ? c : mine; }
        if (sum == G) break;
        __builtin_amdgcn_s_sleep(1);
        if ((++sp & 255u) == 0u) { if (xb_ld(&bar[XB_TMO])) break; if (sp > XB_SPIN_CAP) { atomicAdd(&bar[XB_TMO], 1u); break; } }
    }
    nloc = mine > 0u ? mine : 1u; nx = cnt > 0u ? cnt : 1u;
}
__device__ __forceinline__ void xcd_barrier(const XcdBarrier& b) {
    asm volatile("s_waitcnt vmcnt(0)" ::: "memory");
    __syncthreads();
    if (threadIdx.x == 0) {
        unsigned* bar = b.bar;
        __builtin_amdgcn_s_waitcnt(0);
        unsigned nloc = b.st[0], nx = b.st[1];
        if (nloc == 0u) { xcd_barrier_complete(bar, b.x, nloc, nx); b.st[0] = nloc; b.st[1] = nx; }
        const unsigned old = xb_add(&bar[XB_XSUB(b.x)], 1u);
        const unsigned gen = old / nloc;
        if (old + 1u == (gen + 1u) * nloc) {
            __builtin_amdgcn_fence(__ATOMIC_RELEASE, "agent");
            asm volatile("s_waitcnt vmcnt(0)" ::: "memory");
            const unsigned og = xb_add(&bar[XB_TOP], 1u);
            const unsigned tg = og / nx;
            if (og + 1u == (tg + 1u) * nx) xb_add(&bar[XB_TOPGEN], 1u);
            else XB_SPIN(xb_ld(&bar[XB_TOPGEN]) == tg, bar);
            __builtin_amdgcn_fence(__ATOMIC_ACQUIRE, "agent");
            xb_add(&bar[XB_XGEN(b.x)], 1u);
            asm volatile("s_waitcnt vmcnt(0)" ::: "memory");
        } else {
            XB_SPIN(xb_ld(&bar[XB_XGEN(b.x)]) == gen, bar);
            __builtin_amdgcn_fence(__ATOMIC_ACQUIRE, "agent");
            asm volatile("s_waitcnt vmcnt(0)" ::: "memory");
        }
    }
    __syncthreads();
}

__device__ __forceinline__ int win_phys(int n) {
    if (n < 1024) { const int head = n >> 6, d = n & 63; return (head >> 2) * 256 + (d >> 5) * 128 + (head & 3) * 32 + (d & 31); }
    if (n < 1280) { const int m = n - 1024, kind = m >> 7, hh = (m & 127) >> 6, d = m & 63; return 1024 + (d >> 5) * 128 + (kind * 2 + hh) * 32 + (d & 31); }
    return n;
}
template <bool PERMW>
__device__ __forceinline__ void p0_transpose_item(const float* W, const float* gk, int K, int N, bf16_t* WT, int row_off, LAS float* scr, int item, int lane) {
    const int nblk = N / 32, kb = item / nblk, nb = item % nblk, k0 = 64 * kb, n0 = 32 * nb;
    float wv[32];
#pragma unroll
    for (int i = 0; i < 32; ++i) { const int kk = 2 * i + (lane >> 5); wv[i] = W[(size_t)(k0 + kk) * N + n0 + (lane & 31)]; }
#pragma unroll
    for (int i = 0; i < 32; ++i) { const int kk = 2 * i + (lane >> 5); const float g = gk ? gk[k0 + kk] : 1.f; scr[kk * 33 + (lane & 31)] = wv[i] * g; }
    asm volatile("s_waitcnt lgkmcnt(0)" ::: "memory");
    const int c = lane & 7; const int pr0 = PERMW ? win_phys(n0) : n0;
#pragma unroll
    for (int j = 0; j < 4; ++j) { const int n = (lane >> 3) + 8 * j; const LAS float* s = scr + (8 * c) * 33 + n;
        u32x4 o; o.x = pk2(s[0 * 33], s[1 * 33]); o.y = pk2(s[2 * 33], s[3 * 33]); o.z = pk2(s[4 * 33], s[5 * 33]); o.w = pk2(s[6 * 33], s[7 * 33]);
        *(u32x4*)(WT + (size_t)(row_off + pr0 + n) * K + k0 + 8 * c) = o; }
    asm volatile("s_waitcnt lgkmcnt(0)" ::: "memory");
}
__device__ __forceinline__ void row_to_bf16(const float* xrow, bf16_t* orow, float* ssq, int lane) {
    const f32x4* xr = (const f32x4*)xrow + lane; f32x4 v[8]; float s = 0.f;
#pragma unroll
    for (int j = 0; j < 8; ++j) { v[j] = xr[64 * j]; s += (v[j][0] * v[j][0] + v[j][1] * v[j][1]) + (v[j][2] * v[j][2] + v[j][3] * v[j][3]); }
    s = wave_sum(s);
    u32x2* o8 = (u32x2*)orow + lane;
#pragma unroll
    for (int j = 0; j < 8; ++j) { u32x2 w; w.x = pk2(v[j][0], v[j][1]); w.y = pk2(v[j][2], v[j][3]); o8[64 * j] = w; }
    if (lane == 0) *ssq = s;
}
__device__ __forceinline__ void row2_to_bf16(const float* xrow, bf16_t* orow, float* ssq, size_t rstep, int lane) {
    const f32x4* xr0 = (const f32x4*)xrow + lane; const f32x4* xr1 = (const f32x4*)(xrow + rstep * DM) + lane; f32x4 v[8], q[8]; float s0 = 0.f, s1 = 0.f;
#pragma unroll
    for (int j = 0; j < 8; ++j) { v[j] = xr0[64 * j]; q[j] = xr1[64 * j]; }
#pragma unroll
    for (int j = 0; j < 8; ++j) { s0 += (v[j][0] * v[j][0] + v[j][1] * v[j][1]) + (v[j][2] * v[j][2] + v[j][3] * v[j][3]); s1 += (q[j][0] * q[j][0] + q[j][1] * q[j][1]) + (q[j][2] * q[j][2] + q[j][3] * q[j][3]); }
    s0 = wave_sum(s0); s1 = wave_sum(s1);
    u32x2* o0 = (u32x2*)orow + lane; u32x2* o1 = (u32x2*)(orow + rstep * DM) + lane;
#pragma unroll
    for (int j = 0; j < 8; ++j) { u32x2 w; w.x = pk2(v[j][0], v[j][1]); w.y = pk2(v[j][2], v[j][3]); o0[64 * j] = w; w.x = pk2(q[j][0], q[j][1]); w.y = pk2(q[j][2], q[j][3]); o1[64 * j] = w; }
    if (lane == 0) { ssq[0] = s0; ssq[rstep] = s1; }
}
__device__ __forceinline__ void sincos_red(float ang, float& c, float& s) {
    const float k = rintf(ang * 0.15915494309189535f);
    float r = fmaf(-k, 6.28125f, ang); r = fmaf(-k, 1.9353071795864769e-3f, r);
    const float rev = r * 0.15915494309189535f;
    s = __builtin_amdgcn_sinf(rev); c = __builtin_amdgcn_cosf(rev);
}

#define MFMA16(a, b, c) __builtin_amdgcn_mfma_f32_16x16x32_bf16((a), (b), (c), 0, 0, 0)
__device__ __forceinline__ bf16x8 pack_p(const f32x4& lo, const f32x4& hi) {
    u32x4 w; w.x = pk2(lo[0], lo[1]); w.y = pk2(lo[2], lo[3]); w.z = pk2(hi[0], hi[1]); w.w = pk2(hi[2], hi[3]); return __builtin_bit_cast(bf16x8, w);
}
__device__ __forceinline__ bf16x8 vt_frag(LAS const unsigned char* p, int stride16) {
    const v4i16 lo = __builtin_amdgcn_ds_read_tr16_b64_v4i16((LAS v4i16*)p);
    const v4i16 hi = __builtin_amdgcn_ds_read_tr16_b64_v4i16((LAS v4i16*)(p + stride16));
    return (bf16x8){lo[0], lo[1], lo[2], lo[3], hi[0], hi[1], hi[2], hi[3]};
}

__device__ __forceinline__ void swa_unit(LAS unsigned char* lds, int b, int n, int kvh, const bf16_t* QA, const bf16_t* KA, const bf16_t* VA,
                                         const float* sinks, const float* att_gain, bf16_t* Y) {
    constexpr int KS = 144;
    const int tid = threadIdx.x, lane = tid & 63, c = lane & 15, g = lane >> 4; const int w = __builtin_amdgcn_readfirstlane(tid >> 6);
    LAS unsigned char* Kl = lds; LAS unsigned char* Vl = lds + 256 * KS;
    for (int i = tid; i < 2048; i += 512) { const int key = i >> 3, ch = i & 7, pos = 128 * (n - 1) + key; u32x4 kv = {0u, 0u, 0u, 0u}, vv = {0u, 0u, 0u, 0u};
        if (pos >= 0) { const size_t off = (size_t)(b * SEQ + pos) * 128 + kvh * 64 + ch * 8; kv = *(const u32x4*)(KA + off); vv = *(const u32x4*)(VA + off); }
        *(LAS u32x4*)(Kl + key * KS + ch * 16) = kv; *(LAS u32x4*)(Vl + key * KS + ch * 16) = vv; }
    __syncthreads();
    const int hq = kvh * 8 + w; const float sink = sinks[hq] * LOG2E;
    bf16x8 qn[2];
#pragma unroll
    for (int ks = 0; ks < 2; ++ks) qn[ks] = *(const bf16x8*)(QA + (size_t)(b * SEQ + 128 * n + c) * 1024 + hq * 64 + ks * 32 + 8 * g);
    for (int a = 0; a < 8; ++a) {
        const int t = b * SEQ + 128 * n + 16 * a + c; const int kb0 = (a & ~1) * 16; const int qi = 128 + 16 * a + c;
        bf16x8 qf[2];
#pragma unroll
        for (int ks = 0; ks < 2; ++ks) { qf[ks] = qn[ks]; qn[ks] = *(const bf16x8*)(QA + (size_t)(t + (a < 7 ? 16 : 0)) * 1024 + hq * 64 + ks * 32 + 8 * g); }
        f32x4 s[10]; float m = sink;
#pragma unroll
        for (int blk = 0; blk < 10; ++blk) { const int key0 = kb0 + 16 * blk; f32x4 acc = {0.f, 0.f, 0.f, 0.f};
#pragma unroll
            for (int ks = 0; ks < 2; ++ks) { const bf16x8 kf = *(LAS const bf16x8*)(Kl + (key0 + c) * KS + (ks * 32 + 8 * g) * 2); acc = MFMA16(kf, qf[ks], acc); }
#pragma unroll
            for (int r = 0; r < 4; ++r) { const int j = key0 + 4 * g + r; const bool ok = (j <= qi) && (j > qi - 128) && (n > 0 || j >= 128);
                acc[r] = ok ? acc[r] : -INFINITY; m = fmaxf(m, acc[r]); }
            s[blk] = acc; }
        m = fmaxf(m, __shfl_xor(m, 16)); m = fmaxf(m, __shfl_xor(m, 32));
        float l = 0.f;
#pragma unroll
        for (int blk = 0; blk < 10; ++blk)
#pragma unroll
            for (int r = 0; r < 4; ++r) { const float p = __builtin_amdgcn_exp2f(s[blk][r] - m); s[blk][r] = p; l += p; }
        l += __shfl_xor(l, 16); l += __shfl_xor(l, 32); l += __builtin_amdgcn_exp2f(sink - m);
        f32x4 o[4];
#pragma unroll
        for (int db = 0; db < 4; ++db) o[db] = (f32x4){0.f, 0.f, 0.f, 0.f};
#pragma unroll
        for (int kp = 0; kp < 5; ++kp) { const bf16x8 pf = pack_p(s[2 * kp], s[2 * kp + 1]); const int key0 = kb0 + 32 * kp;
#pragma unroll
            for (int db = 0; db < 4; ++db) { const bf16x8 af = vt_frag(Vl + (key0 + 4 * g + (c >> 2)) * KS + (16 * db + 4 * (c & 3)) * 2, 16 * KS); o[db] = MFMA16(af, pf, o[db]); } }
        const float inv = 1.f / l; float q2 = 0.f;
#pragma unroll
        for (int db = 0; db < 4; ++db) { o[db] = o[db] * inv; q2 += (o[db][0] * o[db][0] + o[db][1] * o[db][1]) + (o[db][2] * o[db][2] + o[db][3] * o[db][3]); }
        q2 += __shfl_xor(q2, 16); q2 += __shfl_xor(q2, 32);
        const float rms = rsqrtf(q2 * (1.f / 64.f) + EPS);
#pragma unroll
        for (int db = 0; db < 4; ++db) { const int col = hq * 64 + 16 * db + 4 * g; const f32x4 gn = *(const f32x4*)(att_gain + col); const f32x4 v = o[db] * rms * gn;
            u32x2 wv; wv.x = pk2(v[0], v[1]); wv.y = pk2(v[2], v[3]); *(u32x2*)(Y + (size_t)t * DM + col) = wv; }
    }
    __syncthreads();
}

__device__ __forceinline__ void ret_unit(LAS unsigned char* lds, int b, int h, int qb, const bf16_t* QR, const bf16_t* KR, const bf16_t* VR, const bf16_t* GR,
                                         const float* ret_gain, bf16_t* Y) {
    constexpr int RS = 544, TB = 64 * RS;
    const int tid = threadIdx.x, lane = tid & 63, c = lane & 15, g = lane >> 4; const int w = __builtin_amdgcn_readfirstlane(tid >> 6);
    const int nt = 2 * qb + 2; const size_t rowb = (size_t)b * SEQ; const int hoff = h * 256;
    const int qpos = 128 * qb + 16 * w + c; const size_t t = rowb + qpos;
    const float lg = log2f(1.f - exp2f(-5.f - (float)h));
    bf16x8 qf[8];
#pragma unroll
    for (int ks = 0; ks < 8; ++ks) qf[ks] = *(const bf16x8*)(QR + t * 1024 + hoff + ks * 32 + 8 * g);
    f32x4 o[16];
#pragma unroll
    for (int db = 0; db < 16; ++db) o[db] = (f32x4){0.f, 0.f, 0.f, 0.f};
    u32x4 pk[4], pv[4];
#define RET_LOAD(kt) do { _Pragma("unroll") for (int i = 0; i < 4; ++i) { const int id = tid + 512 * i, key = id >> 5, ch = id & 31; const size_t off = (rowb + 64 * (kt) + key) * 1024 + hoff + ch * 8; \
        pk[i] = *(const u32x4*)(KR + off); pv[i] = *(const u32x4*)(VR + off); } } while (0)
#define RET_WRITE(buf) do { _Pragma("unroll") for (int i = 0; i < 4; ++i) { const int id = tid + 512 * i, key = id >> 5, ch = id & 31; \
        *(LAS u32x4*)(lds + (buf) * 2 * TB + key * RS + ch * 16) = pk[i]; *(LAS u32x4*)(lds + (buf) * 2 * TB + TB + key * RS + ch * 16) = pv[i]; } } while (0)
    RET_LOAD(0); RET_WRITE(0); __syncthreads();
    for (int kt = 0; kt < nt; ++kt) {
        const int buf = kt & 1;
        if (kt + 1 < nt) RET_LOAD(kt + 1);
        if (64 * kt <= 128 * qb + 16 * w + 15) {
            LAS const unsigned char* Kl = lds + buf * 2 * TB; LAS const unsigned char* Vl = Kl + TB;
            f32x4 s[4];
#pragma unroll
            for (int blk = 0; blk < 4; ++blk) { f32x4 acc = {0.f, 0.f, 0.f, 0.f};
#pragma unroll
                for (int ks = 0; ks < 8; ++ks) { const bf16x8 kf = *(LAS const bf16x8*)(Kl + (16 * blk + c) * RS + (ks * 32 + 8 * g) * 2); acc = MFMA16(kf, qf[ks], acc); }
#pragma unroll
                for (int r = 0; r < 4; ++r) { const int d = qpos - (64 * kt + 16 * blk + 4 * g + r); const float dec = __builtin_amdgcn_exp2f((float)d * lg); acc[r] = (d >= 0) ? acc[r] * dec : 0.f; }
                s[blk] = acc; }
#pragma unroll
            for (int kp = 0; kp < 2; ++kp) { const bf16x8 pf = pack_p(s[2 * kp], s[2 * kp + 1]);
#pragma unroll
                for (int db = 0; db < 16; ++db) { const bf16x8 af = vt_frag(Vl + (32 * kp + 4 * g + (c >> 2)) * RS + (16 * db + 4 * (c & 3)) * 2, 16 * RS); o[db] = MFMA16(af, pf, o[db]); }
                __builtin_amdgcn_sched_barrier(0); }
        }
        if (kt + 1 < nt) RET_WRITE(buf ^ 1);
        __syncthreads();
    }
#undef RET_LOAD
#undef RET_WRITE
    float s1 = 0.f;
#pragma unroll
    for (int db = 0; db < 16; ++db) s1 += (o[db][0] + o[db][1]) + (o[db][2] + o[db][3]);
    s1 += __shfl_xor(s1, 16); s1 += __shfl_xor(s1, 32);
    const float mu = s1 * (1.f / 256.f); float s2 = 0.f;
#pragma unroll
    for (int db = 0; db < 16; ++db) { o[db] = o[db] - mu; s2 += (o[db][0] * o[db][0] + o[db][1] * o[db][1]) + (o[db][2] * o[db][2] + o[db][3] * o[db][3]); }
    s2 += __shfl_xor(s2, 16); s2 += __shfl_xor(s2, 32);
    const float rstd = rsqrtf(s2 * (1.f / 256.f) + GN_EPS);
#pragma unroll
    for (int db = 0; db < 16; ++db) { const int col = hoff + 16 * db + 4 * g; const f32x4 gn = *(const f32x4*)(ret_gain + col); const u32x2 gw = *(const u32x2*)(GR + t * 1024 + col);
        const float z0 = bf_lo(gw.x), z1 = bf_hi(gw.x), z2 = bf_lo(gw.y), z3 = bf_hi(gw.y);
        f32x4 v = o[db] * rstd * gn;
        v[0] *= z0 / (1.f + __expf(-z0)); v[1] *= z1 / (1.f + __expf(-z1)); v[2] *= z2 / (1.f + __expf(-z2)); v[3] *= z3 / (1.f + __expf(-z3));
        u32x2 wv; wv.x = pk2(v[0], v[1]); wv.y = pk2(v[2], v[3]); *(u32x2*)(Y + t * DM + 1024 + col) = wv; }
}

__device__ __forceinline__ void xattn_unit(LAS unsigned char* lds, int b, int hx, int qblk, const bf16_t* QX, const bf16_t* KX, const bf16_t* VX, bf16_t* OX) {
    constexpr int KS = 288;
    const int tid = threadIdx.x, lane = tid & 63, c = lane & 15, g = lane >> 4; const int w = __builtin_amdgcn_readfirstlane(tid >> 6);
    LAS unsigned char* Kl = lds; LAS unsigned char* Vl = lds + 256 * KS;
    for (int i = tid; i < 4096; i += 512) { const int key = i >> 4, ch = i & 15; const size_t off = (size_t)(b * MEML + key) * 512 + hx * 128 + ch * 8;
        *(LAS u32x4*)(Kl + key * KS + ch * 16) = *(const u32x4*)(KX + off); *(LAS u32x4*)(Vl + key * KS + ch * 16) = *(const u32x4*)(VX + off); }
    __syncthreads();
    bf16x8 qn[4];
#pragma unroll
    for (int ks = 0; ks < 4; ++ks) qn[ks] = *(const bf16x8*)(QX + ((size_t)b * SEQ + 256 * qblk + 16 * w + c) * 512 + hx * 128 + ks * 32 + 8 * g);
#pragma unroll 1
    for (int pass = 0; pass < 2; ++pass) {
        const size_t t = (size_t)b * SEQ + 256 * qblk + 128 * pass + 16 * w + c;
        bf16x8 qf[4];
#pragma unroll
        for (int ks = 0; ks < 4; ++ks) { qf[ks] = qn[ks]; qn[ks] = *(const bf16x8*)(QX + (t + (pass == 0 ? 128 : 0)) * 512 + hx * 128 + ks * 32 + 8 * g); }
        f32x4 s[16]; float m = -INFINITY;
#pragma unroll
        for (int blk = 0; blk < 16; ++blk) { f32x4 acc = {0.f, 0.f, 0.f, 0.f};
#pragma unroll
            for (int ks = 0; ks < 4; ++ks) { const bf16x8 kf = *(LAS const bf16x8*)(Kl + (16 * blk + c) * KS + (ks * 32 + 8 * g) * 2); acc = MFMA16(kf, qf[ks], acc); }
            m = fmaxf(fmaxf(fmaxf(acc[0], acc[1]), fmaxf(acc[2], acc[3])), m); s[blk] = acc; __builtin_amdgcn_sched_barrier(0); }
        m = fmaxf(m, __shfl_xor(m, 16)); m = fmaxf(m, __shfl_xor(m, 32));
        float l = 0.f;
#pragma unroll
        for (int blk = 0; blk < 16; ++blk)
#pragma unroll
            for (int r = 0; r < 4; ++r) { const float p = __builtin_amdgcn_exp2f(s[blk][r] - m); s[blk][r] = p; l += p; }
        l += __shfl_xor(l, 16); l += __shfl_xor(l, 32);
        f32x4 o[8];
#pragma unroll
        for (int db = 0; db < 8; ++db) o[db] = (f32x4){0.f, 0.f, 0.f, 0.f};
#pragma unroll
        for (int kp = 0; kp < 8; ++kp) { const bf16x8 pf = pack_p(s[2 * kp], s[2 * kp + 1]);
#pragma unroll
            for (int db = 0; db < 8; ++db) { const bf16x8 af = vt_frag(Vl + (32 * kp + 4 * g + (c >> 2)) * KS + (16 * db + 4 * (c & 3)) * 2, 16 * KS); o[db] = MFMA16(af, pf, o[db]); }
            __builtin_amdgcn_sched_barrier(0); }
        const float inv = 1.f / l;
#pragma unroll
        for (int db = 0; db < 8; ++db) { const f32x4 v = o[db] * inv; u32x2 wv; wv.x = pk2(v[0], v[1]); wv.y = pk2(v[2], v[3]); *(u32x2*)(OX + t * 512 + hx * 128 + 16 * db + 4 * g) = wv; }
    }
    __syncthreads();
}

__device__ __forceinline__ int mono_i(float x) { int i = __float_as_int(x); return i ^ ((i >> 31) & 0x7fffffff); }
__device__ __forceinline__ float mono_f(int i) { return __int_as_float(i ^ ((i >> 31) & 0x7fffffff)); }
#define INS16(L, v) do { int _v = (v); _Pragma("unroll") for (int _k = 0; _k < 16; ++_k) { const int _t = max(L[_k], _v); _v = min(L[_k], _v); L[_k] = _t; } } while (0)
#define CE_DESC(x, y) do { const int _h = max((x), (y)), _l = min((x), (y)); (x) = _h; (y) = _l; } while (0)
#define SORT16_DESC(L) do { \
    CE_DESC(L[0], L[1]); \
    CE_DESC(L[2], L[3]); \
    CE_DESC(L[0], L[2]); \
    CE_DESC(L[1], L[3]); \
    CE_DESC(L[1], L[2]); \
    CE_DESC(L[4], L[5]); \
    CE_DESC(L[6], L[7]); \
    CE_DESC(L[4], L[6]); \
    CE_DESC(L[5], L[7]); \
    CE_DESC(L[5], L[6]); \
    CE_DESC(L[0], L[4]); \
    CE_DESC(L[2], L[6]); \
    CE_DESC(L[2], L[4]); \
    CE_DESC(L[1], L[5]); \
    CE_DESC(L[3], L[7]); \
    CE_DESC(L[3], L[5]); \
    CE_DESC(L[1], L[2]); \
    CE_DESC(L[3], L[4]); \
    CE_DESC(L[5], L[6]); \
    CE_DESC(L[8], L[9]); \
    CE_DESC(L[10], L[11]); \
    CE_DESC(L[8], L[10]); \
    CE_DESC(L[9], L[11]); \
    CE_DESC(L[9], L[10]); \
    CE_DESC(L[12], L[13]); \
    CE_DESC(L[14], L[15]); \
    CE_DESC(L[12], L[14]); \
    CE_DESC(L[13], L[15]); \
    CE_DESC(L[13], L[14]); \
    CE_DESC(L[8], L[12]); \
    CE_DESC(L[10], L[14]); \
    CE_DESC(L[10], L[12]); \
    CE_DESC(L[9], L[13]); \
    CE_DESC(L[11], L[15]); \
    CE_DESC(L[11], L[13]); \
    CE_DESC(L[9], L[10]); \
    CE_DESC(L[11], L[12]); \
    CE_DESC(L[13], L[14]); \
    CE_DESC(L[0], L[8]); \
    CE_DESC(L[4], L[12]); \
    CE_DESC(L[4], L[8]); \
    CE_DESC(L[2], L[10]); \
    CE_DESC(L[6], L[14]); \
    CE_DESC(L[6], L[10]); \
    CE_DESC(L[2], L[4]); \
    CE_DESC(L[6], L[8]); \
    CE_DESC(L[10], L[12]); \
    CE_DESC(L[1], L[9]); \
    CE_DESC(L[5], L[13]); \
    CE_DESC(L[5], L[9]); \
    CE_DESC(L[3], L[11]); \
    CE_DESC(L[7], L[15]); \
    CE_DESC(L[7], L[11]); \
    CE_DESC(L[3], L[5]); \
    CE_DESC(L[7], L[9]); \
    CE_DESC(L[11], L[13]); \
    CE_DESC(L[1], L[2]); \
    CE_DESC(L[3], L[4]); \
    CE_DESC(L[5], L[6]); \
    CE_DESC(L[7], L[8]); \
    CE_DESC(L[9], L[10]); \
    CE_DESC(L[11], L[12]); \
    CE_DESC(L[13], L[14]); \
} while (0)

__device__ __forceinline__ void bitonic_fix16(int (&L)[16]) {
    CE_DESC(L[0], L[8]); CE_DESC(L[1], L[9]); CE_DESC(L[2], L[10]); CE_DESC(L[3], L[11]); CE_DESC(L[4], L[12]); CE_DESC(L[5], L[13]); CE_DESC(L[6], L[14]); CE_DESC(L[7], L[15]);
    CE_DESC(L[0], L[4]); CE_DESC(L[1], L[5]); CE_DESC(L[2], L[6]); CE_DESC(L[3], L[7]); CE_DESC(L[8], L[12]); CE_DESC(L[9], L[13]); CE_DESC(L[10], L[14]); CE_DESC(L[11], L[15]);
    CE_DESC(L[0], L[2]); CE_DESC(L[1], L[3]); CE_DESC(L[4], L[6]); CE_DESC(L[5], L[7]); CE_DESC(L[8], L[10]); CE_DESC(L[9], L[11]); CE_DESC(L[12], L[14]); CE_DESC(L[13], L[15]);
    CE_DESC(L[0], L[1]); CE_DESC(L[2], L[3]); CE_DESC(L[4], L[5]); CE_DESC(L[6], L[7]); CE_DESC(L[8], L[9]); CE_DESC(L[10], L[11]); CE_DESC(L[12], L[13]); CE_DESC(L[14], L[15]);
}
__device__ __forceinline__ void merge16(int (&L)[16], int xm) {
    int P[16];
#pragma unroll
    for (int i = 0; i < 16; ++i) P[i] = __shfl_xor(L[i], xm);
#pragma unroll
    for (int i = 0; i < 16; ++i) L[i] = max(L[i], P[15 - i]);
    bitonic_fix16(L);
}
__device__ __forceinline__ void peer_topk_unit(LAS unsigned char* lds, int pm, int h, const bf16_t* PQ, const float* subk, int* EXP, float* GATE) {
    constexpr int KS = 272;
    const int tid = threadIdx.x, lane = tid & 63, c = lane & 15, g = lane >> 4; const int w = __builtin_amdgcn_readfirstlane(tid >> 6);
    const float* sk = subk + (size_t)h * 2 * 128 * 128;
    for (int i = tid; i < 8192; i += 512) { const int row = i >> 5, ch = i & 31; const f32x4 v = *(const f32x4*)(sk + (size_t)row * 128 + ch * 4);
        u32x2 wv; wv.x = pk2(v[0], v[1]); wv.y = pk2(v[2], v[3]); *(LAS u32x2*)(lds + row * KS + ch * 8) = wv; }
    __syncthreads();
#pragma unroll 1
    for (int grp = 0; grp < 2; ++grp) {
        const size_t t = (size_t)pm * 256 + 32 * w + 16 * grp + c;
        int S1[16], S2[16];
        bf16x8 qall[2][4];
#pragma unroll
        for (int p = 0; p < 2; ++p)
#pragma unroll
            for (int ks = 0; ks < 4; ++ks) qall[p][ks] = *(const bf16x8*)(PQ + t * DM + h * 256 + p * 128 + ks * 32 + 8 * g);
#pragma unroll
        for (int p = 0; p < 2; ++p) {
            bf16x8 qf[4];
#pragma unroll
            for (int ks = 0; ks < 4; ++ks) qf[ks] = qall[p][ks];
            int A[16], B[16];
#pragma unroll
            for (int blk = 0; blk < 8; ++blk) { f32x4 acc = {0.f, 0.f, 0.f, 0.f};
#pragma unroll
                for (int ks = 0; ks < 4; ++ks) { const bf16x8 kf = *(LAS const bf16x8*)(lds + (p * 128 + 16 * blk + c) * KS + (ks * 32 + 8 * g) * 2); acc = MFMA16(kf, qf[ks], acc); }
#pragma unroll
                for (int r = 0; r < 4; ++r) { const int idx = 16 * blk + 4 * g + r; const int key = (mono_i(acc[r]) & ~127) | (127 - idx); if (blk < 4) A[4 * blk + r] = key; else B[4 * (blk - 4) + r] = key; }
                __builtin_amdgcn_sched_barrier(0); }
            SORT16_DESC(A); SORT16_DESC(B);
#pragma unroll
            for (int i = 0; i < 16; ++i) A[i] = max(A[i], B[15 - i]);
            bitonic_fix16(A);
            merge16(A, 16); merge16(A, 32);
#pragma unroll
            for (int k = 0; k < 16; ++k) { if (p == 0) S1[k] = A[k]; else S2[k] = A[k]; }
        }
        float s1v[16], s2v[16];
#pragma unroll
        for (int k = 0; k < 16; ++k) { s1v[k] = mono_f(S1[k] & ~127); s2v[k] = mono_f(S2[k] & ~127); }
        int Mx[16];
#pragma unroll
        for (int k = 0; k < 16; ++k) Mx[k] = (int)0x80000000;
#define STAIR4(a0, b0, a1, b1, a2, b2, a3, b3) do { const float _c0 = s1v[a0] + s2v[b0], _c1 = s1v[a1] + s2v[b1], _c2 = s1v[a2] + s2v[b2], _c3 = s1v[a3] + s2v[b3]; \
        const float _m = (g == 0) ? _c0 : (g == 1) ? _c1 : (g == 2) ? _c2 : _c3; const int _cd = (g == 0) ? (255 - (16 * a0 + b0)) : (g == 1) ? (255 - (16 * a1 + b1)) : (g == 2) ? (255 - (16 * a2 + b2)) : (255 - (16 * a3 + b3)); \
        INS16(Mx, (mono_i(_m) & ~255) | _cd); } while (0)
#define STAIR2(a0, b0, a1, b1) do { const float _c0 = s1v[a0] + s2v[b0], _c1 = s1v[a1] + s2v[b1]; const float _m = (g == 0) ? _c0 : _c1; const int _cd = (g == 0) ? (255 - (16 * a0 + b0)) : (255 - (16 * a1 + b1)); \
        const int _key = (mono_i(_m) & ~255) | _cd; INS16(Mx, (g < 2) ? _key : (int)0x80000000); } while (0)
        STAIR4(0, 0, 0, 1, 0, 2, 0, 3);
        STAIR4(0, 4, 0, 5, 0, 6, 0, 7);
        STAIR4(0, 8, 0, 9, 0, 10, 0, 11);
        STAIR4(0, 12, 0, 13, 0, 14, 0, 15);
        STAIR4(1, 0, 1, 1, 1, 2, 1, 3);
        STAIR4(1, 4, 1, 5, 1, 6, 1, 7);
        STAIR4(2, 0, 2, 1, 2, 2, 2, 3);
        STAIR4(2, 4, 3, 0, 3, 1, 3, 2);
        STAIR4(3, 3, 4, 0, 4, 1, 4, 2);
        STAIR4(5, 0, 5, 1, 6, 0, 6, 1);
        STAIR4(7, 0, 7, 1, 8, 0, 9, 0);
        STAIR4(10, 0, 11, 0, 12, 0, 13, 0);
        STAIR2(14, 0, 15, 0);
#undef STAIR4
#undef STAIR2
        merge16(Mx, 16); merge16(Mx, 32);
        const float top = mono_f(Mx[0] & ~255); float wg[4]; int ex[4]; float wsum = 0.f;
#pragma unroll
        for (int i = 0; i < 4; ++i) { const int key = (g == 0) ? Mx[i] : (g == 1) ? Mx[4 + i] : (g == 2) ? Mx[8 + i] : Mx[12 + i];
            wg[i] = __expf(mono_f(key & ~255) - top); wsum += wg[i];
            const int ab = 255 - (key & 255), a = ab >> 4, bb = ab & 15; int e1 = 0, e2 = 0;
#pragma unroll
            for (int k = 0; k < 16; ++k) { e1 = (a == k) ? (127 - (S1[k] & 127)) : e1; e2 = (bb == k) ? (127 - (S2[k] & 127)) : e2; }
            ex[i] = e1 * 128 + e2; }
        wsum += __shfl_xor(wsum, 16); wsum += __shfl_xor(wsum, 32);
        const float inv = 1.f / wsum;
        *(int4*)(EXP + t * 128 + h * 16 + 4 * g) = make_int4(ex[0], ex[1], ex[2], ex[3]);
        *(f32x4*)(GATE + t * 128 + h * 16 + 4 * g) = (f32x4){wg[0] * inv, wg[1] * inv, wg[2] * inv, wg[3] * inv};
    }
    __syncthreads();
}
typedef __bf16 v32bf16 __attribute__((ext_vector_type(32)));
typedef unsigned v6u32 __attribute__((ext_vector_type(6)));
constexpr int ROWB = 1536;
__device__ __forceinline__ float fdot2bf(bf16x2_t a, bf16x2_t b, float c) { return __builtin_amdgcn_fdot2_f32_bf16(a, b, c, false); }
__device__ __forceinline__ void row_to_fp6(const float* src, const float* colgain, unsigned char* dst, float* inv, int lane) {
    f32x4 v[8]; float am = 0.f;
#pragma unroll
    for (int j = 0; j < 8; ++j) { v[j] = *(const f32x4*)(src + 32 * lane + 4 * j); if (colgain) v[j] = v[j] * *(const f32x4*)(colgain + 32 * lane + 4 * j);
        am = fmaxf(am, fmaxf(fmaxf(fabsf(v[j][0]), fabsf(v[j][1])), fmaxf(fabsf(v[j][2]), fabsf(v[j][3])))); }
#pragma unroll
    for (int o = 1; o < 64; o <<= 1) am = fmaxf(am, __shfl_xor(am, o));
    float S = 1.f;
    if (am > 1e-30f) S = __uint_as_float(__float_as_uint(7.5f / am) & 0x7f800000u);
    unsigned pk[6] = {0u, 0u, 0u, 0u, 0u, 0u};
#pragma unroll
    for (int j = 0; j < 8; ++j)
#pragma unroll
        for (int i = 0; i < 4; ++i) { const float t = v[j][i] * S, a = fabsf(t);
            const float cf = (a < 2.f) ? rintf(a * 8.f) : (a < 4.f) ? 16.f + rintf((a - 2.f) * 4.f) : 24.f + rintf((a - 4.f) * 2.f);
            unsigned cd = (unsigned)fminf(cf, 31.f); if (t < 0.f) cd |= 32u;
            const int e = 4 * j + i, bit = 6 * e, dw = bit >> 5, sh = bit & 31;
            pk[dw] |= cd << sh; if (sh > 26) pk[dw + 1] |= cd >> (32 - sh); }
    *(u32x4*)(dst + 16 * lane) = (u32x4){pk[0], pk[1], pk[2], pk[3]}; *(u32x2*)(dst + 1024 + 8 * lane) = (u32x2){pk[4], pk[5]};
    if (lane == 0) *inv = 1.f / S;
}
__device__ __forceinline__ v32bf16 sw_unpack6(v6u32 s) {
    v32bf16 r;
#pragma unroll
    for (int e = 0; e < 32; ++e) { const int bit = 6 * e, dw = bit >> 5, sh = bit & 31; unsigned cd = s[dw] >> sh; if (sh > 26) cd |= s[dw + 1] << (32 - sh); cd &= 63u;
        const unsigned m = cd & 31u; float a = (m < 16u) ? (float)m * 0.125f : (m < 24u) ? 2.f + (float)(m - 16u) * 0.25f : 4.f + (float)(m - 24u) * 0.5f; if (cd & 32u) a = -a; r[e] = (__bf16)a; }
    return r;
}
constexpr int RING = 8;
typedef unsigned v16u32 __attribute__((ext_vector_type(16)));
__device__ __forceinline__ bf16x2_t as_pair(unsigned w) { return __builtin_bit_cast(bf16x2_t, w); }
#define PAIR(r, p) as_pair((r)[(p)])
__device__ __forceinline__ void peer_gather_token(LAS float* cw, LAS int* ew, size_t t, const float* X, const float* g_ffn, const float* g_fin,
                                                  const unsigned char* UB, const unsigned char* VB, const float* SU, const float* SV, const int* EXP, const float* GATE, float* OUT, int lane, LAS f32x4* xstash) {
    f32x4 xv[8]; float ss = 0.f;
    const float* xr = X + t * DM + 32 * lane;
#pragma unroll
    for (int j = 0; j < 8; ++j) xv[j] = *(const f32x4*)(xr + 4 * j);
#pragma unroll
    for (int j = 0; j < 8; ++j) ss += (xv[j][0] * xv[j][0] + xv[j][1] * xv[j][1]) + (xv[j][2] * xv[j][2] + xv[j][3] * xv[j][3]);
    ss = wave_sum(ss);
    const float rs = rsqrtf(ss * (1.f / DM) + EPS);
    bf16x2_t xb[16];
#pragma unroll
    for (int j = 0; j < 8; ++j) { const f32x4 a = xv[j] * rs * *(const f32x4*)(g_ffn + 32 * lane + 4 * j); xb[2 * j] = __builtin_bit_cast(bf16x2_t, pk2(a[0], a[1])); xb[2 * j + 1] = __builtin_bit_cast(bf16x2_t, pk2(a[2], a[3])); }
    ew[lane] = EXP[t * 128 + lane]; ew[lane + 64] = EXP[t * 128 + 64 + lane];
#pragma unroll
    for (int j = 0; j < 8; ++j) xstash[j * 64 + lane] = xv[j];
    asm volatile("s_waitcnt lgkmcnt(0)" ::: "memory");
    u32x4 ra[RING]; u32x2 rc[RING];
#define ROWLOAD(BASE, slot, k) do { const int _e = __builtin_amdgcn_readfirstlane(ew[(k)]); const unsigned char* _rp = (BASE) + (size_t)_e * ROWB; \
        ra[slot] = *(const u32x4*)(_rp + 16 * lane); rc[slot] = *(const u32x2*)(_rp + 1024 + 8 * lane); } while (0)
#ifdef PROBE_SW_UNPACK
#define ROWCVT(slot) sw_unpack6((v6u32){ra[slot].x, ra[slot].y, ra[slot].z, ra[slot].w, rc[slot].x, rc[slot].y})
#else
#define ROWCVT(slot) __builtin_amdgcn_cvt_scalef32_pk32_bf16_fp6((v6u32){ra[slot].x, ra[slot].y, ra[slot].z, ra[slot].w, rc[slot].x, rc[slot].y}, 1.0f)
#endif
#pragma unroll
    for (int j = 0; j < RING; ++j) ROWLOAD(UB, j, j);
    const int eloc = ((lane >> 5) & 1) * 8 + ((lane >> 4) & 1) * 4 + ((lane >> 3) & 1) * 2 + ((lane >> 2) & 1);
    for (int b = 0; b < 8; ++b) {
        float part[16];
#pragma unroll
        for (int j = 0; j < 16; ++j) { const int slot = j & (RING - 1); const v16u32 r = __builtin_bit_cast(v16u32, ROWCVT(slot)); float a0 = 0.f, a1 = 0.f;
#pragma unroll
            for (int q = 0; q < 8; ++q) { a0 = fdot2bf(PAIR(r, 2 * q), xb[2 * q], a0); a1 = fdot2bf(PAIR(r, 2 * q + 1), xb[2 * q + 1], a1); }
            part[j] = a0 + a1;
            { const int sn = 16 * b + j + RING; const unsigned char* nb = (sn < 128) ? UB : VB; ROWLOAD(nb, slot, sn & 127); } }
        float q8[8], q4[4], q2[2], q1;
#pragma unroll
        for (int i = 0; i < 8; ++i) { const bool up = (lane & 32) != 0; const float snd = up ? part[i] : part[i + 8], kp = up ? part[i + 8] : part[i]; q8[i] = kp + __shfl_xor(snd, 32); }
#pragma unroll
        for (int i = 0; i < 4; ++i) { const bool up = (lane & 16) != 0; const float snd = up ? q8[i] : q8[i + 4], kp = up ? q8[i + 4] : q8[i]; q4[i] = kp + __shfl_xor(snd, 16); }
#pragma unroll
        for (int i = 0; i < 2; ++i) { const bool up = (lane & 8) != 0; const float snd = up ? q4[i] : q4[i + 2], kp = up ? q4[i + 2] : q4[i]; q2[i] = kp + __shfl_xor(snd, 8); }
        { const bool up = (lane & 4) != 0; const float snd = up ? q2[0] : q2[1], kp = up ? q2[1] : q2[0]; q1 = kp + __shfl_xor(snd, 4); }
        q1 += __shfl_xor(q1, 1); q1 += __shfl_xor(q1, 2);
        if ((lane & 3) == 0) { const int k = 16 * b + eloc; const int e = ew[k]; const float av = q1 * SU[e]; const float gl = 0.5f * av * (1.f + erff(av * 0.70710678118654752f)); cw[k] = gl * GATE[t * 128 + k] * SV[e]; }
    }
    asm volatile("s_waitcnt lgkmcnt(0)" ::: "memory");
    float acc[32];
#pragma unroll
    for (int i = 0; i < 32; ++i) acc[i] = 0.f;
    for (int k0 = 0; k0 < 128; k0 += RING) {
#pragma unroll
        for (int j = 0; j < RING; ++j) { const float cv = cw[k0 + j]; const unsigned clo_u = pk2(cv, 0.f); const bf16x2_t clo = __builtin_bit_cast(bf16x2_t, clo_u), chi = __builtin_bit_cast(bf16x2_t, clo_u << 16);
            const v16u32 r = __builtin_bit_cast(v16u32, ROWCVT(j));
#pragma unroll
            for (int q = 0; q < 16; ++q) { acc[2 * q] = fdot2bf(PAIR(r, q), clo, acc[2 * q]); acc[2 * q + 1] = fdot2bf(PAIR(r, q), chi, acc[2 * q + 1]); }
            const int kn = min(k0 + j + RING, 127); ROWLOAD(VB, j, kn); }
    }
#undef ROWLOAD
#undef ROWCVT
#ifdef PROBE_NO_PEER
#pragma unroll
    for (int i = 0; i < 32; ++i) acc[i] = 0.f;
#endif
    float s3 = 0.f;
#pragma unroll
    for (int j = 0; j < 8; ++j) xv[j] = xstash[j * 64 + lane];
#pragma unroll
    for (int j = 0; j < 8; ++j)
#pragma unroll
        for (int i = 0; i < 4; ++i) { xv[j][i] += acc[4 * j + i]; s3 += xv[j][i] * xv[j][i]; }
    s3 = wave_sum(s3);
    const float r3 = rsqrtf(s3 * (1.f / DM) + EPS);
    float* orow = OUT + t * DM + 32 * lane;
#pragma unroll
    for (int j = 0; j < 8; ++j) { const f32x4 g0 = *(const f32x4*)(g_fin + 32 * lane + 4 * j); *(f32x4*)(orow + 4 * j) = xv[j] * r3 * g0; }
}

constexpr unsigned NF1 = 896;
__device__ __forceinline__ void fp8_chunk(int chunk, int wave, int lane, const float* peer_u, const float* peer_v, const float* g_ffn, unsigned char* UB, unsigned char* VB, float* SU, float* SV) {
#pragma unroll 1
    for (int r = 0; r < 2; ++r) { const int row = chunk * 16 + wave * 2 + r;
        if (row < 16384) row_to_fp6(peer_u + (size_t)row * DM, nullptr, UB + (size_t)row * ROWB, SU + row, lane);
        else row_to_fp6(peer_v + (size_t)(row - 16384) * DM, nullptr, VB + (size_t)(row - 16384) * ROWB, SV + (row - 16384), lane); }
}
constexpr int NWAVES = 8, LDS_BYTES = 163840, MISC_OFF = 159744;
constexpr int N_PHASES = 10;
struct Args { const void* in[21]; float* out; unsigned char* ws; int ph_lo, ph_hi; float inv_freq[128]; };

#define IN_x ((const float*)((const float*)args.in[0]))
#define IN_mem ((const float*)((const float*)args.in[1]))
#define IN_positions ((const int*)((const int*)args.in[2]))
#define IN_g_mix ((const float*)((const float*)args.in[3]))
#define IN_w_in ((const float*)((const float*)args.in[4]))
#define IN_sinks ((const float*)((const float*)args.in[5]))
#define IN_att_gain ((const float*)((const float*)args.in[6]))
#define IN_ret_gain ((const float*)((const float*)args.in[7]))
#define IN_w_out ((const float*)((const float*)args.in[8]))
#define IN_g_cross ((const float*)((const float*)args.in[9]))
#define IN_g_mem ((const float*)((const float*)args.in[10]))
#define IN_w_xq ((const float*)((const float*)args.in[11]))
#define IN_w_xk ((const float*)((const float*)args.in[12]))
#define IN_w_xv ((const float*)((const float*)args.in[13]))
#define IN_w_xo ((const float*)((const float*)args.in[14]))
#define IN_g_ffn ((const float*)((const float*)args.in[15]))
#define IN_w_pq ((const float*)((const float*)args.in[16]))
#define IN_subk ((const float*)((const float*)args.in[17]))
#define IN_peer_u ((const float*)((const float*)args.in[18]))
#define IN_peer_v ((const float*)((const float*)args.in[19]))
#define IN_g_fin ((const float*)((const float*)args.in[20]))
#define IN_out ((float*)(args.out))
#define WIN ((bf16_t*)((bf16_t*)(ws + WS_WIN)))
#define WOUT ((bf16_t*)((bf16_t*)(ws + WS_WOUT)))
#define WXQ ((bf16_t*)((bf16_t*)(ws + WS_WXQ)))
#define WXKV ((bf16_t*)((bf16_t*)(ws + WS_WXKV)))
#define WXO ((bf16_t*)((bf16_t*)(ws + WS_WXO)))
#define WPQ ((bf16_t*)((bf16_t*)(ws + WS_WPQ)))
#define XB ((bf16_t*)((bf16_t*)(ws + WS_XB)))
#define MEMB ((bf16_t*)((bf16_t*)(ws + WS_MEMB)))
#define COSA ((float*)((float*)(ws + WS_COSA)))
#define SINA ((float*)((float*)(ws + WS_SINA)))
#define COSR ((float*)((float*)(ws + WS_COSR)))
#define SINR ((float*)((float*)(ws + WS_SINR)))
#define SS0 ((float*)((float*)(ws + WS_SS0)))
#define SS1 ((float*)((float*)(ws + WS_SS1)))
#define SS2 ((float*)((float*)(ws + WS_SS2)))
#define SSM ((float*)((float*)(ws + WS_SSM)))
#define KX ((bf16_t*)((bf16_t*)(ws + WS_KX)))
#define VX ((bf16_t*)((bf16_t*)(ws + WS_VX)))
#define QX ((bf16_t*)((bf16_t*)(ws + WS_QX)))
#define OX ((bf16_t*)((bf16_t*)(ws + WS_OX)))
#define EXPI ((int*)((int*)(ws + WS_EXP)))
#define GATE ((float*)((float*)(ws + WS_GATE)))
#define Y ((bf16_t*)((bf16_t*)(ws + WS_Y)))
#define PQ ((bf16_t*)((bf16_t*)(ws + WS_Y)))
#define QA ((bf16_t*)((bf16_t*)(ws + WS_QA)))
#define KA ((bf16_t*)((bf16_t*)(ws + WS_KA)))
#define VA ((bf16_t*)((bf16_t*)(ws + WS_VA)))
#define QR ((bf16_t*)((bf16_t*)(ws + WS_QR)))
#define KR ((bf16_t*)((bf16_t*)(ws + WS_KR)))
#define VR ((bf16_t*)((bf16_t*)(ws + WS_VR)))
#define GR ((bf16_t*)((bf16_t*)(ws + WS_GR)))
#define UB ((unsigned char*)(ws + WS_UB))
#define VB ((unsigned char*)(ws + WS_VB))
#define SU ((float*)((float*)(ws + WS_SU)))
#define SV ((float*)((float*)(ws + WS_SV)))
__global__ void __launch_bounds__(NWAVES * 64, 2) fwd_kernel(Args args) {
    extern __shared__ __attribute__((aligned(16))) unsigned char lds_raw[];
    LAS unsigned char* lds = (LAS unsigned char*)lds_raw;
    const int tid = threadIdx.x, lane = tid & 63; const int wave = __builtin_amdgcn_readfirstlane(tid >> 6);
    const int G = gridDim.x; const int bx = blockIdx.x; const int vcu = (G % 8 == 0) ? (bx % 8) * (G / 8) + bx / 8 : bx;
    unsigned char* ws = args.ws;
    float* const out_base = args.out;
    for (int u = tid; u < (LDS_BYTES - MISC_OFF) / 4; u += NWAVES * 64) ((LAS unsigned*)(lds + MISC_OFF))[u] = 0u;
    __syncthreads();
    const int lo = args.ph_lo, hi = args.ph_hi;
    const bool use_bar = (hi - lo) > 1;
    XcdBarrier bar; bar.bar = (unsigned*)(ws + WS_CTL) + 1024; bar.x = 0; bar.st = nullptr;
    if (use_bar) bar = xcd_barrier_post((unsigned*)(ws + WS_CTL) + 1024, (volatile LAS unsigned*)(lds + MISC_OFF) + 8);
#ifdef ONLY_PHASE
#define PHASE_ON(k) ((k) == ONLY_PHASE)
#else
#define PHASE_ON(k) true
#endif
#define IN(k) (lo <= (k) && (k) < hi)
#ifdef REPEAT_PHASE
#define REP(k) for (int _rep = 0; _rep < (((k) == REPEAT_PHASE) ? 2 : 1); ++_rep)
#else
#define REP(k)
#endif
#define SEAM(k) do { if (IN(k) && IN((k) + 1)) xcd_barrier(bar); } while (0)
    const int gw = vcu * NWAVES + wave, NGW = G * NWAVES;

    REP(0) if (PHASE_ON(0) && IN(0)) {
        LAS float* scr = (LAS float*)(lds + wave * 8448);
        constexpr int I_IN = 32 * (IN_COLS / 32), I_XQ = 32 * 16;
        constexpr int NITEMS = I_IN + 2 * I_XQ;
        for (int it = gw; it < NITEMS; it += NGW) {
            int r = it;
            if (r < I_IN) { p0_transpose_item<true>(IN_w_in, IN_g_mix, DM, IN_COLS, WIN, 0, scr, r, lane); continue; } r -= I_IN;
            if (r < I_XQ) { p0_transpose_item<false>(IN_w_xk, IN_g_mem, DM, 512, WXKV, 0, scr, r, lane); continue; } r -= I_XQ;
            p0_transpose_item<false>(IN_w_xv, IN_g_mem, DM, 512, WXKV, 512, scr, r, lane);
        }
        for (int m = gw; m < T_TOK; m += 2 * NGW) row2_to_bf16(IN_x + (size_t)m * DM, XB + (size_t)m * DM, SS0 + m, (size_t)NGW, lane);
        for (int m = gw; m < MT; m += NGW) row_to_bf16(IN_mem + (size_t)m * DM, MEMB + (size_t)m * DM, SSM + m, lane);
        const int gt = vcu * (NWAVES * 64) + tid, NGT = G * NWAVES * 64;
        for (int i = gt; i < T_TOK * 128; i += NGT) { const int tok = i >> 7, f = i & 127; const float ang = (float)IN_positions[tok] * args.inv_freq[f]; float cc, sn; sincos_red(ang, cc, sn);
            COSR[i] = cc; SINR[i] = sn; }
        for (int i = gt; i < T_TOK * 32; i += NGT) { const int tok = i >> 5, f = i & 31; const float ang = (float)IN_positions[tok] * args.inv_freq[4 * f]; float cc, sn; sincos_red(ang, cc, sn);
            COSA[i] = cc; SINA[i] = sn; }
        for (int i = gt; i < T_TOK; i += NGT) { SS1[i] = 0.f; SS2[i] = 0.f; }
        __syncthreads();
    }
    SEAM(0);
    REP(1) if (PHASE_ON(1) && IN(1)) {
        pg8::Sched S; S.A = (const char*)XB; S.B = (const char*)WIN; S.nM = T_TOK / 256; S.nN = IN_COLS / 256; S.nwg = S.nM * S.nN;
        S.A2 = (const char*)MEMB; S.B2 = (const char*)WXKV; S.nM2 = MT / 256; S.nwg2 = (MT / 256) * 4; S.G = G; S.c = bx; S.WGM = WGM_P1; S.tstep = (size_t)256 * DM * 2;
        EpiP1 E{ws};
        pg8::gemm_phase<EpiP1>(lds, DM, S, E);
        unsigned* qctr = (unsigned*)(ws + WS_CTL) + 8192 + 64; volatile LAS unsigned* qw = (volatile LAS unsigned*)(lds + MISC_OFF) + 16;
        LAS float* scr = (LAS float*)(lds + wave * 8448);
        for (;;) {
            if (tid == 0) qw[0] = atomicAdd(qctr, 1u);
            __syncthreads(); const unsigned chunk = qw[0]; __syncthreads();
            if (chunk >= 640u + NF1) break;
            if (chunk < 640u) { int r = (int)chunk * 8 + wave;
                if (r < 2048) p0_transpose_item<false>(IN_w_out, nullptr, DM, DM, WOUT, 0, scr, r, lane);
                else if ((r -= 2048) < 512) p0_transpose_item<false>(IN_w_xq, IN_g_cross, DM, 512, WXQ, 0, scr, r, lane);
                else if ((r -= 512) < 512) p0_transpose_item<false>(IN_w_xo, nullptr, 512, DM, WXO, 0, scr, r, lane);
                else p0_transpose_item<false>(IN_w_pq, IN_g_ffn, DM, DM, WPQ, 0, scr, r - 512, lane);
            } else fp8_chunk((int)chunk - 640, wave, lane, IN_peer_u, IN_peer_v, IN_g_ffn, UB, VB, SU, SV);
        }
    }
    SEAM(1);
    REP(2) if (PHASE_ON(2) && IN(2)) {
#ifdef PROBE_RET_X
        for (int rr = 0; rr < PROBE_RET_X; ++rr)
#endif
        for (int u = vcu; u < 256; u += G) { const int bh = u >> 3, s = u & 7; ret_unit(lds, bh >> 2, bh & 3, s, QR, KR, VR, GR, IN_ret_gain, Y); ret_unit(lds, bh >> 2, bh & 3, 15 - s, QR, KR, VR, GR, IN_ret_gain, Y); }
#ifdef PROBE_SWA_X
        for (int rr = 0; rr < PROBE_SWA_X; ++rr)
#endif
        for (int u = vcu; u < 256; u += G) swa_unit(lds, u >> 5, (u >> 1) & 15, u & 1, QA, KA, VA, IN_sinks, IN_att_gain, Y);
    }
    SEAM(2);
    if (PHASE_ON(3) && IN(3)) {
        pg8::Sched S; S.A = (const char*)Y; S.B = (const char*)WOUT; S.WGM = WGM_P3; S.nM = T_TOK / 256; S.nN = DM / 256; S.nwg = S.nM * S.nN; S.A2 = nullptr; S.B2 = nullptr; S.nM2 = 1; S.nwg2 = 0; S.G = G; S.c = bx; S.tstep = (size_t)256 * DM * 2;
        EpiRes1 E{IN_x, XB, SS1};
        pg8::gemm_phase<EpiRes1, false>(lds, DM, S, E);
    }
    SEAM(3);
    REP(4) if (PHASE_ON(4) && IN(4)) {
        pg8::Sched S; S.A = (const char*)XB; S.B = (const char*)WXQ; S.WGM = WGM_P4; S.nM = T_TOK / 256; S.nN = 2; S.nwg = S.nM * S.nN; S.A2 = nullptr; S.B2 = nullptr; S.nM2 = 1; S.nwg2 = 0; S.G = G; S.c = bx; S.tstep = (size_t)256 * DM * 2;
        EpiScale E{QX, 512, SS1, C3Q};
        pg8::gemm_phase<EpiScale>(lds, DM, S, E);
        unsigned* qctr = (unsigned*)(ws + WS_CTL) + 8192; volatile LAS unsigned* qw = (volatile LAS unsigned*)(lds + MISC_OFF) + 16;
        for (;;) {
            if (tid == 0) qw[0] = atomicAdd(qctr, 1u);
            __syncthreads(); const unsigned chunk = qw[0] + NF1; __syncthreads();
            if (chunk >= 2048u) break;
            fp8_chunk((int)chunk, wave, lane, IN_peer_u, IN_peer_v, IN_g_ffn, UB, VB, SU, SV);
        }
    }
    SEAM(4);
    REP(5) if (PHASE_ON(5) && IN(5)) { for (int u = vcu; u < 256; u += G) xattn_unit(lds, u >> 5, (u >> 3) & 3, u & 7, QX, KX, VX, OX); }
    SEAM(5);
    if (PHASE_ON(6) && IN(6)) {
        pg8::Sched S; S.A = (const char*)OX; S.B = (const char*)WXO; S.WGM = WGM_P6; S.nM = T_TOK / 256; S.nN = DM / 256; S.nwg = S.nM * S.nN; S.A2 = nullptr; S.B2 = nullptr; S.nM2 = 1; S.nwg2 = 0; S.G = G; S.c = bx; S.tstep = (size_t)256 * 512 * 2;
        EpiRes2 E{IN_out, XB, SS2};
        pg8::gemm_phase<EpiRes2, false>(lds, 512, S, E);
    }
    SEAM(6);
    REP(7) if (PHASE_ON(7) && IN(7)) {
        pg8::Sched S; S.A = (const char*)XB; S.B = (const char*)WPQ; S.WGM = WGM_P7; S.nM = T_TOK / 256; S.nN = DM / 256; S.nwg = S.nM * S.nN; S.A2 = nullptr; S.B2 = nullptr; S.nM2 = 1; S.nwg2 = 0; S.G = G; S.c = bx; S.tstep = (size_t)256 * DM * 2;
        EpiScale E{PQ, DM, SS2, 1.f};
        pg8::gemm_phase<EpiScale>(lds, DM, S, E);
        asm volatile("s_waitcnt vmcnt(0)" ::: "memory"); __syncthreads();
        { pg8::Unit u; for (int i = 0; S.next(i, u); ++i) peer_topk_unit(lds, u.pm, u.pn, PQ, IN_subk, EXPI, GATE); }
    }
    SEAM(7);
    if (PHASE_ON(9) && IN(9)) {
        LAS float* cw = (LAS float*)(lds + wave * 1024); LAS int* ew = (LAS int*)(lds + wave * 1024 + 512);
        LAS f32x4* xstash = (LAS f32x4*)(lds + 8192 + wave * 8192);
        for (int t = gw; t < T_TOK; t += NGW) peer_gather_token(cw, ew, (size_t)t, IN_out, IN_g_ffn, IN_g_fin, UB, VB, SU, SV, EXPI, GATE, IN_out, lane, xstash);
    }
#undef IN
#undef SEAM
}

extern "C" void kernel_launch(void* const* d_in, const int* in_sizes, int n_in, void* d_out, int out_size, void* d_ws, size_t ws_size, hipStream_t stream) {
    static int grid = 0;
    if (grid == 0) {
        if (n_in != 21 || out_size != T_TOK * DM || ws_size < WS_END) { fprintf(stderr, "kernel_launch: unexpected problem (n_in %d out %d ws %zu)\n", n_in, out_size, ws_size); grid = -1; return; }
        int dev = 0, cus = 0;
        if (hipGetDevice(&dev) != hipSuccess || hipDeviceGetAttribute(&cus, hipDeviceAttributeMultiprocessorCount, dev) != hipSuccess) { grid = -1; return; }
        if (hipFuncSetAttribute((const void*)fwd_kernel, hipFuncAttributeMaxDynamicSharedMemorySize, LDS_BYTES) != hipSuccess) { fprintf(stderr, "kernel_launch: hipFuncSetAttribute failed\n"); grid = -1; return; }
        (void)hipGetLastError();
        grid = cus;
    }
    if (grid < 0) return;
    (void)hipMemsetAsync((char*)d_ws + WS_CTL, 0, CTL_ZERO_BYTES, stream);
    Args a{};
    for (int i = 0; i < 21; ++i) a.in[i] = d_in[i];
    a.out = (float*)d_out; a.ws = (unsigned char*)d_ws;
    for (int i = 0; i < 128; ++i) a.inv_freq[i] = (float)pow(10000.0, -(double)(2 * i) / 256.0);
#ifdef MK_PER_PHASE
    for (int p = 0; p < N_PHASES; ++p) { a.ph_lo = p; a.ph_hi = p + 1;
#ifdef REPEAT_LAUNCH
        if (p == REPEAT_LAUNCH) for (int r = 0; r < 4; ++r) hipLaunchKernelGGL(fwd_kernel, dim3(grid), dim3(NWAVES * 64), LDS_BYTES, stream, a);
#endif
        hipLaunchKernelGGL(fwd_kernel, dim3(grid), dim3(NWAVES * 64), LDS_BYTES, stream, a); }
#else
    a.ph_lo = 0; a.ph_hi = N_PHASES; hipLaunchKernelGGL(fwd_kernel, dim3(grid), dim3(NWAVES * 64), LDS_BYTES, stream, a);
#endif
}
```

```cpp
#include <hip/hip_runtime.h>
#include <cstdio>
#include <cstdint>
#include <cmath>
#ifndef WGM_P1
#define WGM_P1 4
#endif
#ifndef WGM_P3
#define WGM_P3 4
#endif
#ifndef WGM_P4
#define WGM_P4 4
#endif
#ifndef WGM_P6
#define WGM_P6 4
#endif
#ifndef WGM_P7
#define WGM_P7 4
#endif
namespace pg8 {
#define PG8_LAS __attribute__((address_space(3)))
typedef unsigned short bf16_t;
typedef short bf16x8 __attribute__((ext_vector_type(8)));
typedef float f32x4 __attribute__((ext_vector_type(4)));
typedef unsigned u32x4 __attribute__((ext_vector_type(4)));
typedef unsigned u32x2 __attribute__((ext_vector_type(2)));
constexpr int BM = 256, BK = 64, HALF = 128, HTB = HALF * BK * 2  , STAGE_BYTES = 8 * HTB, NXCD = 8;

__host__ __device__ __forceinline__ int lds_byte(int r, int c) { const int st = (r >> 4) * 2 + (c >> 5), rr = r & 15, cc = c & 31, ob = rr * 64 + cc * 2; return st * 1024 + (ob ^ (((ob >> 9) & 1) << 5)); }
__host__ __device__ __forceinline__ void stage_rc(int b, int& R, int& C) { const int st = b / 1024, sb = b % 1024, swz = sb ^ (((sb >> 9) & 1) << 5); R = (st >> 1) * 16 + swz / 64; C = (st & 1) * 32 + (swz % 64) / 2; }
__host__ __device__ __forceinline__ int perm32(int rho) { const int n = rho >> 4, i = rho & 15; return 8 * (i >> 2) + 4 * n + (i & 3); }

struct Unit { int pm, pn, kind; const char* a; const char* b; };

struct Sched {
    const char *A, *B, *A2, *B2; int nM, nN, nwg, nM2, nwg2, G, c, WGM; size_t tstep;
    __device__ __forceinline__ bool next(int i, Unit& u) const {
        const long L = (long)i * G + c;
        if (L < nwg) {
            int wgid = (int)L; { const int q = nwg / NXCD, r = nwg % NXCD, xcd = wgid % NXCD, off = wgid / NXCD; wgid = (xcd < r ? xcd * (q + 1) : r * (q + 1) + (xcd - r) * q) + off; }
            const int nig = WGM * nN, gid = wgid / nig, fm = gid * WGM, gsz = (nM - fm) < WGM ? (nM - fm) : WGM;
            u.pm = fm + ((wgid % nig) % gsz); u.pn = (wgid % nig) / gsz; u.kind = 0; u.a = A + (size_t)u.pm * tstep; u.b = B + (size_t)u.pn * tstep; return true;
        }
        const long L2 = L - nwg; if (L2 >= nwg2) return false;
        u.pm = (int)(L2 % nM2); u.pn = (int)(L2 / nM2); u.kind = 1; u.a = A2 + (size_t)u.pm * tstep; u.b = B2 + (size_t)u.pn * tstep; return true;
    }
};

__device__ __forceinline__ unsigned cvt_pk_bf16(float lo, float hi) { unsigned r; asm volatile("v_cvt_pk_bf16_f32 %0, %1, %2" : "=v"(r) : "v"(lo), "v"(hi)); return r; }

template <class Epi, bool ALIGN_EPI = true, bool SP2 = true>
__device__ __forceinline__ void gemm_phase(PG8_LAS unsigned char* lds, const int K, const Sched& S, const Epi& E) {
    const int tid = threadIdx.x, wid = __builtin_amdgcn_readfirstlane(tid >> 6), lane = tid & 63, wr = wid >> 2, wc = wid & 3, fr = lane & 15, fq = lane >> 4;
    const int nt = K / BK;
    unsigned voffA[2], voffB[2];
#pragma unroll
    for (int i = 0; i < 2; ++i) { int R, C; stage_rc(tid * 16 + i * 8192, R, C); const int Rb = Epi::PERM ? ((R & ~31) + perm32(R & 31)) : R;
        voffA[i] = (unsigned)(R * K + C) * 2u; voffB[i] = (unsigned)(Rb * K + C) * 2u; }
    const size_t kstep = (size_t)(BK * 2);
    const size_t hstep = (size_t)HALF * K * 2;
    const unsigned ldsw = (unsigned)wid * 1024u;
    const int aoff = lds_byte(wr * 64 + fr, fq * 8), boff = lds_byte(wc * 32 + fr, fq * 8);
#define PG8_SA(b, h) (((b) * 2 + (h)) * HTB)
#define PG8_SB(b, h) ((4 + (b) * 2 + (h)) * HTB)
#define PG8_STAGE(bufoff, gbase, voff) do { _Pragma("unroll") for (int _i = 0; _i < 2; ++_i) \
        __builtin_amdgcn_global_load_lds((const unsigned*)((const char*)(gbase) + (voff)[_i]), (PG8_LAS unsigned*)(lds + (bufoff) + ldsw + _i * 8192), 16, 0, 0); } while (0)
#define PG8_LDA(dst, b, h) do { _Pragma("unroll") for (int m = 0; m < 4; ++m) _Pragma("unroll") for (int k = 0; k < 2; ++k) dst[m][k] = *(const PG8_LAS bf16x8*)(lds + PG8_SA(b, h) + aoff + m * 2048 + k * 1024); } while (0)
#define PG8_LDB(dst, b, h) do { _Pragma("unroll") for (int n = 0; n < 2; ++n) _Pragma("unroll") for (int k = 0; k < 2; ++k) dst[n][k] = *(const PG8_LAS bf16x8*)(lds + PG8_SB(b, h) + boff + n * 2048 + k * 1024); } while (0)
#define PG8_MMA(ai, bj, At, Bt) do { __builtin_amdgcn_s_setprio(1); _Pragma("unroll") for (int m = 0; m < 4; ++m) _Pragma("unroll") for (int n = 0; n < 2; ++n) _Pragma("unroll") for (int k = 0; k < 2; ++k) \
        acc[ai][bj][m][n] = __builtin_amdgcn_mfma_f32_16x16x32_bf16(Bt[n][k], At[m][k], acc[ai][bj][m][n], 0, 0, 0); __builtin_amdgcn_s_setprio(0); } while (0)
#define PG8_WAIT_V(n) asm volatile("s_waitcnt vmcnt(" #n ")" ::: "memory")
#define PG8_WAIT_L(n) asm volatile("s_waitcnt lgkmcnt(" #n ")" ::: "memory")
#define PG8_BAR __builtin_amdgcn_s_barrier()
#define PG8_SCHED __builtin_amdgcn_sched_barrier(0)
    Unit cur, nxt; int ui = 0;
    if (!S.next(0, cur)) return;
    f32x4 acc[2][2][4][2];
#pragma unroll
    for (int a = 0; a < 2; ++a)
#pragma unroll
        for (int b = 0; b < 2; ++b)
#pragma unroll
            for (int m = 0; m < 4; ++m)
#pragma unroll
                for (int n = 0; n < 2; ++n) acc[a][b][m][n] = (f32x4){0.f, 0.f, 0.f, 0.f};
    bf16x8 At[4][2], B0[2][2], B1[2][2];
    const char* cA = cur.a; const char* cB = cur.b;
    if constexpr (SP2) {
        PG8_STAGE(PG8_SB(0, 0), cB, voffB); PG8_STAGE(PG8_SB(0, 1), cB + hstep, voffB); PG8_STAGE(PG8_SA(0, 0), cA, voffA); PG8_STAGE(PG8_SA(0, 1), cA + hstep, voffA);
        if (wr == 1) PG8_BAR;
        PG8_WAIT_V(2); PG8_BAR;
        PG8_STAGE(PG8_SB(1, 0), cB + kstep, voffB); PG8_STAGE(PG8_SA(1, 0), cA + kstep, voffA); PG8_STAGE(PG8_SB(1, 1), cB + hstep + kstep, voffB);
        PG8_WAIT_V(6); PG8_BAR;
    } else {
        PG8_STAGE(PG8_SB(0, 0), cB, voffB); PG8_STAGE(PG8_SA(0, 0), cA, voffA); PG8_STAGE(PG8_SB(0, 1), cB + hstep, voffB); PG8_STAGE(PG8_SA(0, 1), cA + hstep, voffA);
        if (wr == 1) PG8_BAR;
        PG8_WAIT_V(4); PG8_BAR;
        PG8_STAGE(PG8_SB(1, 0), cB + kstep, voffB); PG8_STAGE(PG8_SA(1, 0), cA + kstep, voffA); PG8_STAGE(PG8_SB(1, 1), cB + hstep + kstep, voffB);
        PG8_WAIT_V(6); PG8_BAR;
    }
    for (;;) {
        const bool has_next = S.next(ui + 1, nxt);
        const char* nA = has_next ? nxt.a : cA; const char* nB = has_next ? nxt.b : cB;
        for (int t = 0; t < nt; t += 2) {
            const bool last = (t == nt - 2);
            const char* a1 = cA + (size_t)(t + 1) * kstep;
            const char* a2 = last ? nA : cA + (size_t)(t + 2) * kstep; const char* b2 = last ? nB : cB + (size_t)(t + 2) * kstep;
            const char* a3 = a2 + kstep; const char* b3 = b2 + kstep;
            if constexpr (SP2) {
            PG8_LDB(B0, 0, 0); PG8_LDB(B1, 0, 1); PG8_SCHED; PG8_LDA(At, 0, 0); PG8_STAGE(PG8_SA(1, 1), a1 + hstep, voffA);
            PG8_WAIT_V(8); PG8_WAIT_L(0); PG8_BAR; PG8_MMA(0, 0, At, B0); PG8_MMA(0, 1, At, B1); PG8_BAR; PG8_SCHED;
            PG8_LDA(At, 0, 1); PG8_STAGE(PG8_SB(0, 0), b2, voffB); PG8_STAGE(PG8_SB(0, 1), b2 + hstep, voffB); PG8_STAGE(PG8_SA(0, 0), a2, voffA);
            PG8_WAIT_V(8); PG8_WAIT_L(0); PG8_BAR; PG8_MMA(1, 0, At, B0); PG8_MMA(1, 1, At, B1); PG8_BAR; PG8_SCHED;
            PG8_LDB(B0, 1, 0); PG8_LDB(B1, 1, 1); PG8_SCHED; PG8_LDA(At, 1, 0); PG8_STAGE(PG8_SA(0, 1), a2 + hstep, voffA);
            PG8_WAIT_V(8); PG8_WAIT_L(0); PG8_BAR; PG8_MMA(0, 0, At, B0); PG8_MMA(0, 1, At, B1); PG8_BAR; PG8_SCHED;
            PG8_LDA(At, 1, 1); PG8_STAGE(PG8_SB(1, 0), b3, voffB); PG8_STAGE(PG8_SB(1, 1), b3 + hstep, voffB); PG8_STAGE(PG8_SA(1, 0), a3, voffA);
            PG8_WAIT_V(8); PG8_WAIT_L(0); PG8_BAR; PG8_MMA(1, 0, At, B0); PG8_MMA(1, 1, At, B1); PG8_BAR; PG8_SCHED;
            } else {
            PG8_LDB(B0, 0, 0); PG8_SCHED; PG8_LDA(At, 0, 0); PG8_STAGE(PG8_SA(1, 1), a1 + hstep, voffA);
            PG8_WAIT_L(8); PG8_BAR; PG8_WAIT_L(0); PG8_MMA(0, 0, At, B0); PG8_BAR; PG8_SCHED;
            PG8_LDB(B1, 0, 1); PG8_STAGE(PG8_SB(0, 0), b2, voffB);
            PG8_BAR; PG8_WAIT_L(0); PG8_MMA(0, 1, At, B1); PG8_BAR;
            PG8_LDA(At, 0, 1); PG8_STAGE(PG8_SA(0, 0), a2, voffA);
            PG8_BAR; PG8_WAIT_L(0); PG8_MMA(1, 0, At, B0); PG8_BAR; PG8_SCHED;
            PG8_STAGE(PG8_SB(0, 1), b2 + hstep, voffB);
            PG8_WAIT_V(6); PG8_BAR; PG8_MMA(1, 1, At, B1); PG8_BAR;
            PG8_LDB(B0, 1, 0); PG8_SCHED; PG8_LDA(At, 1, 0); PG8_STAGE(PG8_SA(0, 1), a2 + hstep, voffA);
            PG8_WAIT_L(8); PG8_BAR; PG8_WAIT_L(0); PG8_MMA(0, 0, At, B0); PG8_BAR; PG8_SCHED;
            PG8_LDB(B1, 1, 1); PG8_STAGE(PG8_SB(1, 0), b3, voffB);
            PG8_BAR; PG8_WAIT_L(0); PG8_MMA(0, 1, At, B1); PG8_BAR;
            PG8_LDA(At, 1, 1); PG8_STAGE(PG8_SA(1, 0), a3, voffA);
            PG8_BAR; PG8_WAIT_L(0); PG8_MMA(1, 0, At, B0); PG8_BAR; PG8_SCHED;
            PG8_STAGE(PG8_SB(1, 1), b3 + hstep, voffB);
            PG8_WAIT_V(6); PG8_BAR; PG8_MMA(1, 1, At, B1); PG8_BAR;
            }
        }
        if constexpr (ALIGN_EPI) { if (wr == 0) PG8_BAR; }
        E(acc, cur, wr, wc, fr, fq);
        if (!has_next) break;
#pragma unroll
        for (int a = 0; a < 2; ++a)
#pragma unroll
            for (int b = 0; b < 2; ++b)
#pragma unroll
                for (int m = 0; m < 4; ++m)
#pragma unroll
                    for (int n = 0; n < 2; ++n) acc[a][b][m][n] = (f32x4){0.f, 0.f, 0.f, 0.f};
        cur = nxt; cA = nA; cB = nB; ++ui;
        if constexpr (ALIGN_EPI) { if (wr == 1) PG8_BAR; }
    }
    PG8_WAIT_V(0);
    if constexpr (!ALIGN_EPI) { if (wr == 0) PG8_BAR; }
    PG8_BAR;
#undef PG8_SA
#undef PG8_SB
#undef PG8_STAGE
#undef PG8_LDA
#undef PG8_LDB
#undef PG8_MMA
#undef PG8_WAIT_V
#undef PG8_WAIT_L
#undef PG8_BAR
#undef PG8_SCHED
}
}
constexpr int T_TOK = 16384, DM = 2048, SEQ = 2048, NBATCH = 8, MEML = 256, MT = NBATCH * MEML, IN_COLS = 5376;
constexpr float EPS = 1e-6f, GN_EPS = 1e-5f, LOG2E = 1.4426950408889634f;
constexpr float C2Q = 0.125f * LOG2E;
constexpr float C3Q = 0.08838834764831845f * LOG2E;
constexpr size_t MiB = 1u << 20;
constexpr size_t WS_CTL = 0, CTL_ZERO_BYTES = 64 * 1024;
constexpr size_t WS_WIN = 2 * MiB, WS_WOUT = 23 * MiB, WS_WXQ = 31 * MiB, WS_WXKV = 33 * MiB, WS_WXO = 37 * MiB, WS_WPQ = 39 * MiB;
constexpr size_t WS_XB = 48 * MiB, WS_MEMB = 112 * MiB;
constexpr size_t WS_COSA = 120 * MiB, WS_SINA = 122 * MiB, WS_COSR = 124 * MiB, WS_SINR = 132 * MiB;
constexpr size_t WS_SS0 = 140 * MiB, WS_SS1 = WS_SS0 + 65536, WS_SS2 = WS_SS1 + 65536, WS_SSM = WS_SS2 + 65536;
constexpr size_t WS_KX = 141 * MiB, WS_VX = 143 * MiB, WS_QX = 145 * MiB, WS_OX = 161 * MiB, WS_EXP = 177 * MiB, WS_GATE = 185 * MiB;
constexpr size_t WS_Y = 193 * MiB;
constexpr size_t WS_QA = 257 * MiB, WS_KA = 289 * MiB, WS_VA = 293 * MiB, WS_QR = 297 * MiB, WS_KR = 329 * MiB, WS_VR = 361 * MiB, WS_GR = 393 * MiB;
constexpr size_t WS_UB = 425 * MiB, WS_VB = 457 * MiB, WS_SU = 489 * MiB, WS_SV = WS_SU + 65536;
constexpr size_t WS_END = 490 * MiB;

#define GAS __attribute__((address_space(1)))
#define LAS __attribute__((address_space(3)))
typedef unsigned short bf16_t;
typedef short bf16x8 __attribute__((ext_vector_type(8)));
typedef short v4i16 __attribute__((ext_vector_type(4)));
typedef float f32x4 __attribute__((ext_vector_type(4)));
typedef float f32x2 __attribute__((ext_vector_type(2)));
typedef unsigned u32x4 __attribute__((ext_vector_type(4)));
typedef unsigned u32x2 __attribute__((ext_vector_type(2)));
typedef __bf16 bf16x2_t __attribute__((ext_vector_type(2)));

__device__ __forceinline__ unsigned pk2(float lo, float hi) { f32x2 v = {lo, hi}; bf16x2_t b = __builtin_convertvector(v, bf16x2_t); return __builtin_bit_cast(unsigned, b); }
__device__ __forceinline__ float bf_lo(unsigned w) { return __uint_as_float(w << 16); }
__device__ __forceinline__ float bf_hi(unsigned w) { return __uint_as_float(w & 0xffff0000u); }
__device__ __forceinline__ float wave_sum(float v) {
#pragma unroll
    for (int o = 1; o < 64; o <<= 1) v += __shfl_xor(v, o);
    return v;
}

struct EpiP1 {
    static constexpr bool PERM = true;
    unsigned char* ws;
    __device__ __forceinline__ void operator()(const pg8::f32x4 (&acc)[2][2][4][2], const pg8::Unit& u, int wr, int wc, int fr, int fq) const {
        if (u.kind == 1) {
            const float* ssm = (const float*)(ws + WS_SSM);
            bf16_t* O = (bf16_t*)(ws + ((u.pn < 2) ? WS_KX : WS_VX)); const int cb = (u.pn & 1) * 256 + wc * 32 + 8 * fq;
#pragma unroll
            for (int ai = 0; ai < 2; ++ai)
#pragma unroll
                for (int m = 0; m < 4; ++m) { const int row = u.pm * 256 + ai * 128 + wr * 64 + m * 16 + fr; const float rs = rsqrtf(ssm[row] * (1.f / DM) + EPS);
#pragma unroll
                    for (int bj = 0; bj < 2; ++bj) { const f32x4 v0 = acc[ai][bj][m][0] * rs, v1 = acc[ai][bj][m][1] * rs;
                        u32x4 w; w.x = pk2(v0[0], v0[1]); w.y = pk2(v0[2], v0[3]); w.z = pk2(v1[0], v1[1]); w.w = pk2(v1[2], v1[3]);
                        *(u32x4*)(O + (size_t)row * 512 + cb + bj * 128) = w; } }
            return;
        }
        const float* ss0 = (const float*)(ws + WS_SS0);
        const int pn = u.pn;
        size_t ooff, ctoff, stoff; int pitch, colbase, i0, half, tw; float sc; bool rope;
        if (pn < 4)        { ooff = WS_QA; pitch = 1024; colbase = (4 * pn + wc) * 64; i0 = 8 * fq; half = 32; tw = 32; ctoff = WS_COSA; stoff = WS_SINA; sc = C2Q; rope = true; }
        else if (pn == 4)  { if (wc < 2) { ooff = WS_KA; colbase = wc * 64; rope = true; } else { ooff = WS_VA; colbase = (wc - 2) * 64; rope = false; }
                             pitch = 128; i0 = 8 * fq; half = 32; tw = 32; ctoff = WS_COSA; stoff = WS_SINA; sc = 1.f; }
        else { const int q = (pn - 5) >> 2, h = (pn - 5) & 3; ooff = WS_QR + (size_t)q * (32 * MiB); pitch = 1024; colbase = h * 256; i0 = 32 * wc + 8 * fq; half = 128; tw = 128; ctoff = WS_COSR; stoff = WS_SINR;
               sc = (q == 1) ? 0.0625f : 1.f; rope = (q < 2); }
        bf16_t* O = (bf16_t*)(ws + ooff); const float* ct = (const float*)(ws + ctoff); const float* st = (const float*)(ws + stoff);
#pragma unroll
        for (int ai = 0; ai < 2; ++ai)
#pragma unroll
            for (int m = 0; m < 4; ++m) { const int row = u.pm * 256 + ai * 128 + wr * 64 + m * 16 + fr; const float rs = rsqrtf(ss0[row] * (1.f / DM) + EPS) * sc;
                f32x4 a0 = acc[ai][0][m][0] * rs, a1 = acc[ai][0][m][1] * rs, b0 = acc[ai][1][m][0] * rs, b1 = acc[ai][1][m][1] * rs;
                if (rope) { const f32x4 c0 = *(const f32x4*)(ct + (size_t)row * tw + i0), c1 = *(const f32x4*)(ct + (size_t)row * tw + i0 + 4);
                            const f32x4 s0 = *(const f32x4*)(st + (size_t)row * tw + i0), s1 = *(const f32x4*)(st + (size_t)row * tw + i0 + 4);
                            const f32x4 o0 = a0 * c0 - b0 * s0, o1 = a1 * c1 - b1 * s1, p0 = b0 * c0 + a0 * s0, p1 = b1 * c1 + a1 * s1; a0 = o0; a1 = o1; b0 = p0; b1 = p1; }
                bf16_t* rp = O + (size_t)row * pitch + colbase + i0;
                u32x4 w; w.x = pk2(a0[0], a0[1]); w.y = pk2(a0[2], a0[3]); w.z = pk2(a1[0], a1[1]); w.w = pk2(a1[2], a1[3]); *(u32x4*)rp = w;
                w.x = pk2(b0[0], b0[1]); w.y = pk2(b0[2], b0[3]); w.z = pk2(b1[0], b1[1]); w.w = pk2(b1[2], b1[3]); *(u32x4*)(rp + half) = w; }
    }
};
struct EpiRes1 {
    static constexpr bool PERM = true;
    const float* res; bf16_t* XB; float* ss;
    __device__ __forceinline__ void operator()(const pg8::f32x4 (&acc)[2][2][4][2], const pg8::Unit& u, int wr, int wc, int fr, int fq) const {
        const int col0 = u.pn * 256 + wc * 32 + 8 * fq;
#pragma unroll
        for (int ai = 0; ai < 2; ++ai) {
            f32x4 r[4][2][2];
#pragma unroll
            for (int m = 0; m < 4; ++m) { const size_t off = (size_t)(u.pm * 256 + ai * 128 + wr * 64 + m * 16 + fr) * DM + col0;
#pragma unroll
                for (int bj = 0; bj < 2; ++bj) { r[m][bj][0] = *(const f32x4*)(res + off + bj * 128); r[m][bj][1] = *(const f32x4*)(res + off + bj * 128 + 4); } }
#pragma unroll
            for (int m = 0; m < 4; ++m) { const int row = u.pm * 256 + ai * 128 + wr * 64 + m * 16 + fr; const size_t off = (size_t)row * DM + col0; float s = 0.f;
#pragma unroll
                for (int bj = 0; bj < 2; ++bj) { const size_t o = off + bj * 128;
                    const f32x4 v0 = r[m][bj][0] + acc[ai][bj][m][0], v1 = r[m][bj][1] + acc[ai][bj][m][1];
                    u32x4 w; w.x = pk2(v0[0], v0[1]); w.y = pk2(v0[2], v0[3]); w.z = pk2(v1[0], v1[1]); w.w = pk2(v1[2], v1[3]); *(u32x4*)(XB + o) = w;
                    s += ((v0[0] * v0[0] + v0[1] * v0[1]) + (v0[2] * v0[2] + v0[3] * v0[3])) + ((v1[0] * v1[0] + v1[1] * v1[1]) + (v1[2] * v1[2] + v1[3] * v1[3])); }
                s += __shfl_xor(s, 16); s += __shfl_xor(s, 32);
                if (fq == 0) atomicAdd(ss + row, s); }
            asm volatile("" ::: "memory");
        }
    }
};
struct EpiRes2 {
    static constexpr bool PERM = true;
    float* X; bf16_t* XB; float* ss;
    __device__ __forceinline__ void operator()(const pg8::f32x4 (&acc)[2][2][4][2], const pg8::Unit& u, int wr, int wc, int fr, int fq) const {
        const int col0 = u.pn * 256 + wc * 32 + 8 * fq;
        u32x4 r[2][4][2];
#pragma unroll
        for (int ai = 0; ai < 2; ++ai)
#pragma unroll
            for (int m = 0; m < 4; ++m) { const size_t off = (size_t)(u.pm * 256 + ai * 128 + wr * 64 + m * 16 + fr) * DM + col0;
#pragma unroll
                for (int bj = 0; bj < 2; ++bj) r[ai][m][bj] = *(const u32x4*)(XB + off + bj * 128); }
#pragma unroll
        for (int ai = 0; ai < 2; ++ai)
#pragma unroll
            for (int m = 0; m < 4; ++m) { const int row = u.pm * 256 + ai * 128 + wr * 64 + m * 16 + fr; const size_t off = (size_t)row * DM + col0; float s = 0.f;
#pragma unroll
                for (int bj = 0; bj < 2; ++bj) { const size_t o = off + bj * 128; const u32x4 q = r[ai][m][bj];
                    const f32x4 v0 = (f32x4){bf_lo(q.x), bf_hi(q.x), bf_lo(q.y), bf_hi(q.y)} + acc[ai][bj][m][0], v1 = (f32x4){bf_lo(q.z), bf_hi(q.z), bf_lo(q.w), bf_hi(q.w)} + acc[ai][bj][m][1];
                    *(f32x4*)(X + o) = v0; *(f32x4*)(X + o + 4) = v1;
                    u32x4 w; w.x = pk2(v0[0], v0[1]); w.y = pk2(v0[2], v0[3]); w.z = pk2(v1[0], v1[1]); w.w = pk2(v1[2], v1[3]); *(u32x4*)(XB + o) = w;
                    s += ((v0[0] * v0[0] + v0[1] * v0[1]) + (v0[2] * v0[2] + v0[3] * v0[3])) + ((v1[0] * v1[0] + v1[1] * v1[1]) + (v1[2] * v1[2] + v1[3] * v1[3])); }
                s += __shfl_xor(s, 16); s += __shfl_xor(s, 32);
                if (fq == 0) atomicAdd(ss + row, s); }
    }
};
struct EpiScale {
    static constexpr bool PERM = true;
    bf16_t* O; int ldc; const float* ss; float scale;
    __device__ __forceinline__ void operator()(const pg8::f32x4 (&acc)[2][2][4][2], const pg8::Unit& u, int wr, int wc, int fr, int fq) const {
        const int col0 = u.pn * 256 + wc * 32 + 8 * fq;
#pragma unroll
        for (int ai = 0; ai < 2; ++ai)
#pragma unroll
            for (int m = 0; m < 4; ++m) { const int row = u.pm * 256 + ai * 128 + wr * 64 + m * 16 + fr; const float rs = rsqrtf(ss[row] * (1.f / DM) + EPS) * scale;
#pragma unroll
                for (int bj = 0; bj < 2; ++bj) { const f32x4 v0 = acc[ai][bj][m][0] * rs, v1 = acc[ai][bj][m][1] * rs;
                    u32x4 w; w.x = pk2(v0[0], v0[1]); w.y = pk2(v0[2], v0[3]); w.z = pk2(v1[0], v1[1]); w.w = pk2(v1[2], v1[3]);
                    *(u32x4*)(O + (size_t)row * ldc + col0 + bj * 128) = w; } }
    }
};
#define XB_TMO      128
#define XB_XCNT(j)  (256  + 64 * (j))
#define XB_XSUB(j)  (1280 + 64 * (j))
#define XB_XGEN(j)  (2304 + 64 * (j))
#define XB_TOP      3328
#define XB_TOPGEN   3392
#define XCD_BAR_WORDS 3456
#define XB_SPIN_CAP (1u << 18)
__device__ __forceinline__ unsigned xb_ld(unsigned* p)              { return __hip_atomic_load(p, __ATOMIC_RELAXED, __HIP_MEMORY_SCOPE_AGENT); }
__device__ __forceinline__ unsigned xb_add(unsigned* p, unsigned v) { return __hip_atomic_fetch_add(p, v, __ATOMIC_RELAXED, __HIP_MEMORY_SCOPE_AGENT); }
__device__ __forceinline__ unsigned xb_xcc_id() { return (unsigned)__builtin_amdgcn_s_getreg((3 << 11) | 20) & 0xFu; }
#define XB_SPIN(cond, bar) do { unsigned _sp = 0; while (cond) { __builtin_amdgcn_s_sleep(1); \
    if ((++_sp & 255u) == 0u) { if (xb_ld(&(bar)[XB_TMO])) break; if (_sp > XB_SPIN_CAP) { atomicAdd(&(bar)[XB_TMO], 1u); break; } } } } while (0)
struct XcdBarrier { unsigned* bar; unsigned x; volatile LAS unsigned* st; };
__device__ __forceinline__ XcdBarrier xcd_barrier_post(unsigned* bar, volatile LAS unsigned* st) {
    XcdBarrier b; b.bar = bar; b.x = xb_xcc_id(); b.st = st;
    if (threadIdx.x == 0) (void)xb_add(&bar[XB_XCNT(b.x)], 1u);
    return b;
}
__device__ __forceinline__ void xcd_barrier_complete(unsigned* bar, unsigned x, unsigned& nloc, unsigned& nx) {
    const unsigned G = gridDim.x * gridDim.y * gridDim.z;
    unsigned sum, cnt, mine, sp = 0u;
    for (;;) {
        sum = 0u; cnt = 0u; mine = 0u;
#pragma unroll
        for (unsigned j = 0; j < 16; ++j) { const unsigned c = xb_ld(&bar[XB_XCNT(j)]); sum += c; cnt += (c > 0u) ? 1u : 0u; mine = (j == x) ? c : mine; }
        if (sum == G) break;
        __builtin_amdgcn_s_sleep(1);
        if ((++sp & 255u) == 0u) { if (xb_ld(&bar[XB_TMO])) break; if (sp > XB_SPIN_CAP) { atomicAdd(&bar[XB_TMO], 1u); break; } }
    }
    nloc = mine > 0u ? mine : 1u; nx = cnt > 0u ? cnt : 1u;
}
__device__ __forceinline__ void xcd_barrier(const XcdBarrier& b) {
    asm volatile("s_waitcnt vmcnt(0)" ::: "memory");
    __syncthreads();
    if (threadIdx.x == 0) {
        unsigned* bar = b.bar;
        __builtin_amdgcn_s_waitcnt(0);
        unsigned nloc = b.st[0], nx = b.st[1];
        if (nloc == 0u) { xcd_barrier_complete(bar, b.x, nloc, nx); b.st[0] = nloc; b.st[1] = nx; }
        const unsigned old = xb_add(&bar[XB_XSUB(b.x)], 1u);
        const unsigned gen = old / nloc;
        if (old + 1u == (gen + 1u) * nloc) {
            __builtin_amdgcn_fence(__ATOMIC_RELEASE, "agent");
            asm volatile("s_waitcnt vmcnt(0)" ::: "memory");
            const unsigned og = xb_add(&bar[XB_TOP], 1u);
            const unsigned tg = og / nx;
            if (og + 1u == (tg + 1u) * nx) xb_add(&bar[XB_TOPGEN], 1u);
            else XB_SPIN(xb_ld(&bar[XB_TOPGEN]) == tg, bar);
            __builtin_amdgcn_fence(__ATOMIC_ACQUIRE, "agent");
            xb_add(&bar[XB_XGEN(b.x)], 1u);
            asm volatile("s_waitcnt vmcnt(0)" ::: "memory");
        } else {
            XB_SPIN(xb_ld(&bar[XB_XGEN(b.x)]) == gen, bar);
            __builtin_amdgcn_fence(__ATOMIC_ACQUIRE, "agent");
            asm volatile("s_waitcnt vmcnt(0)" ::: "memory");
        }
    }
    __syncthreads();
}

__device__ __forceinline__ int win_phys(int n) {
    if (n < 1024) { const int head = n >> 6, d = n & 63; return (head >> 2) * 256 + (d >> 5) * 128 + (head & 3) * 32 + (d & 31); }
    if (n < 1280) { const int m = n - 1024, kind = m >> 7, hh = (m & 127) >> 6, d = m & 63; return 1024 + (d >> 5) * 128 + (kind * 2 + hh) * 32 + (d & 31); }
    return n;
}
template <bool PERMW>
__device__ __forceinline__ void p0_transpose_item(const float* W, const float* gk, int K, int N, bf16_t* WT, int row_off, LAS float* scr, int item, int lane) {
    const int nblk = N / 32, kb = item / nblk, nb = item % nblk, k0 = 64 * kb, n0 = 32 * nb;
    float wv[32];
#pragma unroll
    for (int i = 0; i < 32; ++i) { const int kk = 2 * i + (lane >> 5); wv[i] = W[(size_t)(k0 + kk) * N + n0 + (lane & 31)]; }
#pragma unroll
    for (int i = 0; i < 32; ++i) { const int kk = 2 * i + (lane >> 5); const float g = gk ? gk[k0 + kk] : 1.f; scr[kk * 33 + (lane & 31)] = wv[i] * g; }
    asm volatile("s_waitcnt lgkmcnt(0)" ::: "memory");
    const int c = lane & 7; const int pr0 = PERMW ? win_phys(n0) : n0;
#pragma unroll
    for (int j = 0; j < 4; ++j) { const int n = (lane >> 3) + 8 * j; const LAS float* s = scr + (8 * c) * 33 + n;
        u32x4 o; o.x = pk2(s[0 * 33], s[1 * 33]); o.y = pk2(s[2 * 33], s[3 * 33]); o.z = pk2(s[4 * 33], s[5 * 33]); o.w = pk2(s[6 * 33], s[7 * 33]);
        *(u32x4*)(WT + (size_t)(row_off + pr0 + n) * K + k0 + 8 * c) = o; }
    asm volatile("s_waitcnt lgkmcnt(0)" ::: "memory");
}
__device__ __forceinline__ void row_to_bf16(const float* xrow, bf16_t* orow, float* ssq, int lane) {
    const f32x4* xr = (const f32x4*)xrow + lane; f32x4 v[8]; float s = 0.f;
#pragma unroll
    for (int j = 0; j < 8; ++j) { v[j] = xr[64 * j]; s += (v[j][0] * v[j][0] + v[j][1] * v[j][1]) + (v[j][2] * v[j][2] + v[j][3] * v[j][3]); }
    s = wave_sum(s);
    u32x2* o8 = (u32x2*)orow + lane;
#pragma unroll
    for (int j = 0; j < 8; ++j) { u32x2 w; w.x = pk2(v[j][0], v[j][1]); w.y = pk2(v[j][2], v[j][3]); o8[64 * j] = w; }
    if (lane == 0) *ssq = s;
}
__device__ __forceinline__ void row2_to_bf16(const float* xrow, bf16_t* orow, float* ssq, size_t rstep, int lane) {
    const f32x4* xr0 = (const f32x4*)xrow + lane; const f32x4* xr1 = (const f32x4*)(xrow + rstep * DM) + lane; f32x4 v[8], q[8]; float s0 = 0.f, s1 = 0.f;
#pragma unroll
    for (int j = 0; j < 8; ++j) { v[j] = xr0[64 * j]; q[j] = xr1[64 * j]; }
#pragma unroll
    for (int j = 0; j < 8; ++j) { s0 += (v[j][0] * v[j][0] + v[j][1] * v[j][1]) + (v[j][2] * v[j][2] + v[j][3] * v[j][3]); s1 += (q[j][0] * q[j][0] + q[j][1] * q[j][1]) + (q[j][2] * q[j][2] + q[j][3] * q[j][3]); }
    s0 = wave_sum(s0); s1 = wave_sum(s1);
    u32x2* o0 = (u32x2*)orow + lane; u32x2* o1 = (u32x2*)(orow + rstep * DM) + lane;
#pragma unroll
    for (int j = 0; j < 8; ++j) { u32x2 w; w.x = pk2(v[j][0], v[j][1]); w.y = pk2(v[j][2], v[j][3]); o0[64 * j] = w; w.x = pk2(q[j][0], q[j][1]); w.y = pk2(q[j][2], q[j][3]); o1[64 * j] = w; }
    if (lane == 0) { ssq[0] = s0; ssq[rstep] = s1; }
}
__device__ __forceinline__ void sincos_red(float ang, float& c, float& s) {
    const float k = rintf(ang * 0.15915494309189535f);
    float r = fmaf(-k, 6.28125f, ang); r = fmaf(-k, 1.9353071795864769e-3f, r);
    const float rev = r * 0.15915494309189535f;
    s = __builtin_amdgcn_sinf(rev); c = __builtin_amdgcn_cosf(rev);
}

#define MFMA16(a, b, c) __builtin_amdgcn_mfma_f32_16x16x32_bf16((a), (b), (c), 0, 0, 0)
__device__ __forceinline__ bf16x8 pack_p(const f32x4& lo, const f32x4& hi) {
    u32x4 w; w.x = pk2(lo[0], lo[1]); w.y = pk2(lo[2], lo[3]); w.z = pk2(hi[0], hi[1]); w.w = pk2(hi[2], hi[3]); return __builtin_bit_cast(bf16x8, w);
}
__device__ __forceinline__ bf16x8 vt_frag(LAS const unsigned char* p, int stride16) {
    const v4i16 lo = __builtin_amdgcn_ds_read_tr16_b64_v4i16((LAS v4i16*)p);
    const v4i16 hi = __builtin_amdgcn_ds_read_tr16_b64_v4i16((LAS v4i16*)(p + stride16));
    return (bf16x8){lo[0], lo[1], lo[2], lo[3], hi[0], hi[1], hi[2], hi[3]};
}

__device__ __forceinline__ void swa_unit(LAS unsigned char* lds, int b, int n, int kvh, const bf16_t* QA, const bf16_t* KA, const bf16_t* VA,
                                         const float* sinks, const float* att_gain, bf16_t* Y) {
    constexpr int KS = 144;
    const int tid = threadIdx.x, lane = tid & 63, c = lane & 15, g = lane >> 4; const int w = __builtin_amdgcn_readfirstlane(tid >> 6);
    LAS unsigned char* Kl = lds; LAS unsigned char* Vl = lds + 256 * KS;
    for (int i = tid; i < 2048; i += 512) { const int key = i >> 3, ch = i & 7, pos = 128 * (n - 1) + key; u32x4 kv = {0u, 0u, 0u, 0u}, vv = {0u, 0u, 0u, 0u};
        if (pos >= 0) { const size_t off = (size_t)(b * SEQ + pos) * 128 + kvh * 64 + ch * 8; kv = *(const u32x4*)(KA + off); vv = *(const u32x4*)(VA + off); }
        *(LAS u32x4*)(Kl + key * KS + ch * 16) = kv; *(LAS u32x4*)(Vl + key * KS + ch * 16) = vv; }
    __syncthreads();
    const int hq = kvh * 8 + w; const float sink = sinks[hq] * LOG2E;
    bf16x8 qn[2];
#pragma unroll
    for (int ks = 0; ks < 2; ++ks) qn[ks] = *(const bf16x8*)(QA + (size_t)(b * SEQ + 128 * n + c) * 1024 + hq * 64 + ks * 32 + 8 * g);
    for (int a = 0; a < 8; ++a) {
        const int t = b * SEQ + 128 * n + 16 * a + c; const int kb0 = (a & ~1) * 16; const int qi = 128 + 16 * a + c;
        bf16x8 qf[2];
#pragma unroll
        for (int ks = 0; ks < 2; ++ks) { qf[ks] = qn[ks]; qn[ks] = *(const bf16x8*)(QA + (size_t)(t + (a < 7 ? 16 : 0)) * 1024 + hq * 64 + ks * 32 + 8 * g); }
        f32x4 s[10]; float m = sink;
#pragma unroll
        for (int blk = 0; blk < 10; ++blk) { const int key0 = kb0 + 16 * blk; f32x4 acc = {0.f, 0.f, 0.f, 0.f};
#pragma unroll
            for (int ks = 0; ks < 2; ++ks) { const bf16x8 kf = *(LAS const bf16x8*)(Kl + (key0 + c) * KS + (ks * 32 + 8 * g) * 2); acc = MFMA16(kf, qf[ks], acc); }
#pragma unroll
            for (int r = 0; r < 4; ++r) { const int j = key0 + 4 * g + r; const bool ok = (j <= qi) && (j > qi - 128) && (n > 0 || j >= 128);
                acc[r] = ok ? acc[r] : -INFINITY; m = fmaxf(m, acc[r]); }
            s[blk] = acc; }
        m = fmaxf(m, __shfl_xor(m, 16)); m = fmaxf(m, __shfl_xor(m, 32));
        float l = 0.f;
#pragma unroll
        for (int blk = 0; blk < 10; ++blk)
#pragma unroll
            for (int r = 0; r < 4; ++r) { const float p = __builtin_amdgcn_exp2f(s[blk][r] - m); s[blk][r] = p; l += p; }
        l += __shfl_xor(l, 16); l += __shfl_xor(l, 32); l += __builtin_amdgcn_exp2f(sink - m);
        f32x4 o[4];
#pragma unroll
        for (int db = 0; db < 4; ++db) o[db] = (f32x4){0.f, 0.f, 0.f, 0.f};
#pragma unroll
        for (int kp = 0; kp < 5; ++kp) { const bf16x8 pf = pack_p(s[2 * kp], s[2 * kp + 1]); const int key0 = kb0 + 32 * kp;
#pragma unroll
            for (int db = 0; db < 4; ++db) { const bf16x8 af = vt_frag(Vl + (key0 + 4 * g + (c >> 2)) * KS + (16 * db + 4 * (c & 3)) * 2, 16 * KS); o[db] = MFMA16(af, pf, o[db]); } }
        const float inv = 1.f / l; float q2 = 0.f;
#pragma unroll
        for (int db = 0; db < 4; ++db) { o[db] = o[db] * inv; q2 += (o[db][0] * o[db][0] + o[db][1] * o[db][1]) + (o[db][2] * o[db][2] + o[db][3] * o[db][3]); }
        q2 += __shfl_xor(q2, 16); q2 += __shfl_xor(q2, 32);
        const float rms = rsqrtf(q2 * (1.f / 64.f) + EPS);
#pragma unroll
        for (int db = 0; db < 4; ++db) { const int col = hq * 64 + 16 * db + 4 * g; const f32x4 gn = *(const f32x4*)(att_gain + col); const f32x4 v = o[db] * rms * gn;
            u32x2 wv; wv.x = pk2(v[0], v[1]); wv.y = pk2(v[2], v[3]); *(u32x2*)(Y + (size_t)t * DM + col) = wv; }
    }
    __syncthreads();
}

__device__ __forceinline__ void ret_unit(LAS unsigned char* lds, int b, int h, int qb, const bf16_t* QR, const bf16_t* KR, const bf16_t* VR, const bf16_t* GR,
                                         const float* ret_gain, bf16_t* Y) {
    constexpr int RS = 544, TB = 64 * RS;
    const int tid = threadIdx.x, lane = tid & 63, c = lane & 15, g = lane >> 4; const int w = __builtin_amdgcn_readfirstlane(tid >> 6);
    const int nt = 2 * qb + 2; const size_t rowb = (size_t)b * SEQ; const int hoff = h * 256;
    const int qpos = 128 * qb + 16 * w + c; const size_t t = rowb + qpos;
    const float lg = log2f(1.f - exp2f(-5.f - (float)h));
    bf16x8 qf[8];
#pragma unroll
    for (int ks = 0; ks < 8; ++ks) qf[ks] = *(const bf16x8*)(QR + t * 1024 + hoff + ks * 32 + 8 * g);
    f32x4 o[16];
#pragma unroll
    for (int db = 0; db < 16; ++db) o[db] = (f32x4){0.f, 0.f, 0.f, 0.f};
    u32x4 pk[4], pv[4];
#define RET_LOAD(kt) do { _Pragma("unroll") for (int i = 0; i < 4; ++i) { const int id = tid + 512 * i, key = id >> 5, ch = id & 31; const size_t off = (rowb + 64 * (kt) + key) * 1024 + hoff + ch * 8; \
        pk[i] = *(const u32x4*)(KR + off); pv[i] = *(const u32x4*)(VR + off); } } while (0)
#define RET_WRITE(buf) do { _Pragma("unroll") for (int i = 0; i < 4; ++i) { const int id = tid + 512 * i, key = id >> 5, ch = id & 31; \
        *(LAS u32x4*)(lds + (buf) * 2 * TB + key * RS + ch * 16) = pk[i]; *(LAS u32x4*)(lds + (buf) * 2 * TB + TB + key * RS + ch * 16) = pv[i]; } } while (0)
    RET_LOAD(0); RET_WRITE(0); __syncthreads();
    for (int kt = 0; kt < nt; ++kt) {
        const int buf = kt & 1;
        if (kt + 1 < nt) RET_LOAD(kt + 1);
        if (64 * kt <= 128 * qb + 16 * w + 15) {
            LAS const unsigned char* Kl = lds + buf * 2 * TB; LAS const unsigned char* Vl = Kl + TB;
            f32x4 s[4];
#pragma unroll
            for (int blk = 0; blk < 4; ++blk) { f32x4 acc = {0.f, 0.f, 0.f, 0.f};
#pragma unroll
                for (int ks = 0; ks < 8; ++ks) { const bf16x8 kf = *(LAS const bf16x8*)(Kl + (16 * blk + c) * RS + (ks * 32 + 8 * g) * 2); acc = MFMA16(kf, qf[ks], acc); }
#pragma unroll
                for (int r = 0; r < 4; ++r) { const int d = qpos - (64 * kt + 16 * blk + 4 * g + r); const float dec = __builtin_amdgcn_exp2f((float)d * lg); acc[r] = (d >= 0) ? acc[r] * dec : 0.f; }
                s[blk] = acc; }
#pragma unroll
            for (int kp = 0; kp < 2; ++kp) { const bf16x8 pf = pack_p(s[2 * kp], s[2 * kp + 1]);
#pragma unroll
                for (int db = 0; db < 16; ++db) { const bf16x8 af = vt_frag(Vl + (32 * kp + 4 * g + (c >> 2)) * RS + (16 * db + 4 * (c & 3)) * 2, 16 * RS); o[db] = MFMA16(af, pf, o[db]); }
                __builtin_amdgcn_sched_barrier(0); }
        }
        if (kt + 1 < nt) RET_WRITE(buf ^ 1);
        __syncthreads();
    }
#undef RET_LOAD
#undef RET_WRITE
    float s1 = 0.f;
#pragma unroll
    for (int db = 0; db < 16; ++db) s1 += (o[db][0] + o[db][1]) + (o[db][2] + o[db][3]);
    s1 += __shfl_xor(s1, 16); s1 += __shfl_xor(s1, 32);
    const float mu = s1 * (1.f / 256.f); float s2 = 0.f;
#pragma unroll
    for (int db = 0; db < 16; ++db) { o[db] = o[db] - mu; s2 += (o[db][0] * o[db][0] + o[db][1] * o[db][1]) + (o[db][2] * o[db][2] + o[db][3] * o[db][3]); }
    s2 += __shfl_xor(s2, 16); s2 += __shfl_xor(s2, 32);
    const float rstd = rsqrtf(s2 * (1.f / 256.f) + GN_EPS);
#pragma unroll
    for (int db = 0; db < 16; ++db) { const int col = hoff + 16 * db + 4 * g; const f32x4 gn = *(const f32x4*)(ret_gain + col); const u32x2 gw = *(const u32x2*)(GR + t * 1024 + col);
        const float z0 = bf_lo(gw.x), z1 = bf_hi(gw.x), z2 = bf_lo(gw.y), z3 = bf_hi(gw.y);
        f32x4 v = o[db] * rstd * gn;
        v[0] *= z0 / (1.f + __expf(-z0)); v[1] *= z1 / (1.f + __expf(-z1)); v[2] *= z2 / (1.f + __expf(-z2)); v[3] *= z3 / (1.f + __expf(-z3));
        u32x2 wv; wv.x = pk2(v[0], v[1]); wv.y = pk2(v[2], v[3]); *(u32x2*)(Y + t * DM + 1024 + col) = wv; }
}

__device__ __forceinline__ void xattn_unit(LAS unsigned char* lds, int b, int hx, int qblk, const bf16_t* QX, const bf16_t* KX, const bf16_t* VX, bf16_t* OX) {
    constexpr int KS = 288;
    const int tid = threadIdx.x, lane = tid & 63, c = lane & 15, g = lane >> 4; const int w = __builtin_amdgcn_readfirstlane(tid >> 6);
    LAS unsigned char* Kl = lds; LAS unsigned char* Vl = lds + 256 * KS;
    for (int i = tid; i < 4096; i += 512) { const int key = i >> 4, ch = i & 15; const size_t off = (size_t)(b * MEML + key) * 512 + hx * 128 + ch * 8;
        *(LAS u32x4*)(Kl + key * KS + ch * 16) = *(const u32x4*)(KX + off); *(LAS u32x4*)(Vl + key * KS + ch * 16) = *(const u32x4*)(VX + off); }
    __syncthreads();
    bf16x8 qn[4];
#pragma unroll
    for (int ks = 0; ks < 4; ++ks) qn[ks] = *(const bf16x8*)(QX + ((size_t)b * SEQ + 256 * qblk + 16 * w + c) * 512 + hx * 128 + ks * 32 + 8 * g);
#pragma unroll 1
    for (int pass = 0; pass < 2; ++pass) {
        const size_t t = (size_t)b * SEQ + 256 * qblk + 128 * pass + 16 * w + c;
        bf16x8 qf[4];
#pragma unroll
        for (int ks = 0; ks < 4; ++ks) { qf[ks] = qn[ks]; qn[ks] = *(const bf16x8*)(QX + (t + (pass == 0 ? 128 : 0)) * 512 + hx * 128 + ks * 32 + 8 * g); }
        f32x4 s[16]; float m = -INFINITY;
#pragma unroll
        for (int blk = 0; blk < 16; ++blk) { f32x4 acc = {0.f, 0.f, 0.f, 0.f};
#pragma unroll
            for (int ks = 0; ks < 4; ++ks) { const bf16x8 kf = *(LAS const bf16x8*)(Kl + (16 * blk + c) * KS + (ks * 32 + 8 * g) * 2); acc = MFMA16(kf, qf[ks], acc); }
            m = fmaxf(fmaxf(fmaxf(acc[0], acc[1]), fmaxf(acc[2], acc[3])), m); s[blk] = acc; __builtin_amdgcn_sched_barrier(0); }
        m = fmaxf(m, __shfl_xor(m, 16)); m = fmaxf(m, __shfl_xor(m, 32));
        float l = 0.f;
#pragma unroll
        for (int blk = 0; blk < 16; ++blk)
#pragma unroll
            for (int r = 0; r < 4; ++r) { const float p = __builtin_amdgcn_exp2f(s[blk][r] - m); s[blk][r] = p; l += p; }
        l += __shfl_xor(l, 16); l += __shfl_xor(l, 32);
        f32x4 o[8];
#pragma unroll
        for (int db = 0; db < 8; ++db) o[db] = (f32x4){0.f, 0.f, 0.f, 0.f};
#pragma unroll
        for (int kp = 0; kp < 8; ++kp) { const bf16x8 pf = pack_p(s[2 * kp], s[2 * kp + 1]);
#pragma unroll
            for (int db = 0; db < 8; ++db) { const bf16x8 af = vt_frag(Vl + (32 * kp + 4 * g + (c >> 2)) * KS + (16 * db + 4 * (c & 3)) * 2, 16 * KS); o[db] = MFMA16(af, pf, o[db]); }
            __builtin_amdgcn_sched_barrier(0); }
        const float inv = 1.f / l;
#pragma unroll
        for (int db = 0; db < 8; ++db) { const f32x4 v = o[db] * inv; u32x2 wv; wv.x = pk2(v[0], v[1]); wv.y = pk2(v[2], v[3]); *(u32x2*)(OX + t * 512 + hx * 128 + 16 * db + 4 * g) = wv; }
    }
    __syncthreads();
}

__device__ __forceinline__ int mono_i(float x) { int i = __float_as_int(x); return i ^ ((i >> 31) & 0x7fffffff); }
__device__ __forceinline__ float mono_f(int i) { return __int_as_float(i ^ ((i >> 31) & 0x7fffffff)); }
#define INS16(L, v) do { int _v = (v); _Pragma("unroll") for (int _k = 0; _k < 16; ++_k) { const int _t = max(L[_k], _v); _v = min(L[_k], _v); L[_k] = _t; } } while (0)
#define CE_DESC(x, y) do { const int _h = max((x), (y)), _l = min((x), (y)); (x) = _h; (y) = _l; } while (0)
#define SORT16_DESC(L) do { \
    CE_DESC(L[0], L[1]); \
    CE_DESC(L[2], L[3]); \
    CE_DESC(L[0], L[2]); \
    CE_DESC(L[1], L[3]); \
    CE_DESC(L[1], L[2]); \
    CE_DESC(L[4], L[5]); \
    CE_DESC(L[6], L[7]); \
    CE_DESC(L[4], L[6]); \
    CE_DESC(L[5], L[7]); \
    CE_DESC(L[5], L[6]); \
    CE_DESC(L[0], L[4]); \
    CE_DESC(L[2], L[6]); \
    CE_DESC(L[2], L[4]); \
    CE_DESC(L[1], L[5]); \
    CE_DESC(L[3], L[7]); \
    CE_DESC(L[3], L[5]); \
    CE_DESC(L[1], L[2]); \
    CE_DESC(L[3], L[4]); \
    CE_DESC(L[5], L[6]); \
    CE_DESC(L[8], L[9]); \
    CE_DESC(L[10], L[11]); \
    CE_DESC(L[8], L[10]); \
    CE_DESC(L[9], L[11]); \
    CE_DESC(L[9], L[10]); \
    CE_DESC(L[12], L[13]); \
    CE_DESC(L[14], L[15]); \
    CE_DESC(L[12], L[14]); \
    CE_DESC(L[13], L[15]); \
    CE_DESC(L[13], L[14]); \
    CE_DESC(L[8], L[12]); \
    CE_DESC(L[10], L[14]); \
    CE_DESC(L[10], L[12]); \
    CE_DESC(L[9], L[13]); \
    CE_DESC(L[11], L[15]); \
    CE_DESC(L[11], L[13]); \
    CE_DESC(L[9], L[10]); \
    CE_DESC(L[11], L[12]); \
    CE_DESC(L[13], L[14]); \
    CE_DESC(L[0], L[8]); \
    CE_DESC(L[4], L[12]); \
    CE_DESC(L[4], L[8]); \
    CE_DESC(L[2], L[10]); \
    CE_DESC(L[6], L[14]); \
    CE_DESC(L[6], L[10]); \
    CE_DESC(L[2], L[4]); \
    CE_DESC(L[6], L[8]); \
    CE_DESC(L[10], L[12]); \
    CE_DESC(L[1], L[9]); \
    CE_DESC(L[5], L[13]); \
    CE_DESC(L[5], L[9]); \
    CE_DESC(L[3], L[11]); \
    CE_DESC(L[7], L[15]); \
    CE_DESC(L[7], L[11]); \
    CE_DESC(L[3], L[5]); \
    CE_DESC(L[7], L[9]); \
    CE_DESC(L[11], L[13]); \
    CE_DESC(L[1], L[2]); \
    CE_DESC(L[3], L[4]); \
    CE_DESC(L[5], L[6]); \
    CE_DESC(L[7], L[8]); \
    CE_DESC(L[9], L[10]); \
    CE_DESC(L[11], L[12]); \
    CE_DESC(L[13], L[14]); \
} while (0)

__device__ __forceinline__ void bitonic_fix16(int (&L)[16]) {
    CE_DESC(L[0], L[8]); CE_DESC(L[1], L[9]); CE_DESC(L[2], L[10]); CE_DESC(L[3], L[11]); CE_DESC(L[4], L[12]); CE_DESC(L[5], L[13]); CE_DESC(L[6], L[14]); CE_DESC(L[7], L[15]);
    CE_DESC(L[0], L[4]); CE_DESC(L[1], L[5]); CE_DESC(L[2], L[6]); CE_DESC(L[3], L[7]); CE_DESC(L[8], L[12]); CE_DESC(L[9], L[13]); CE_DESC(L[10], L[14]); CE_DESC(L[11], L[15]);
    CE_DESC(L[0], L[2]); CE_DESC(L[1], L[3]); CE_DESC(L[4], L[6]); CE_DESC(L[5], L[7]); CE_DESC(L[8], L[10]); CE_DESC(L[9], L[11]); CE_DESC(L[12], L[14]); CE_DESC(L[13], L[15]);
    CE_DESC(L[0], L[1]); CE_DESC(L[2], L[3]); CE_DESC(L[4], L[5]); CE_DESC(L[6], L[7]); CE_DESC(L[8], L[9]); CE_DESC(L[10], L[11]); CE_DESC(L[12], L[13]); CE_DESC(L[14], L[15]);
}
__device__ __forceinline__ void merge16(int (&L)[16], int xm) {
    int P[16];
#pragma unroll
    for (int i = 0; i < 16; ++i) P[i] = __shfl_xor(L[i], xm);
#pragma unroll
    for (int i = 0; i < 16; ++i) L[i] = max(L[i], P[15 - i]);
    bitonic_fix16(L);
}
__device__ __forceinline__ void peer_topk_unit(LAS unsigned char* lds, int pm, int h, const bf16_t* PQ, const float* subk, int* EXP, float* GATE) {
    constexpr int KS = 272;
    const int tid = threadIdx.x, lane = tid & 63, c = lane & 15, g = lane >> 4; const int w = __builtin_amdgcn_readfirstlane(tid >> 6);
    const float* sk = subk + (size_t)h * 2 * 128 * 128;
    for (int i = tid; i < 8192; i += 512) { const int row = i >> 5, ch = i & 31; const f32x4 v = *(const f32x4*)(sk + (size_t)row * 128 + ch * 4);
        u32x2 wv; wv.x = pk2(v[0], v[1]); wv.y = pk2(v[2], v[3]); *(LAS u32x2*)(lds + row * KS + ch * 8) = wv; }
    __syncthreads();
#pragma unroll 1
    for (int grp = 0; grp < 2; ++grp) {
        const size_t t = (size_t)pm * 256 + 32 * w + 16 * grp + c;
        int S1[16], S2[16];
        bf16x8 qall[2][4];
#pragma unroll
        for (int p = 0; p < 2; ++p)
#pragma unroll
            for (int ks = 0; ks < 4; ++ks) qall[p][ks] = *(const bf16x8*)(PQ + t * DM + h * 256 + p * 128 + ks * 32 + 8 * g);
#pragma unroll
        for (int p = 0; p < 2; ++p) {
            bf16x8 qf[4];
#pragma unroll
            for (int ks = 0; ks < 4; ++ks) qf[ks] = qall[p][ks];
            int A[16], B[16];
#pragma unroll
            for (int blk = 0; blk < 8; ++blk) { f32x4 acc = {0.f, 0.f, 0.f, 0.f};
#pragma unroll
                for (int ks = 0; ks < 4; ++ks) { const bf16x8 kf = *(LAS const bf16x8*)(lds + (p * 128 + 16 * blk + c) * KS + (ks * 32 + 8 * g) * 2); acc = MFMA16(kf, qf[ks], acc); }
#pragma unroll
                for (int r = 0; r < 4; ++r) { const int idx = 16 * blk + 4 * g + r; const int key = (mono_i(acc[r]) & ~127) | (127 - idx); if (blk < 4) A[4 * blk + r] = key; else B[4 * (blk - 4) + r] = key; }
                __builtin_amdgcn_sched_barrier(0); }
            SORT16_DESC(A); SORT16_DESC(B);
#pragma unroll
            for (int i = 0; i < 16; ++i) A[i] = max(A[i], B[15 - i]);
            bitonic_fix16(A);
            merge16(A, 16); merge16(A, 32);
#pragma unroll
            for (int k = 0; k < 16; ++k) { if (p == 0) S1[k] = A[k]; else S2[k] = A[k]; }
        }
        float s1v[16], s2v[16];
#pragma unroll
        for (int k = 0; k < 16; ++k) { s1v[k] = mono_f(S1[k] & ~127); s2v[k] = mono_f(S2[k] & ~127); }
        int Mx[16];
#pragma unroll
        for (int k = 0; k < 16; ++k) Mx[k] = (int)0x80000000;
#define STAIR4(a0, b0, a1, b1, a2, b2, a3, b3) do { const float _c0 = s1v[a0] + s2v[b0], _c1 = s1v[a1] + s2v[b1], _c2 = s1v[a2] + s2v[b2], _c3 = s1v[a3] + s2v[b3]; \
        const float _m = (g == 0) ? _c0 : (g == 1) ? _c1 : (g == 2) ? _c2 : _c3; const int _cd = (g == 0) ? (255 - (16 * a0 + b0)) : (g == 1) ? (255 - (16 * a1 + b1)) : (g == 2) ? (255 - (16 * a2 + b2)) : (255 - (16 * a3 + b3)); \
        INS16(Mx, (mono_i(_m) & ~255) | _cd); } while (0)
#define STAIR2(a0, b0, a1, b1) do { const float _c0 = s1v[a0] + s2v[b0], _c1 = s1v[a1] + s2v[b1]; const float _m = (g == 0) ? _c0 : _c1; const int _cd = (g == 0) ? (255 - (16 * a0 + b0)) : (255 - (16 * a1 + b1)); \
        const int _key = (mono_i(_m) & ~255) | _cd; INS16(Mx, (g < 2) ? _key : (int)0x80000000); } while (0)
        STAIR4(0, 0, 0, 1, 0, 2, 0, 3);
        STAIR4(0, 4, 0, 5, 0, 6, 0, 7);
        STAIR4(0, 8, 0, 9, 0, 10, 0, 11);
        STAIR4(0, 12, 0, 13, 0, 14, 0, 15);
        STAIR4(1, 0, 1, 1, 1, 2, 1, 3);
        STAIR4(1, 4, 1, 5, 1, 6, 1, 7);
        STAIR4(2, 0, 2, 1, 2, 2, 2, 3);
        STAIR4(2, 4, 3, 0, 3, 1, 3, 2);
        STAIR4(3, 3, 4, 0, 4, 1, 4, 2);
        STAIR4(5, 0, 5, 1, 6, 0, 6, 1);
        STAIR4(7, 0, 7, 1, 8, 0, 9, 0);
        STAIR4(10, 0, 11, 0, 12, 0, 13, 0);
        STAIR2(14, 0, 15, 0);
#undef STAIR4
#undef STAIR2
        merge16(Mx, 16); merge16(Mx, 32);
        const float top = mono_f(Mx[0] & ~255); float wg[4]; int ex[4]; float wsum = 0.f;
#pragma unroll
        for (int i = 0; i < 4; ++i) { const int key = (g == 0) ? Mx[i] : (g == 1) ? Mx[4 + i] : (g == 2) ? Mx[8 + i] : Mx[12 + i];
            wg[i] = __expf(mono_f(key & ~255) - top); wsum += wg[i];
            const int ab = 255 - (key & 255), a = ab >> 4, bb = ab & 15; int e1 = 0, e2 = 0;
#pragma unroll
            for (int k = 0; k < 16; ++k) { e1 = (a == k) ? (127 - (S1[k] & 127)) : e1; e2 = (bb == k) ? (127 - (S2[k] & 127)) : e2; }
            ex[i] = e1 * 128 + e2; }
        wsum += __shfl_xor(wsum, 16); wsum += __shfl_xor(wsum, 32);
        const float inv = 1.f / wsum;
        *(int4*)(EXP + t * 128 + h * 16 + 4 * g) = make_int4(ex[0], ex[1], ex[2], ex[3]);
        *(f32x4*)(GATE + t * 128 + h * 16 + 4 * g) = (f32x4){wg[0] * inv, wg[1] * inv, wg[2] * inv, wg[3] * inv};
    }
    __syncthreads();
}
typedef __bf16 v32bf16 __attribute__((ext_vector_type(32)));
typedef unsigned v6u32 __attribute__((ext_vector_type(6)));
constexpr int ROWB = 1536;
__device__ __forceinline__ float fdot2bf(bf16x2_t a, bf16x2_t b, float c) { return __builtin_amdgcn_fdot2_f32_bf16(a, b, c, false); }
__device__ __forceinline__ void row_to_fp6(const float* src, const float* colgain, unsigned char* dst, float* inv, int lane) {
    f32x4 v[8]; float am = 0.f;
#pragma unroll
    for (int j = 0; j < 8; ++j) { v[j] = *(const f32x4*)(src + 32 * lane + 4 * j); if (colgain) v[j] = v[j] * *(const f32x4*)(colgain + 32 * lane + 4 * j);
        am = fmaxf(am, fmaxf(fmaxf(fabsf(v[j][0]), fabsf(v[j][1])), fmaxf(fabsf(v[j][2]), fabsf(v[j][3])))); }
#pragma unroll
    for (int o = 1; o < 64; o <<= 1) am = fmaxf(am, __shfl_xor(am, o));
    float S = 1.f;
    if (am > 1e-30f) S = __uint_as_float(__float_as_uint(7.5f / am) & 0x7f800000u);
    unsigned pk[6] = {0u, 0u, 0u, 0u, 0u, 0u};
#pragma unroll
    for (int j = 0; j < 8; ++j)
#pragma unroll
        for (int i = 0; i < 4; ++i) { const float t = v[j][i] * S, a = fabsf(t);
            const float cf = (a < 2.f) ? rintf(a * 8.f) : (a < 4.f) ? 16.f + rintf((a - 2.f) * 4.f) : 24.f + rintf((a - 4.f) * 2.f);
            unsigned cd = (unsigned)fminf(cf, 31.f); if (t < 0.f) cd |= 32u;
            const int e = 4 * j + i, bit = 6 * e, dw = bit >> 5, sh = bit & 31;
            pk[dw] |= cd << sh; if (sh > 26) pk[dw + 1] |= cd >> (32 - sh); }
    *(u32x4*)(dst + 16 * lane) = (u32x4){pk[0], pk[1], pk[2], pk[3]}; *(u32x2*)(dst + 1024 + 8 * lane) = (u32x2){pk[4], pk[5]};
    if (lane == 0) *inv = 1.f / S;
}
__device__ __forceinline__ v32bf16 sw_unpack6(v6u32 s) {
    v32bf16 r;
#pragma unroll
    for (int e = 0; e < 32; ++e) { const int bit = 6 * e, dw = bit >> 5, sh = bit & 31; unsigned cd = s[dw] >> sh; if (sh > 26) cd |= s[dw + 1] << (32 - sh); cd &= 63u;
        const unsigned m = cd & 31u; float a = (m < 16u) ? (float)m * 0.125f : (m < 24u) ? 2.f + (float)(m - 16u) * 0.25f : 4.f + (float)(m - 24u) * 0.5f; if (cd & 32u) a = -a; r[e] = (__bf16)a; }
    return r;
}
constexpr int RING = 8;
typedef unsigned v16u32 __attribute__((ext_vector_type(16)));
__device__ __forceinline__ bf16x2_t as_pair(unsigned w) { return __builtin_bit_cast(bf16x2_t, w); }
#define PAIR(r, p) as_pair((r)[(p)])
__device__ __forceinline__ void peer_gather_token(LAS float* cw, LAS int* ew, size_t t, const float* X, const float* g_ffn, const float* g_fin,
                                                  const unsigned char* UB, const unsigned char* VB, const float* SU, const float* SV, const int* EXP, const float* GATE, float* OUT, int lane, LAS f32x4* xstash) {
    f32x4 xv[8]; float ss = 0.f;
    const float* xr = X + t * DM + 32 * lane;
#pragma unroll
    for (int j = 0; j < 8; ++j) xv[j] = *(const f32x4*)(xr + 4 * j);
#pragma unroll
    for (int j = 0; j < 8; ++j) ss += (xv[j][0] * xv[j][0] + xv[j][1] * xv[j][1]) + (xv[j][2] * xv[j][2] + xv[j][3] * xv[j][3]);
    ss = wave_sum(ss);
    const float rs = rsqrtf(ss * (1.f / DM) + EPS);
    bf16x2_t xb[16];
#pragma unroll
    for (int j = 0; j < 8; ++j) { const f32x4 a = xv[j] * rs * *(const f32x4*)(g_ffn + 32 * lane + 4 * j); xb[2 * j] = __builtin_bit_cast(bf16x2_t, pk2(a[0], a[1])); xb[2 * j + 1] = __builtin_bit_cast(bf16x2_t, pk2(a[2], a[3])); }
    {
        int k0 = (EXP[t * 128 + lane] << 7) | lane, k1 = (EXP[t * 128 + 64 + lane] << 7) | (64 + lane);
#pragma unroll
        for (int k = 2; k <= 128; k <<= 1)
#pragma unroll
            for (int j = k >> 1; j > 0; j >>= 1) {
                if (j == 64) { const int a = min(k0, k1), c = max(k0, k1); k0 = a; k1 = c; }
                else { const int p0 = __shfl_xor(k0, j), p1 = __shfl_xor(k1, j); const bool lower = (lane & j) == 0;
                       const bool asc0 = (k >= 64) ? true : ((lane & k) == 0), asc1 = (k == 128) ? true : ((k == 64) ? false : ((lane & k) == 0));
                       k0 = (lower == asc0) ? min(k0, p0) : max(k0, p0); k1 = (lower == asc1) ? min(k1, p1) : max(k1, p1); }
            }
        ew[lane] = k0; ew[lane + 64] = k1; }
#pragma unroll
    for (int j = 0; j < 8; ++j) xstash[j * 64 + lane] = xv[j];
    asm volatile("s_waitcnt lgkmcnt(0)" ::: "memory");
    u32x4 ra[RING]; u32x2 rc[RING];
#define ROWLOAD(BASE, slot, k) do { const int _e = __builtin_amdgcn_readfirstlane(ew[(k)]) >> 7; const unsigned char* _rp = (BASE) + (size_t)_e * ROWB; \
        ra[slot] = *(const u32x4*)(_rp + 16 * lane); rc[slot] = *(const u32x2*)(_rp + 1024 + 8 * lane); } while (0)
#ifdef PROBE_SW_UNPACK
#define ROWCVT(slot) sw_unpack6((v6u32){ra[slot].x, ra[slot].y, ra[slot].z, ra[slot].w, rc[slot].x, rc[slot].y})
#else
#define ROWCVT(slot) __builtin_amdgcn_cvt_scalef32_pk32_bf16_fp6((v6u32){ra[slot].x, ra[slot].y, ra[slot].z, ra[slot].w, rc[slot].x, rc[slot].y}, 1.0f)
#endif
#pragma unroll
    for (int j = 0; j < RING; ++j) ROWLOAD(UB, j, j);
    const int eloc = ((lane >> 5) & 1) * 8 + ((lane >> 4) & 1) * 4 + ((lane >> 3) & 1) * 2 + ((lane >> 2) & 1);
    for (int b = 0; b < 8; ++b) {
        float part[16];
#pragma unroll
        for (int j = 0; j < 16; ++j) { const int slot = j & (RING - 1); const v16u32 r = __builtin_bit_cast(v16u32, ROWCVT(slot)); float a0 = 0.f, a1 = 0.f;
#pragma unroll
            for (int q = 0; q < 8; ++q) { a0 = fdot2bf(PAIR(r, 2 * q), xb[2 * q], a0); a1 = fdot2bf(PAIR(r, 2 * q + 1), xb[2 * q + 1], a1); }
            part[j] = a0 + a1;
            { const int sn = 16 * b + j + RING; const unsigned char* nb = (sn < 128) ? UB : VB; ROWLOAD(nb, slot, sn & 127); } }
        float q8[8], q4[4], q2[2], q1;
#pragma unroll
        for (int i = 0; i < 8; ++i) { const bool up = (lane & 32) != 0; const float snd = up ? part[i] : part[i + 8], kp = up ? part[i + 8] : part[i]; q8[i] = kp + __shfl_xor(snd, 32); }
#pragma unroll
        for (int i = 0; i < 4; ++i) { const bool up = (lane & 16) != 0; const float snd = up ? q8[i] : q8[i + 4], kp = up ? q8[i + 4] : q8[i]; q4[i] = kp + __shfl_xor(snd, 16); }
#pragma unroll
        for (int i = 0; i < 2; ++i) { const bool up = (lane & 8) != 0; const float snd = up ? q4[i] : q4[i + 2], kp = up ? q4[i + 2] : q4[i]; q2[i] = kp + __shfl_xor(snd, 8); }
        { const bool up = (lane & 4) != 0; const float snd = up ? q2[0] : q2[1], kp = up ? q2[1] : q2[0]; q1 = kp + __shfl_xor(snd, 4); }
        q1 += __shfl_xor(q1, 1); q1 += __shfl_xor(q1, 2);
        if ((lane & 3) == 0) { const int k = 16 * b + eloc; const int key = ew[k], e = key >> 7; const float av = q1 * SU[e]; const float gl = 0.5f * av * (1.f + erff(av * 0.70710678118654752f)); cw[k] = gl * GATE[t * 128 + (key & 127)] * SV[e]; }
    }
    asm volatile("s_waitcnt lgkmcnt(0)" ::: "memory");
    float acc[32];
#pragma unroll
    for (int i = 0; i < 32; ++i) acc[i] = 0.f;
    for (int k0 = 0; k0 < 128; k0 += RING) {
#pragma unroll
        for (int j = 0; j < RING; ++j) { const float cv = cw[k0 + j]; const unsigned clo_u = pk2(cv, 0.f); const bf16x2_t clo = __builtin_bit_cast(bf16x2_t, clo_u), chi = __builtin_bit_cast(bf16x2_t, clo_u << 16);
            const v16u32 r = __builtin_bit_cast(v16u32, ROWCVT(j));
#pragma unroll
            for (int q = 0; q < 16; ++q) { acc[2 * q] = fdot2bf(PAIR(r, q), clo, acc[2 * q]); acc[2 * q + 1] = fdot2bf(PAIR(r, q), chi, acc[2 * q + 1]); }
            const int kn = min(k0 + j + RING, 127); ROWLOAD(VB, j, kn); }
    }
#undef ROWLOAD
#undef ROWCVT
#ifdef PROBE_NO_PEER
#pragma unroll
    for (int i = 0; i < 32; ++i) acc[i] = 0.f;
#endif
    float s3 = 0.f;
#pragma unroll
    for (int j = 0; j < 8; ++j) xv[j] = xstash[j * 64 + lane];
#pragma unroll
    for (int j = 0; j < 8; ++j)
#pragma unroll
        for (int i = 0; i < 4; ++i) { xv[j][i] += acc[4 * j + i]; s3 += xv[j][i] * xv[j][i]; }
    s3 = wave_sum(s3);
    const float r3 = rsqrtf(s3 * (1.f / DM) + EPS);
    float* orow = OUT + t * DM + 32 * lane;
#pragma unroll
    for (int j = 0; j < 8; ++j) { const f32x4 g0 = *(const f32x4*)(g_fin + 32 * lane + 4 * j); *(f32x4*)(orow + 4 * j) = xv[j] * r3 * g0; }
}

constexpr unsigned NF1 = 896;
__device__ __forceinline__ void fp8_chunk(int chunk, int wave, int lane, const float* peer_u, const float* peer_v, const float* g_ffn, unsigned char* UB, unsigned char* VB, float* SU, float* SV) {
#pragma unroll 1
    for (int r = 0; r < 2; ++r) { const int row = chunk * 16 + wave * 2 + r;
        if (row < 16384) row_to_fp6(peer_u + (size_t)row * DM, nullptr, UB + (size_t)row * ROWB, SU + row, lane);
        else row_to_fp6(peer_v + (size_t)(row - 16384) * DM, nullptr, VB + (size_t)(row - 16384) * ROWB, SV + (row - 16384), lane); }
}
constexpr int NWAVES = 8, LDS_BYTES = 163840, MISC_OFF = 159744;
constexpr int N_PHASES = 10;
struct Args { const void* in[21]; float* out; unsigned char* ws; int ph_lo, ph_hi; float inv_freq[128]; };

#define IN_x ((const float*)((const float*)args.in[0]))
#define IN_mem ((const float*)((const float*)args.in[1]))
#define IN_positions ((const int*)((const int*)args.in[2]))
#define IN_g_mix ((const float*)((const float*)args.in[3]))
#define IN_w_in ((const float*)((const float*)args.in[4]))
#define IN_sinks ((const float*)((const float*)args.in[5]))
#define IN_att_gain ((const float*)((const float*)args.in[6]))
#define IN_ret_gain ((const float*)((const float*)args.in[7]))
#define IN_w_out ((const float*)((const float*)args.in[8]))
#define IN_g_cross ((const float*)((const float*)args.in[9]))
#define IN_g_mem ((const float*)((const float*)args.in[10]))
#define IN_w_xq ((const float*)((const float*)args.in[11]))
#define IN_w_xk ((const float*)((const float*)args.in[12]))
#define IN_w_xv ((const float*)((const float*)args.in[13]))
#define IN_w_xo ((const float*)((const float*)args.in[14]))
#define IN_g_ffn ((const float*)((const float*)args.in[15]))
#define IN_w_pq ((const float*)((const float*)args.in[16]))
#define IN_subk ((const float*)((const float*)args.in[17]))
#define IN_peer_u ((const float*)((const float*)args.in[18]))
#define IN_peer_v ((const float*)((const float*)args.in[19]))
#define IN_g_fin ((const float*)((const float*)args.in[20]))
#define IN_out ((float*)(args.out))
#define WIN ((bf16_t*)((bf16_t*)(ws + WS_WIN)))
#define WOUT ((bf16_t*)((bf16_t*)(ws + WS_WOUT)))
#define WXQ ((bf16_t*)((bf16_t*)(ws + WS_WXQ)))
#define WXKV ((bf16_t*)((bf16_t*)(ws + WS_WXKV)))
#define WXO ((bf16_t*)((bf16_t*)(ws + WS_WXO)))
#define WPQ ((bf16_t*)((bf16_t*)(ws + WS_WPQ)))
#define XB ((bf16_t*)((bf16_t*)(ws + WS_XB)))
#define MEMB ((bf16_t*)((bf16_t*)(ws + WS_MEMB)))
#define COSA ((float*)((float*)(ws + WS_COSA)))
#define SINA ((float*)((float*)(ws + WS_SINA)))
#define COSR ((float*)((float*)(ws + WS_COSR)))
#define SINR ((float*)((float*)(ws + WS_SINR)))
#define SS0 ((float*)((float*)(ws + WS_SS0)))
#define SS1 ((float*)((float*)(ws + WS_SS1)))
#define SS2 ((float*)((float*)(ws + WS_SS2)))
#define SSM ((float*)((float*)(ws + WS_SSM)))
#define KX ((bf16_t*)((bf16_t*)(ws + WS_KX)))
#define VX ((bf16_t*)((bf16_t*)(ws + WS_VX)))
#define QX ((bf16_t*)((bf16_t*)(ws + WS_QX)))
#define OX ((bf16_t*)((bf16_t*)(ws + WS_OX)))
#define EXPI ((int*)((int*)(ws + WS_EXP)))
#define GATE ((float*)((float*)(ws + WS_GATE)))
#define Y ((bf16_t*)((bf16_t*)(ws + WS_Y)))
#define PQ ((bf16_t*)((bf16_t*)(ws + WS_Y)))
#define QA ((bf16_t*)((bf16_t*)(ws + WS_QA)))
#define KA ((bf16_t*)((bf16_t*)(ws + WS_KA)))
#define VA ((bf16_t*)((bf16_t*)(ws + WS_VA)))
#define QR ((bf16_t*)((bf16_t*)(ws + WS_QR)))
#define KR ((bf16_t*)((bf16_t*)(ws + WS_KR)))
#define VR ((bf16_t*)((bf16_t*)(ws + WS_VR)))
#define GR ((bf16_t*)((bf16_t*)(ws + WS_GR)))
#define UB ((unsigned char*)(ws + WS_UB))
#define VB ((unsigned char*)(ws + WS_VB))
#define SU ((float*)((float*)(ws + WS_SU)))
#define SV ((float*)((float*)(ws + WS_SV)))
__global__ void __launch_bounds__(NWAVES * 64, 2) fwd_kernel(Args args) {
    extern __shared__ __attribute__((aligned(16))) unsigned char lds_raw[];
    LAS unsigned char* lds = (LAS unsigned char*)lds_raw;
    const int tid = threadIdx.x, lane = tid & 63; const int wave = __builtin_amdgcn_readfirstlane(tid >> 6);
    const int G = gridDim.x; const int bx = blockIdx.x; const int vcu = (G % 8 == 0) ? (bx % 8) * (G / 8) + bx / 8 : bx;
    unsigned char* ws = args.ws;
    float* const out_base = args.out;
    for (int u = tid; u < (LDS_BYTES - MISC_OFF) / 4; u += NWAVES * 64) ((LAS unsigned*)(lds + MISC_OFF))[u] = 0u;
    __syncthreads();
    const int lo = args.ph_lo, hi = args.ph_hi;
    const bool use_bar = (hi - lo) > 1;
    XcdBarrier bar; bar.bar = (unsigned*)(ws + WS_CTL) + 1024; bar.x = 0; bar.st = nullptr;
    if (use_bar) bar = xcd_barrier_post((unsigned*)(ws + WS_CTL) + 1024, (volatile LAS unsigned*)(lds + MISC_OFF) + 8);
#ifdef ONLY_PHASE
#define PHASE_ON(k) ((k) == ONLY_PHASE)
#else
#define PHASE_ON(k) true
#endif
#define IN(k) (lo <= (k) && (k) < hi)
#ifdef REPEAT_PHASE
#define REP(k) for (int _rep = 0; _rep < (((k) == REPEAT_PHASE) ? 2 : 1); ++_rep)
#else
#define REP(k)
#endif
#define SEAM(k) do { if (IN(k) && IN((k) + 1)) xcd_barrier(bar); } while (0)
    const int gw = vcu * NWAVES + wave, NGW = G * NWAVES;

    REP(0) if (PHASE_ON(0) && IN(0)) {
        LAS float* scr = (LAS float*)(lds + wave * 8448);
        constexpr int I_IN = 32 * (IN_COLS / 32), I_XQ = 32 * 16;
        constexpr int NITEMS = I_IN + 2 * I_XQ;
        for (int it = gw; it < NITEMS; it += NGW) {
            int r = it;
            if (r < I_IN) { p0_transpose_item<true>(IN_w_in, IN_g_mix, DM, IN_COLS, WIN, 0, scr, r, lane); continue; } r -= I_IN;
            if (r < I_XQ) { p0_transpose_item<false>(IN_w_xk, IN_g_mem, DM, 512, WXKV, 0, scr, r, lane); continue; } r -= I_XQ;
            p0_transpose_item<false>(IN_w_xv, IN_g_mem, DM, 512, WXKV, 512, scr, r, lane);
        }
        for (int m = gw; m < T_TOK; m += 2 * NGW) row2_to_bf16(IN_x + (size_t)m * DM, XB + (size_t)m * DM, SS0 + m, (size_t)NGW, lane);
        for (int m = gw; m < MT; m += NGW) row_to_bf16(IN_mem + (size_t)m * DM, MEMB + (size_t)m * DM, SSM + m, lane);
        const int gt = vcu * (NWAVES * 64) + tid, NGT = G * NWAVES * 64;
        for (int i = gt; i < T_TOK * 128; i += NGT) { const int tok = i >> 7, f = i & 127; const float ang = (float)IN_positions[tok] * args.inv_freq[f]; float cc, sn; sincos_red(ang, cc, sn);
            COSR[i] = cc; SINR[i] = sn; }
        for (int i = gt; i < T_TOK * 32; i += NGT) { const int tok = i >> 5, f = i & 31; const float ang = (float)IN_positions[tok] * args.inv_freq[4 * f]; float cc, sn; sincos_red(ang, cc, sn);
            COSA[i] = cc; SINA[i] = sn; }
        for (int i = gt; i < T_TOK; i += NGT) { SS1[i] = 0.f; SS2[i] = 0.f; }
        __syncthreads();
    }
    SEAM(0);
    REP(1) if (PHASE_ON(1) && IN(1)) {
        pg8::Sched S; S.A = (const char*)XB; S.B = (const char*)WIN; S.nM = T_TOK / 256; S.nN = IN_COLS / 256; S.nwg = S.nM * S.nN;
        S.A2 = (const char*)MEMB; S.B2 = (const char*)WXKV; S.nM2 = MT / 256; S.nwg2 = (MT / 256) * 4; S.G = G; S.c = bx; S.WGM = WGM_P1; S.tstep = (size_t)256 * DM * 2;
        EpiP1 E{ws};
        pg8::gemm_phase<EpiP1>(lds, DM, S, E);
        unsigned* qctr = (unsigned*)(ws + WS_CTL) + 8192 + 64; volatile LAS unsigned* qw = (volatile LAS unsigned*)(lds + MISC_OFF) + 16;
        LAS float* scr = (LAS float*)(lds + wave * 8448);
        for (;;) {
            if (tid == 0) qw[0] = atomicAdd(qctr, 1u);
            __syncthreads(); const unsigned chunk = qw[0]; __syncthreads();
            if (chunk >= 640u + NF1) break;
            if (chunk < 640u) { int r = (int)chunk * 8 + wave;
                if (r < 2048) p0_transpose_item<false>(IN_w_out, nullptr, DM, DM, WOUT, 0, scr, r, lane);
                else if ((r -= 2048) < 512) p0_transpose_item<false>(IN_w_xq, IN_g_cross, DM, 512, WXQ, 0, scr, r, lane);
                else if ((r -= 512) < 512) p0_transpose_item<false>(IN_w_xo, nullptr, 512, DM, WXO, 0, scr, r, lane);
                else p0_transpose_item<false>(IN_w_pq, IN_g_ffn, DM, DM, WPQ, 0, scr, r - 512, lane);
            } else fp8_chunk((int)chunk - 640, wave, lane, IN_peer_u, IN_peer_v, IN_g_ffn, UB, VB, SU, SV);
        }
    }
    SEAM(1);
    REP(2) if (PHASE_ON(2) && IN(2)) {
#ifdef PROBE_RET_X
        for (int rr = 0; rr < PROBE_RET_X; ++rr)
#endif
        for (int u = vcu; u < 256; u += G) { const int bh = u >> 3, s = u & 7; ret_unit(lds, bh >> 2, bh & 3, s, QR, KR, VR, GR, IN_ret_gain, Y); ret_unit(lds, bh >> 2, bh & 3, 15 - s, QR, KR, VR, GR, IN_ret_gain, Y); }
#ifdef PROBE_SWA_X
        for (int rr = 0; rr < PROBE_SWA_X; ++rr)
#endif
        for (int u = vcu; u < 256; u += G) swa_unit(lds, u >> 5, (u >> 1) & 15, u & 1, QA, KA, VA, IN_sinks, IN_att_gain, Y);
    }
    SEAM(2);
    if (PHASE_ON(3) && IN(3)) {
        pg8::Sched S; S.A = (const char*)Y; S.B = (const char*)WOUT; S.WGM = WGM_P3; S.nM = T_TOK / 256; S.nN = DM / 256; S.nwg = S.nM * S.nN; S.A2 = nullptr; S.B2 = nullptr; S.nM2 = 1; S.nwg2 = 0; S.G = G; S.c = bx; S.tstep = (size_t)256 * DM * 2;
        EpiRes1 E{IN_x, XB, SS1};
        pg8::gemm_phase<EpiRes1, false>(lds, DM, S, E);
    }
    SEAM(3);
    REP(4) if (PHASE_ON(4) && IN(4)) {
        pg8::Sched S; S.A = (const char*)XB; S.B = (const char*)WXQ; S.WGM = WGM_P4; S.nM = T_TOK / 256; S.nN = 2; S.nwg = S.nM * S.nN; S.A2 = nullptr; S.B2 = nullptr; S.nM2 = 1; S.nwg2 = 0; S.G = G; S.c = bx; S.tstep = (size_t)256 * DM * 2;
        EpiScale E{QX, 512, SS1, C3Q};
        pg8::gemm_phase<EpiScale>(lds, DM, S, E);
        unsigned* qctr = (unsigned*)(ws + WS_CTL) + 8192; volatile LAS unsigned* qw = (volatile LAS unsigned*)(lds + MISC_OFF) + 16;
        for (;;) {
            if (tid == 0) qw[0] = atomicAdd(qctr, 1u);
            __syncthreads(); const unsigned chunk = qw[0] + NF1; __syncthreads();
            if (chunk >= 2048u) break;
            fp8_chunk((int)chunk, wave, lane, IN_peer_u, IN_peer_v, IN_g_ffn, UB, VB, SU, SV);
        }
    }
    SEAM(4);
    REP(5) if (PHASE_ON(5) && IN(5)) { for (int u = vcu; u < 256; u += G) xattn_unit(lds, u >> 5, (u >> 3) & 3, u & 7, QX, KX, VX, OX); }
    SEAM(5);
    if (PHASE_ON(6) && IN(6)) {
        pg8::Sched S; S.A = (const char*)OX; S.B = (const char*)WXO; S.WGM = WGM_P6; S.nM = T_TOK / 256; S.nN = DM / 256; S.nwg = S.nM * S.nN; S.A2 = nullptr; S.B2 = nullptr; S.nM2 = 1; S.nwg2 = 0; S.G = G; S.c = bx; S.tstep = (size_t)256 * 512 * 2;
        EpiRes2 E{IN_out, XB, SS2};
        pg8::gemm_phase<EpiRes2, false>(lds, 512, S, E);
    }
    SEAM(6);
    REP(7) if (PHASE_ON(7) && IN(7)) {
        pg8::Sched S; S.A = (const char*)XB; S.B = (const char*)WPQ; S.WGM = WGM_P7; S.nM = T_TOK / 256; S.nN = DM / 256; S.nwg = S.nM * S.nN; S.A2 = nullptr; S.B2 = nullptr; S.nM2 = 1; S.nwg2 = 0; S.G = G; S.c = bx; S.tstep = (size_t)256 * DM * 2;
        EpiScale E{PQ, DM, SS2, 1.f};
        pg8::gemm_phase<EpiScale>(lds, DM, S, E);
        asm volatile("s_waitcnt vmcnt(0)" ::: "memory"); __syncthreads();
        { pg8::Unit u; for (int i = 0; S.next(i, u); ++i) peer_topk_unit(lds, u.pm, u.pn, PQ, IN_subk, EXPI, GATE); }
    }
    SEAM(7);
    if (PHASE_ON(9) && IN(9)) {
        LAS float* cw = (LAS float*)(lds + wave * 1024); LAS int* ew = (LAS int*)(lds + wave * 1024 + 512);
        LAS f32x4* xstash = (LAS f32x4*)(lds + 8192 + wave * 8192);
        for (int t = gw; t < T_TOK; t += NGW) peer_gather_token(cw, ew, (size_t)t, IN_out, IN_g_ffn, IN_g_fin, UB, VB, SU, SV, EXPI, GATE, IN_out, lane, xstash);
    }
#undef IN
#undef SEAM
}

extern "C" void kernel_launch(void* const* d_in, const int* in_sizes, int n_in, void* d_out, int out_size, void* d_ws, size_t ws_size, hipStream_t stream) {
    static int grid = 0;
    if (grid == 0) {
        if (n_in != 21 || out_size != T_TOK * DM || ws_size < WS_END) { fprintf(stderr, "kernel_launch: unexpected problem (n_in %d out %d ws %zu)\n", n_in, out_size, ws_size); grid = -1; return; }
        int dev = 0, cus = 0;
        if (hipGetDevice(&dev) != hipSuccess || hipDeviceGetAttribute(&cus, hipDeviceAttributeMultiprocessorCount, dev) != hipSuccess) { grid = -1; return; }
        if (hipFuncSetAttribute((const void*)fwd_kernel, hipFuncAttributeMaxDynamicSharedMemorySize, LDS_BYTES) != hipSuccess) { fprintf(stderr, "kernel_launch: hipFuncSetAttribute failed\n"); grid = -1; return; }
        (void)hipGetLastError();
        grid = cus;
    }
    if (grid < 0) return;
    (void)hipMemsetAsync((char*)d_ws + WS_CTL, 0, CTL_ZERO_BYTES, stream);
    Args a{};
    for (int i = 0; i < 21; ++i) a.in[i] = d_in[i];
    a.out = (float*)d_out; a.ws = (unsigned char*)d_ws;
    for (int i = 0; i < 128; ++i) a.inv_freq[i] = (float)pow(10000.0, -(double)(2 * i) / 256.0);
#ifdef MK_PER_PHASE
    for (int p = 0; p < N_PHASES; ++p) { a.ph_lo = p; a.ph_hi = p + 1;
#ifdef REPEAT_LAUNCH
        if (p == REPEAT_LAUNCH) for (int r = 0; r < 4; ++r) hipLaunchKernelGGL(fwd_kernel, dim3(grid), dim3(NWAVES * 64), LDS_BYTES, stream, a);
#endif
        hipLaunchKernelGGL(fwd_kernel, dim3(grid), dim3(NWAVES * 64), LDS_BYTES, stream, a); }
#else
    a.ph_lo = 0; a.ph_hi = N_PHASES; hipLaunchKernelGGL(fwd_kernel, dim3(grid), dim3(NWAVES * 64), LDS_BYTES, stream, a);
#endif
}
```

```cpp
#include <hip/hip_runtime.h>
#include <cstdio>
#include <cstdint>
#include <cmath>
#ifndef WGM_P1
#define WGM_P1 4
#endif
#ifndef WGM_P3
#define WGM_P3 4
#endif
#ifndef WGM_P4
#define WGM_P4 4
#endif
#ifndef WGM_P6
#define WGM_P6 4
#endif
#ifndef WGM_P7
#define WGM_P7 4
#endif
namespace pg8 {
#define PG8_LAS __attribute__((address_space(3)))
typedef unsigned short bf16_t;
typedef short bf16x8 __attribute__((ext_vector_type(8)));
typedef float f32x4 __attribute__((ext_vector_type(4)));
typedef unsigned u32x4 __attribute__((ext_vector_type(4)));
typedef unsigned u32x2 __attribute__((ext_vector_type(2)));
constexpr int BM = 256, BK = 64, HALF = 128, HTB = HALF * BK * 2  , STAGE_BYTES = 8 * HTB, NXCD = 8;

__host__ __device__ __forceinline__ int lds_byte(int r, int c) { const int st = (r >> 4) * 2 + (c >> 5), rr = r & 15, cc = c & 31, ob = rr * 64 + cc * 2; return st * 1024 + (ob ^ (((ob >> 9) & 1) << 5)); }
__host__ __device__ __forceinline__ void stage_rc(int b, int& R, int& C) { const int st = b / 1024, sb = b % 1024, swz = sb ^ (((sb >> 9) & 1) << 5); R = (st >> 1) * 16 + swz / 64; C = (st & 1) * 32 + (swz % 64) / 2; }
__host__ __device__ __forceinline__ int perm32(int rho) { const int n = rho >> 4, i = rho & 15; return 8 * (i >> 2) + 4 * n + (i & 3); }

struct Unit { int pm, pn, kind; const char* a; const char* b; };

struct Sched {
    const char *A, *B, *A2, *B2; int nM, nN, nwg, nM2, nwg2, G, c, WGM; size_t tstep;
    __device__ __forceinline__ bool next(int i, Unit& u) const {
        const long L = (long)i * G + c;
        if (L < nwg) {
            int wgid = (int)L; { const int q = nwg / NXCD, r = nwg % NXCD, xcd = wgid % NXCD, off = wgid / NXCD; wgid = (xcd < r ? xcd * (q + 1) : r * (q + 1) + (xcd - r) * q) + off; }
            const int nig = WGM * nN, gid = wgid / nig, fm = gid * WGM, gsz = (nM - fm) < WGM ? (nM - fm) : WGM;
            u.pm = fm + ((wgid % nig) % gsz); u.pn = (wgid % nig) / gsz; u.kind = 0; u.a = A + (size_t)u.pm * tstep; u.b = B + (size_t)u.pn * tstep; return true;
        }
        const long L2 = L - nwg; if (L2 >= nwg2) return false;
        u.pm = (int)(L2 % nM2); u.pn = (int)(L2 / nM2); u.kind = 1; u.a = A2 + (size_t)u.pm * tstep; u.b = B2 + (size_t)u.pn * tstep; return true;
    }
};

__device__ __forceinline__ unsigned cvt_pk_bf16(float lo, float hi) { unsigned r; asm volatile("v_cvt_pk_bf16_f32 %0, %1, %2" : "=v"(r) : "v"(lo), "v"(hi)); return r; }

template <class Epi, bool ALIGN_EPI = true, bool SP2 = true>
__device__ __forceinline__ void gemm_phase(PG8_LAS unsigned char* lds, const int K, const Sched& S, const Epi& E) {
    const int tid = threadIdx.x, wid = __builtin_amdgcn_readfirstlane(tid >> 6), lane = tid & 63, wr = wid >> 2, wc = wid & 3, fr = lane & 15, fq = lane >> 4;
    const int nt = K / BK;
    unsigned voffA[2], voffB[2];
#pragma unroll
    for (int i = 0; i < 2; ++i) { int R, C; stage_rc(tid * 16 + i * 8192, R, C); const int Rb = Epi::PERM ? ((R & ~31) + perm32(R & 31)) : R;
        voffA[i] = (unsigned)(R * K + C) * 2u; voffB[i] = (unsigned)(Rb * K + C) * 2u; }
    const size_t kstep = (size_t)(BK * 2);
    const size_t hstep = (size_t)HALF * K * 2;
    const unsigned ldsw = (unsigned)wid * 1024u;
    const int aoff = lds_byte(wr * 64 + fr, fq * 8), boff = lds_byte(wc * 32 + fr, fq * 8);
#define PG8_SA(b, h) (((b) * 2 + (h)) * HTB)
#define PG8_SB(b, h) ((4 + (b) * 2 + (h)) * HTB)
#define PG8_STAGE(bufoff, gbase, voff) do { _Pragma("unroll") for (int _i = 0; _i < 2; ++_i) \
        __builtin_amdgcn_global_load_lds((const unsigned*)((const char*)(gbase) + (voff)[_i]), (PG8_LAS unsigned*)(lds + (bufoff) + ldsw + _i * 8192), 16, 0, 0); } while (0)
#define PG8_LDA(dst, b, h) do { _Pragma("unroll") for (int m = 0; m < 4; ++m) _Pragma("unroll") for (int k = 0; k < 2; ++k) dst[m][k] = *(const PG8_LAS bf16x8*)(lds + PG8_SA(b, h) + aoff + m * 2048 + k * 1024); } while (0)
#define PG8_LDB(dst, b, h) do { _Pragma("unroll") for (int n = 0; n < 2; ++n) _Pragma("unroll") for (int k = 0; k < 2; ++k) dst[n][k] = *(const PG8_LAS bf16x8*)(lds + PG8_SB(b, h) + boff + n * 2048 + k * 1024); } while (0)
#define PG8_MMA(ai, bj, At, Bt) do { __builtin_amdgcn_s_setprio(1); _Pragma("unroll") for (int m = 0; m < 4; ++m) _Pragma("unroll") for (int n = 0; n < 2; ++n) _Pragma("unroll") for (int k = 0; k < 2; ++k) \
        acc[ai][bj][m][n] = __builtin_amdgcn_mfma_f32_16x16x32_bf16(Bt[n][k], At[m][k], acc[ai][bj][m][n], 0, 0, 0); __builtin_amdgcn_s_setprio(0); } while (0)
#define PG8_WAIT_V(n) asm volatile("s_waitcnt vmcnt(" #n ")" ::: "memory")
#define PG8_WAIT_L(n) asm volatile("s_waitcnt lgkmcnt(" #n ")" ::: "memory")
#define PG8_BAR __builtin_amdgcn_s_barrier()
#define PG8_SCHED __builtin_amdgcn_sched_barrier(0)
    Unit cur, nxt; int ui = 0;
    if (!S.next(0, cur)) return;
    f32x4 acc[2][2][4][2];
#pragma unroll
    for (int a = 0; a < 2; ++a)
#pragma unroll
        for (int b = 0; b < 2; ++b)
#pragma unroll
            for (int m = 0; m < 4; ++m)
#pragma unroll
                for (int n = 0; n < 2; ++n) acc[a][b][m][n] = (f32x4){0.f, 0.f, 0.f, 0.f};
    bf16x8 At[4][2], B0[2][2], B1[2][2];
    const char* cA = cur.a; const char* cB = cur.b;
    if constexpr (SP2) {
        PG8_STAGE(PG8_SB(0, 0), cB, voffB); PG8_STAGE(PG8_SB(0, 1), cB + hstep, voffB); PG8_STAGE(PG8_SA(0, 0), cA, voffA); PG8_STAGE(PG8_SA(0, 1), cA + hstep, voffA);
        if (wr == 1) PG8_BAR;
        PG8_WAIT_V(2); PG8_BAR;
        PG8_STAGE(PG8_SB(1, 0), cB + kstep, voffB); PG8_STAGE(PG8_SA(1, 0), cA + kstep, voffA); PG8_STAGE(PG8_SB(1, 1), cB + hstep + kstep, voffB);
        PG8_WAIT_V(6); PG8_BAR;
    } else {
        PG8_STAGE(PG8_SB(0, 0), cB, voffB); PG8_STAGE(PG8_SA(0, 0), cA, voffA); PG8_STAGE(PG8_SB(0, 1), cB + hstep, voffB); PG8_STAGE(PG8_SA(0, 1), cA + hstep, voffA);
        if (wr == 1) PG8_BAR;
        PG8_WAIT_V(4); PG8_BAR;
        PG8_STAGE(PG8_SB(1, 0), cB + kstep, voffB); PG8_STAGE(PG8_SA(1, 0), cA + kstep, voffA); PG8_STAGE(PG8_SB(1, 1), cB + hstep + kstep, voffB);
        PG8_WAIT_V(6); PG8_BAR;
    }
    for (;;) {
        const bool has_next = S.next(ui + 1, nxt);
        const char* nA = has_next ? nxt.a : cA; const char* nB = has_next ? nxt.b : cB;
        for (int t = 0; t < nt; t += 2) {
            const bool last = (t == nt - 2);
            const char* a1 = cA + (size_t)(t + 1) * kstep;
            const char* a2 = last ? nA : cA + (size_t)(t + 2) * kstep; const char* b2 = last ? nB : cB + (size_t)(t + 2) * kstep;
            const char* a3 = a2 + kstep; const char* b3 = b2 + kstep;
            if constexpr (SP2) {
            PG8_LDB(B0, 0, 0); PG8_LDB(B1, 0, 1); PG8_SCHED; PG8_LDA(At, 0, 0); PG8_STAGE(PG8_SA(1, 1), a1 + hstep, voffA);
            PG8_WAIT_V(8); PG8_WAIT_L(0); PG8_BAR; PG8_MMA(0, 0, At, B0); PG8_MMA(0, 1, At, B1); PG8_BAR; PG8_SCHED;
            PG8_LDA(At, 0, 1); PG8_STAGE(PG8_SB(0, 0), b2, voffB); PG8_STAGE(PG8_SB(0, 1), b2 + hstep, voffB); PG8_STAGE(PG8_SA(0, 0), a2, voffA);
            PG8_WAIT_V(8); PG8_WAIT_L(0); PG8_BAR; PG8_MMA(1, 0, At, B0); PG8_MMA(1, 1, At, B1); PG8_BAR; PG8_SCHED;
            PG8_LDB(B0, 1, 0); PG8_LDB(B1, 1, 1); PG8_SCHED; PG8_LDA(At, 1, 0); PG8_STAGE(PG8_SA(0, 1), a2 + hstep, voffA);
            PG8_WAIT_V(8); PG8_WAIT_L(0); PG8_BAR; PG8_MMA(0, 0, At, B0); PG8_MMA(0, 1, At, B1); PG8_BAR; PG8_SCHED;
            PG8_LDA(At, 1, 1); PG8_STAGE(PG8_SB(1, 0), b3, voffB); PG8_STAGE(PG8_SB(1, 1), b3 + hstep, voffB); PG8_STAGE(PG8_SA(1, 0), a3, voffA);
            PG8_WAIT_V(8); PG8_WAIT_L(0); PG8_BAR; PG8_MMA(1, 0, At, B0); PG8_MMA(1, 1, At, B1); PG8_BAR; PG8_SCHED;
            } else {
            PG8_LDB(B0, 0, 0); PG8_SCHED; PG8_LDA(At, 0, 0); PG8_STAGE(PG8_SA(1, 1), a1 + hstep, voffA);
            PG8_WAIT_L(8); PG8_BAR; PG8_WAIT_L(0); PG8_MMA(0, 0, At, B0); PG8_BAR; PG8_SCHED;
            PG8_LDB(B1, 0, 1); PG8_STAGE(PG8_SB(0, 0), b2, voffB);
            PG8_BAR; PG8_WAIT_L(0); PG8_MMA(0, 1, At, B1); PG8_BAR;
            PG8_LDA(At, 0, 1); PG8_STAGE(PG8_SA(0, 0), a2, voffA);
            PG8_BAR; PG8_WAIT_L(0); PG8_MMA(1, 0, At, B0); PG8_BAR; PG8_SCHED;
            PG8_STAGE(PG8_SB(0, 1), b2 + hstep, voffB);
            PG8_WAIT_V(6); PG8_BAR; PG8_MMA(1, 1, At, B1); PG8_BAR;
            PG8_LDB(B0, 1, 0); PG8_SCHED; PG8_LDA(At, 1, 0); PG8_STAGE(PG8_SA(0, 1), a2 + hstep, voffA);
            PG8_WAIT_L(8); PG8_BAR; PG8_WAIT_L(0); PG8_MMA(0, 0, At, B0); PG8_BAR; PG8_SCHED;
            PG8_LDB(B1, 1, 1); PG8_STAGE(PG8_SB(1, 0), b3, voffB);
            PG8_BAR; PG8_WAIT_L(0); PG8_MMA(0, 1, At, B1); PG8_BAR;
            PG8_LDA(At, 1, 1); PG8_STAGE(PG8_SA(1, 0), a3, voffA);
            PG8_BAR; PG8_WAIT_L(0); PG8_MMA(1, 0, At, B0); PG8_BAR; PG8_SCHED;
            PG8_STAGE(PG8_SB(1, 1), b3 + hstep, voffB);
            PG8_WAIT_V(6); PG8_BAR; PG8_MMA(1, 1, At, B1); PG8_BAR;
            }
        }
        if constexpr (ALIGN_EPI) { if (wr == 0) PG8_BAR; }
        E(acc, cur, wr, wc, fr, fq);
        if (!has_next) break;
#pragma unroll
        for (int a = 0; a < 2; ++a)
#pragma unroll
            for (int b = 0; b < 2; ++b)
#pragma unroll
                for (int m = 0; m < 4; ++m)
#pragma unroll
                    for (int n = 0; n < 2; ++n) acc[a][b][m][n] = (f32x4){0.f, 0.f, 0.f, 0.f};
        cur = nxt; cA = nA; cB = nB; ++ui;
        if constexpr (ALIGN_EPI) { if (wr == 1) PG8_BAR; }
    }
    PG8_WAIT_V(0);
    if constexpr (!ALIGN_EPI) { if (wr == 0) PG8_BAR; }
    PG8_BAR;
#undef PG8_SA
#undef PG8_SB
#undef PG8_STAGE
#undef PG8_LDA
#undef PG8_LDB
#undef PG8_MMA
#undef PG8_WAIT_V
#undef PG8_WAIT_L
#undef PG8_BAR
#undef PG8_SCHED
}
}
constexpr int T_TOK = 16384, DM = 2048, SEQ = 2048, NBATCH = 8, MEML = 256, MT = NBATCH * MEML, IN_COLS = 5376;
constexpr float EPS = 1e-6f, GN_EPS = 1e-5f, LOG2E = 1.4426950408889634f;
constexpr float C2Q = 0.125f * LOG2E;
constexpr float C3Q = 0.08838834764831845f * LOG2E;
constexpr size_t MiB = 1u << 20;
constexpr size_t WS_CTL = 0, CTL_ZERO_BYTES = 64 * 1024;
constexpr size_t WS_WIN = 2 * MiB, WS_WOUT = 23 * MiB, WS_WXQ = 31 * MiB, WS_WXKV = 33 * MiB, WS_WXO = 37 * MiB, WS_WPQ = 39 * MiB;
constexpr size_t WS_XB = 48 * MiB, WS_MEMB = 112 * MiB;
constexpr size_t WS_COSA = 120 * MiB, WS_SINA = 122 * MiB, WS_COSR = 124 * MiB, WS_SINR = 132 * MiB;
constexpr size_t WS_SS0 = 140 * MiB, WS_SS1 = WS_SS0 + 65536, WS_SS2 = WS_SS1 + 65536, WS_SSM = WS_SS2 + 65536;
constexpr size_t WS_KX = 141 * MiB, WS_VX = 143 * MiB, WS_QX = 145 * MiB, WS_OX = 161 * MiB, WS_EXP = 177 * MiB, WS_GATE = 185 * MiB;
constexpr size_t WS_Y = 193 * MiB;
constexpr size_t WS_QA = 257 * MiB, WS_KA = 289 * MiB, WS_VA = 293 * MiB, WS_QR = 297 * MiB, WS_KR = 329 * MiB, WS_VR = 361 * MiB, WS_GR = 393 * MiB;
constexpr size_t WS_UB = 425 * MiB, WS_VB = 457 * MiB, WS_SU = 489 * MiB, WS_SV = WS_SU + 65536;
constexpr size_t WS_END = 490 * MiB;

#define GAS __attribute__((address_space(1)))
#define LAS __attribute__((address_space(3)))
typedef unsigned short bf16_t;
typedef short bf16x8 __attribute__((ext_vector_type(8)));
typedef short v4i16 __attribute__((ext_vector_type(4)));
typedef float f32x4 __attribute__((ext_vector_type(4)));
typedef float f32x2 __attribute__((ext_vector_type(2)));
typedef unsigned u32x4 __attribute__((ext_vector_type(4)));
typedef unsigned u32x2 __attribute__((ext_vector_type(2)));
typedef __bf16 bf16x2_t __attribute__((ext_vector_type(2)));

__device__ __forceinline__ unsigned pk2(float lo, float hi) { f32x2 v = {lo, hi}; bf16x2_t b = __builtin_convertvector(v, bf16x2_t); return __builtin_bit_cast(unsigned, b); }
__device__ __forceinline__ float bf_lo(unsigned w) { return __uint_as_float(w << 16); }
__device__ __forceinline__ float bf_hi(unsigned w) { return __uint_as_float(w & 0xffff0000u); }
__device__ __forceinline__ float wave_sum(float v) {
#pragma unroll
    for (int o = 1; o < 64; o <<= 1) v += __shfl_xor(v, o);
    return v;
}

struct EpiP1 {
    static constexpr bool PERM = true;
    unsigned char* ws;
    __device__ __forceinline__ void operator()(const pg8::f32x4 (&acc)[2][2][4][2], const pg8::Unit& u, int wr, int wc, int fr, int fq) const {
        if (u.kind == 1) {
            const float* ssm = (const float*)(ws + WS_SSM);
            bf16_t* O = (bf16_t*)(ws + ((u.pn < 2) ? WS_KX : WS_VX)); const int cb = (u.pn & 1) * 256 + wc * 32 + 8 * fq;
#pragma unroll
            for (int ai = 0; ai < 2; ++ai)
#pragma unroll
                for (int m = 0; m < 4; ++m) { const int row = u.pm * 256 + ai * 128 + wr * 64 + m * 16 + fr; const float rs = rsqrtf(ssm[row] * (1.f / DM) + EPS);
#pragma unroll
                    for (int bj = 0; bj < 2; ++bj) { const f32x4 v0 = acc[ai][bj][m][0] * rs, v1 = acc[ai][bj][m][1] * rs;
                        u32x4 w; w.x = pk2(v0[0], v0[1]); w.y = pk2(v0[2], v0[3]); w.z = pk2(v1[0], v1[1]); w.w = pk2(v1[2], v1[3]);
                        *(u32x4*)(O + (size_t)row * 512 + cb + bj * 128) = w; } }
            return;
        }
        const float* ss0 = (const float*)(ws + WS_SS0);
        const int pn = u.pn;
        size_t ooff, ctoff, stoff; int pitch, colbase, i0, half, tw; float sc; bool rope;
        if (pn < 4)        { ooff = WS_QA; pitch = 1024; colbase = (4 * pn + wc) * 64; i0 = 8 * fq; half = 32; tw = 32; ctoff = WS_COSA; stoff = WS_SINA; sc = C2Q; rope = true; }
        else if (pn == 4)  { if (wc < 2) { ooff = WS_KA; colbase = wc * 64; rope = true; } else { ooff = WS_VA; colbase = (wc - 2) * 64; rope = false; }
                             pitch = 128; i0 = 8 * fq; half = 32; tw = 32; ctoff = WS_COSA; stoff = WS_SINA; sc = 1.f; }
        else { const int q = (pn - 5) >> 2, h = (pn - 5) & 3; ooff = WS_QR + (size_t)q * (32 * MiB); pitch = 1024; colbase = h * 256; i0 = 32 * wc + 8 * fq; half = 128; tw = 128; ctoff = WS_COSR; stoff = WS_SINR;
               sc = (q == 1) ? 0.0625f : 1.f; rope = (q < 2); }
        bf16_t* O = (bf16_t*)(ws + ooff); const float* ct = (const float*)(ws + ctoff); const float* st = (const float*)(ws + stoff);
#pragma unroll
        for (int ai = 0; ai < 2; ++ai)
#pragma unroll
            for (int m = 0; m < 4; ++m) { const int row = u.pm * 256 + ai * 128 + wr * 64 + m * 16 + fr; const float rs = rsqrtf(ss0[row] * (1.f / DM) + EPS) * sc;
                f32x4 a0 = acc[ai][0][m][0] * rs, a1 = acc[ai][0][m][1] * rs, b0 = acc[ai][1][m][0] * rs, b1 = acc[ai][1][m][1] * rs;
                if (rope) { const f32x4 c0 = *(const f32x4*)(ct + (size_t)row * tw + i0), c1 = *(const f32x4*)(ct + (size_t)row * tw + i0 + 4);
                            const f32x4 s0 = *(const f32x4*)(st + (size_t)row * tw + i0), s1 = *(const f32x4*)(st + (size_t)row * tw + i0 + 4);
                            const f32x4 o0 = a0 * c0 - b0 * s0, o1 = a1 * c1 - b1 * s1, p0 = b0 * c0 + a0 * s0, p1 = b1 * c1 + a1 * s1; a0 = o0; a1 = o1; b0 = p0; b1 = p1; }
                bf16_t* rp = O + (size_t)row * pitch + colbase + i0;
                u32x4 w; w.x = pk2(a0[0], a0[1]); w.y = pk2(a0[2], a0[3]); w.z = pk2(a1[0], a1[1]); w.w = pk2(a1[2], a1[3]); *(u32x4*)rp = w;
                w.x = pk2(b0[0], b0[1]); w.y = pk2(b0[2], b0[3]); w.z = pk2(b1[0], b1[1]); w.w = pk2(b1[2], b1[3]); *(u32x4*)(rp + half) = w; }
    }
};
struct EpiRes1 {
    static constexpr bool PERM = true;
    const float* res; bf16_t* XB; float* ss;
    __device__ __forceinline__ void operator()(const pg8::f32x4 (&acc)[2][2][4][2], const pg8::Unit& u, int wr, int wc, int fr, int fq) const {
        const int col0 = u.pn * 256 + wc * 32 + 8 * fq;
#pragma unroll
        for (int ai = 0; ai < 2; ++ai) {
            f32x4 r[4][2][2];
#pragma unroll
            for (int m = 0; m < 4; ++m) { const size_t off = (size_t)(u.pm * 256 + ai * 128 + wr * 64 + m * 16 + fr) * DM + col0;
#pragma unroll
                for (int bj = 0; bj < 2; ++bj) { r[m][bj][0] = *(const f32x4*)(res + off + bj * 128); r[m][bj][1] = *(const f32x4*)(res + off + bj * 128 + 4); } }
#pragma unroll
            for (int m = 0; m < 4; ++m) { const int row = u.pm * 256 + ai * 128 + wr * 64 + m * 16 + fr; const size_t off = (size_t)row * DM + col0; float s = 0.f;
#pragma unroll
                for (int bj = 0; bj < 2; ++bj) { const size_t o = off + bj * 128;
                    const f32x4 v0 = r[m][bj][0] + acc[ai][bj][m][0], v1 = r[m][bj][1] + acc[ai][bj][m][1];
                    u32x4 w; w.x = pk2(v0[0], v0[1]); w.y = pk2(v0[2], v0[3]); w.z = pk2(v1[0], v1[1]); w.w = pk2(v1[2], v1[3]); *(u32x4*)(XB + o) = w;
                    s += ((v0[0] * v0[0] + v0[1] * v0[1]) + (v0[2] * v0[2] + v0[3] * v0[3])) + ((v1[0] * v1[0] + v1[1] * v1[1]) + (v1[2] * v1[2] + v1[3] * v1[3])); }
                s += __shfl_xor(s, 16); s += __shfl_xor(s, 32);
                if (fq == 0) atomicAdd(ss + row, s); }
            asm volatile("" ::: "memory");
        }
    }
};
struct EpiRes2 {
    static constexpr bool PERM = true;
    float* X; bf16_t* XB; float* ss;
    __device__ __forceinline__ void operator()(const pg8::f32x4 (&acc)[2][2][4][2], const pg8::Unit& u, int wr, int wc, int fr, int fq) const {
        const int col0 = u.pn * 256 + wc * 32 + 8 * fq;
        u32x4 r[2][4][2];
#pragma unroll
        for (int ai = 0; ai < 2; ++ai)
#pragma unroll
            for (int m = 0; m < 4; ++m) { const size_t off = (size_t)(u.pm * 256 + ai * 128 + wr * 64 + m * 16 + fr) * DM + col0;
#pragma unroll
                for (int bj = 0; bj < 2; ++bj) r[ai][m][bj] = *(const u32x4*)(XB + off + bj * 128); }
#pragma unroll
        for (int ai = 0; ai < 2; ++ai)
#pragma unroll
            for (int m = 0; m < 4; ++m) { const int row = u.pm * 256 + ai * 128 + wr * 64 + m * 16 + fr; const size_t off = (size_t)row * DM + col0; float s = 0.f;
#pragma unroll
                for (int bj = 0; bj < 2; ++bj) { const size_t o = off + bj * 128; const u32x4 q = r[ai][m][bj];
                    const f32x4 v0 = (f32x4){bf_lo(q.x), bf_hi(q.x), bf_lo(q.y), bf_hi(q.y)} + acc[ai][bj][m][0], v1 = (f32x4){bf_lo(q.z), bf_hi(q.z), bf_lo(q.w), bf_hi(q.w)} + acc[ai][bj][m][1];
                    *(f32x4*)(X + o) = v0; *(f32x4*)(X + o + 4) = v1;
                    u32x4 w; w.x = pk2(v0[0], v0[1]); w.y = pk2(v0[2], v0[3]); w.z = pk2(v1[0], v1[1]); w.w = pk2(v1[2], v1[3]); *(u32x4*)(XB + o) = w;
                    s += ((v0[0] * v0[0] + v0[1] * v0[1]) + (v0[2] * v0[2] + v0[3] * v0[3])) + ((v1[0] * v1[0] + v1[1] * v1[1]) + (v1[2] * v1[2] + v1[3] * v1[3])); }
                s += __shfl_xor(s, 16); s += __shfl_xor(s, 32);
                if (fq == 0) atomicAdd(ss + row, s); }
    }
};
struct EpiScale {
    static constexpr bool PERM = true;
    bf16_t* O; int ldc; const float* ss; float scale;
    __device__ __forceinline__ void operator()(const pg8::f32x4 (&acc)[2][2][4][2], const pg8::Unit& u, int wr, int wc, int fr, int fq) const {
        const int col0 = u.pn * 256 + wc * 32 + 8 * fq;
#pragma unroll
        for (int ai = 0; ai < 2; ++ai)
#pragma unroll
            for (int m = 0; m < 4; ++m) { const int row = u.pm * 256 + ai * 128 + wr * 64 + m * 16 + fr; const float rs = rsqrtf(ss[row] * (1.f / DM) + EPS) * scale;
#pragma unroll
                for (int bj = 0; bj < 2; ++bj) { const f32x4 v0 = acc[ai][bj][m][0] * rs, v1 = acc[ai][bj][m][1] * rs;
                    u32x4 w; w.x = pk2(v0[0], v0[1]); w.y = pk2(v0[2], v0[3]); w.z = pk2(v1[0], v1[1]); w.w = pk2(v1[2], v1[3]);
                    *(u32x4*)(O + (size_t)row * ldc + col0 + bj * 128) = w; } }
    }
};
#define XB_TMO      128
#define XB_XCNT(j)  (256  + 64 * (j))
#define XB_XSUB(j)  (1280 + 64 * (j))
#define XB_XGEN(j)  (2304 + 64 * (j))
#define XB_TOP      3328
#define XB_TOPGEN   3392
#define XCD_BAR_WORDS 3456
#define XB_SPIN_CAP (1u << 18)
__device__ __forceinline__ unsigned xb_ld(unsigned* p)              { return __hip_atomic_load(p, __ATOMIC_RELAXED, __HIP_MEMORY_SCOPE_AGENT); }
__device__ __forceinline__ unsigned xb_add(unsigned* p, unsigned v) { return __hip_atomic_fetch_add(p, v, __ATOMIC_RELAXED, __HIP_MEMORY_SCOPE_AGENT); }
__device__ __forceinline__ unsigned xb_xcc_id() { return (unsigned)__builtin_amdgcn_s_getreg((3 << 11) | 20) & 0xFu; }
#define XB_SPIN(cond, bar) do { unsigned _sp = 0; while (cond) { __builtin_amdgcn_s_sleep(1); \
    if ((++_sp & 255u) == 0u) { if (xb_ld(&(bar)[XB_TMO])) break; if (_sp > XB_SPIN_CAP) { atomicAdd(&(bar)[XB_TMO], 1u); break; } } } } while (0)
struct XcdBarrier { unsigned* bar; unsigned x; volatile LAS unsigned* st; };
__device__ __forceinline__ XcdBarrier xcd_barrier_post(unsigned* bar, volatile LAS unsigned* st) {
    XcdBarrier b; b.bar = bar; b.x = xb_xcc_id(); b.st = st;
    if (threadIdx.x == 0) (void)xb_add(&bar[XB_XCNT(b.x)], 1u);
    return b;
}
__device__ __forceinline__ void xcd_barrier_complete(unsigned* bar, unsigned x, unsigned& nloc, unsigned& nx) {
    const unsigned G = gridDim.x * gridDim.y * gridDim.z;
    unsigned sum, cnt, mine, sp = 0u;
    for (;;) {
        sum = 0u; cnt = 0u; mine = 0u;
#pragma unroll
        for (unsigned j = 0; j < 16; ++j) { const unsigned c = xb_ld(&bar[XB_XCNT(j)]); sum += c; cnt += (c > 0u) ? 1u : 0u; mine = (j == x) ? c : mine; }
        if (sum == G) break;
        __builtin_amdgcn_s_sleep(1);
        if ((++sp & 255u) == 0u) { if (xb_ld(&bar[XB_TMO])) break; if (sp > XB_SPIN_CAP) { atomicAdd(&bar[XB_TMO], 1u); break; } }
    }
    nloc = mine > 0u ? mine : 1u; nx = cnt > 0u ? cnt : 1u;
}
__device__ __forceinline__ void xcd_barrier(const XcdBarrier& b) {
    asm volatile("s_waitcnt vmcnt(0)" ::: "memory");
    __syncthreads();
    if (threadIdx.x == 0) {
        unsigned* bar = b.bar;
        __builtin_amdgcn_s_waitcnt(0);
        unsigned nloc = b.st[0], nx = b.st[1];
        if (nloc == 0u) { xcd_barrier_complete(bar, b.x, nloc, nx); b.st[0] = nloc; b.st[1] = nx; }
        const unsigned old = xb_add(&bar[XB_XSUB(b.x)], 1u);
        const unsigned gen = old / nloc;
        if (old + 1u == (gen + 1u) * nloc) {
            __builtin_amdgcn_fence(__ATOMIC_RELEASE, "agent");
            asm volatile("s_waitcnt vmcnt(0)" ::: "memory");
            const unsigned og = xb_add(&bar[XB_TOP], 1u);
            const unsigned tg = og / nx;
            if (og + 1u == (tg + 1u) * nx) xb_add(&bar[XB_TOPGEN], 1u);
            else XB_SPIN(xb_ld(&bar[XB_TOPGEN]) == tg, bar);
            __builtin_amdgcn_fence(__ATOMIC_ACQUIRE, "agent");
            xb_add(&bar[XB_XGEN(b.x)], 1u);
            asm volatile("s_waitcnt vmcnt(0)" ::: "memory");
        } else {
            XB_SPIN(xb_ld(&bar[XB_XGEN(b.x)]) == gen, bar);
            __builtin_amdgcn_fence(__ATOMIC_ACQUIRE, "agent");
            asm volatile("s_waitcnt vmcnt(0)" ::: "memory");
        }
    }
    __syncthreads();
}

__device__ __forceinline__ int win_phys(int n) {
    if (n < 1024) { const int head = n >> 6, d = n & 63; return (head >> 2) * 256 + (d >> 5) * 128 + (head & 3) * 32 + (d & 31); }
    if (n < 1280) { const int m = n - 1024, kind = m >> 7, hh = (m & 127) >> 6, d = m & 63; return 1024 + (d >> 5) * 128 + (kind * 2 + hh) * 32 + (d & 31); }
    return n;
}
template <bool PERMW>
__device__ __forceinline__ void p0_transpose_item(const float* W, const float* gk, int K, int N, bf16_t* WT, int row_off, LAS float* scr, int item, int lane) {
    const int nblk = N / 32, kb = item / nblk, nb = item % nblk, k0 = 64 * kb, n0 = 32 * nb;
    float wv[32];
#pragma unroll
    for (int i = 0; i < 32; ++i) { const int kk = 2 * i + (lane >> 5); wv[i] = W[(size_t)(k0 + kk) * N + n0 + (lane & 31)]; }
#pragma unroll
    for (int i = 0; i < 32; ++i) { const int kk = 2 * i + (lane >> 5); const float g = gk ? gk[k0 + kk] : 1.f; scr[kk * 33 + (lane & 31)] = wv[i] * g; }
    asm volatile("s_waitcnt lgkmcnt(0)" ::: "memory");
    const int c = lane & 7; const int pr0 = PERMW ? win_phys(n0) : n0;
#pragma unroll
    for (int j = 0; j < 4; ++j) { const int n = (lane >> 3) + 8 * j; const LAS float* s = scr + (8 * c) * 33 + n;
        u32x4 o; o.x = pk2(s[0 * 33], s[1 * 33]); o.y = pk2(s[2 * 33], s[3 * 33]); o.z = pk2(s[4 * 33], s[5 * 33]); o.w = pk2(s[6 * 33], s[7 * 33]);
        *(u32x4*)(WT + (size_t)(row_off + pr0 + n) * K + k0 + 8 * c) = o; }
    asm volatile("s_waitcnt lgkmcnt(0)" ::: "memory");
}
__device__ __forceinline__ void row_to_bf16(const float* xrow, bf16_t* orow, float* ssq, int lane) {
    const f32x4* xr = (const f32x4*)xrow + lane; f32x4 v[8]; float s = 0.f;
#pragma unroll
    for (int j = 0; j < 8; ++j) { v[j] = xr[64 * j]; s += (v[j][0] * v[j][0] + v[j][1] * v[j][1]) + (v[j][2] * v[j][2] + v[j][3] * v[j][3]); }
    s = wave_sum(s);
    u32x2* o8 = (u32x2*)orow + lane;
#pragma unroll
    for (int j = 0; j < 8; ++j) { u32x2 w; w.x = pk2(v[j][0], v[j][1]); w.y = pk2(v[j][2], v[j][3]); o8[64 * j] = w; }
    if (lane == 0) *ssq = s;
}
__device__ __forceinline__ void row2_to_bf16(const float* xrow, bf16_t* orow, float* ssq, size_t rstep, int lane) {
    const f32x4* xr0 = (const f32x4*)xrow + lane; const f32x4* xr1 = (const f32x4*)(xrow + rstep * DM) + lane; f32x4 v[8], q[8]; float s0 = 0.f, s1 = 0.f;
#pragma unroll
    for (int j = 0; j < 8; ++j) { v[j] = xr0[64 * j]; q[j] = xr1[64 * j]; }
#pragma unroll
    for (int j = 0; j < 8; ++j) { s0 += (v[j][0] * v[j][0] + v[j][1] * v[j][1]) + (v[j][2] * v[j][2] + v[j][3] * v[j][3]); s1 += (q[j][0] * q[j][0] + q[j][1] * q[j][1]) + (q[j][2] * q[j][2] + q[j][3] * q[j][3]); }
    s0 = wave_sum(s0); s1 = wave_sum(s1);
    u32x2* o0 = (u32x2*)orow + lane; u32x2* o1 = (u32x2*)(orow + rstep * DM) + lane;
#pragma unroll
    for (int j = 0; j < 8; ++j) { u32x2 w; w.x = pk2(v[j][0], v[j][1]); w.y = pk2(v[j][2], v[j][3]); o0[64 * j] = w; w.x = pk2(q[j][0], q[j][1]); w.y = pk2(q[j][2], q[j][3]); o1[64 * j] = w; }
    if (lane == 0) { ssq[0] = s0; ssq[rstep] = s1; }
}
__device__ __forceinline__ void sincos_red(float ang, float& c, float& s) {
    const float k = rintf(ang * 0.15915494309189535f);
    float r = fmaf(-k, 6.28125f, ang); r = fmaf(-k, 1.9353071795864769e-3f, r);
    const float rev = r * 0.15915494309189535f;
    s = __builtin_amdgcn_sinf(rev); c = __builtin_amdgcn_cosf(rev);
}

#define MFMA16(a, b, c) __builtin_amdgcn_mfma_f32_16x16x32_bf16((a), (b), (c), 0, 0, 0)
__device__ __forceinline__ bf16x8 pack_p(const f32x4& lo, const f32x4& hi) {
    u32x4 w; w.x = pk2(lo[0], lo[1]); w.y = pk2(lo[2], lo[3]); w.z = pk2(hi[0], hi[1]); w.w = pk2(hi[2], hi[3]); return __builtin_bit_cast(bf16x8, w);
}
__device__ __forceinline__ bf16x8 vt_frag(LAS const unsigned char* p, int stride16) {
    const v4i16 lo = __builtin_amdgcn_ds_read_tr16_b64_v4i16((LAS v4i16*)p);
    const v4i16 hi = __builtin_amdgcn_ds_read_tr16_b64_v4i16((LAS v4i16*)(p + stride16));
    return (bf16x8){lo[0], lo[1], lo[2], lo[3], hi[0], hi[1], hi[2], hi[3]};
}

__device__ __forceinline__ void swa_unit(LAS unsigned char* lds, int b, int n, int kvh, const bf16_t* QA, const bf16_t* KA, const bf16_t* VA,
                                         const float* sinks, const float* att_gain, bf16_t* Y) {
    constexpr int KS = 144;
    const int tid = threadIdx.x, lane = tid & 63, c = lane & 15, g = lane >> 4; const int w = __builtin_amdgcn_readfirstlane(tid >> 6);
    LAS unsigned char* Kl = lds; LAS unsigned char* Vl = lds + 256 * KS;
    for (int i = tid; i < 2048; i += 512) { const int key = i >> 3, ch = i & 7, pos = 128 * (n - 1) + key; u32x4 kv = {0u, 0u, 0u, 0u}, vv = {0u, 0u, 0u, 0u};
        if (pos >= 0) { const size_t off = (size_t)(b * SEQ + pos) * 128 + kvh * 64 + ch * 8; kv = *(const u32x4*)(KA + off); vv = *(const u32x4*)(VA + off); }
        *(LAS u32x4*)(Kl + key * KS + ch * 16) = kv; *(LAS u32x4*)(Vl + key * KS + ch * 16) = vv; }
    __syncthreads();
    const int hq = kvh * 8 + w; const float sink = sinks[hq] * LOG2E;
    bf16x8 qn[2];
#pragma unroll
    for (int ks = 0; ks < 2; ++ks) qn[ks] = *(const bf16x8*)(QA + (size_t)(b * SEQ + 128 * n + c) * 1024 + hq * 64 + ks * 32 + 8 * g);
    for (int a = 0; a < 8; ++a) {
        const int t = b * SEQ + 128 * n + 16 * a + c; const int kb0 = (a & ~1) * 16; const int qi = 128 + 16 * a + c;
        bf16x8 qf[2];
#pragma unroll
        for (int ks = 0; ks < 2; ++ks) { qf[ks] = qn[ks]; qn[ks] = *(const bf16x8*)(QA + (size_t)(t + (a < 7 ? 16 : 0)) * 1024 + hq * 64 + ks * 32 + 8 * g); }
        f32x4 s[10]; float m = sink;
#pragma unroll
        for (int blk = 0; blk < 10; ++blk) { const int key0 = kb0 + 16 * blk; f32x4 acc = {0.f, 0.f, 0.f, 0.f};
#pragma unroll
            for (int ks = 0; ks < 2; ++ks) { const bf16x8 kf = *(LAS const bf16x8*)(Kl + (key0 + c) * KS + (ks * 32 + 8 * g) * 2); acc = MFMA16(kf, qf[ks], acc); }
#pragma unroll
            for (int r = 0; r < 4; ++r) { const int j = key0 + 4 * g + r; const bool ok = (j <= qi) && (j > qi - 128) && (n > 0 || j >= 128);
                acc[r] = ok ? acc[r] : -INFINITY; m = fmaxf(m, acc[r]); }
            s[blk] = acc; }
        m = fmaxf(m, __shfl_xor(m, 16)); m = fmaxf(m, __shfl_xor(m, 32));
        float l = 0.f;
#pragma unroll
        for (int blk = 0; blk < 10; ++blk)
#pragma unroll
            for (int r = 0; r < 4; ++r) { const float p = __builtin_amdgcn_exp2f(s[blk][r] - m); s[blk][r] = p; l += p; }
        l += __shfl_xor(l, 16); l += __shfl_xor(l, 32); l += __builtin_amdgcn_exp2f(sink - m);
        f32x4 o[4];
#pragma unroll
        for (int db = 0; db < 4; ++db) o[db] = (f32x4){0.f, 0.f, 0.f, 0.f};
#pragma unroll
        for (int kp = 0; kp < 5; ++kp) { const bf16x8 pf = pack_p(s[2 * kp], s[2 * kp + 1]); const int key0 = kb0 + 32 * kp;
#pragma unroll
            for (int db = 0; db < 4; ++db) { const bf16x8 af = vt_frag(Vl + (key0 + 4 * g + (c >> 2)) * KS + (16 * db + 4 * (c & 3)) * 2, 16 * KS); o[db] = MFMA16(af, pf, o[db]); } }
        const float inv = 1.f / l; float q2 = 0.f;
#pragma unroll
        for (int db = 0; db < 4; ++db) { o[db] = o[db] * inv; q2 += (o[db][0] * o[db][0] + o[db][1] * o[db][1]) + (o[db][2] * o[db][2] + o[db][3] * o[db][3]); }
        q2 += __shfl_xor(q2, 16); q2 += __shfl_xor(q2, 32);
        const float rms = rsqrtf(q2 * (1.f / 64.f) + EPS);
#pragma unroll
        for (int db = 0; db < 4; ++db) { const int col = hq * 64 + 16 * db + 4 * g; const f32x4 gn = *(const f32x4*)(att_gain + col); const f32x4 v = o[db] * rms * gn;
            u32x2 wv; wv.x = pk2(v[0], v[1]); wv.y = pk2(v[2], v[3]); *(u32x2*)(Y + (size_t)t * DM + col) = wv; }
    }
    __syncthreads();
}

__device__ __forceinline__ void ret_unit(LAS unsigned char* lds, int b, int h, int qb, const bf16_t* QR, const bf16_t* KR, const bf16_t* VR, const bf16_t* GR,
                                         const float* ret_gain, bf16_t* Y) {
    constexpr int RS = 544, TB = 64 * RS;
    const int tid = threadIdx.x, lane = tid & 63, c = lane & 15, g = lane >> 4; const int w = __builtin_amdgcn_readfirstlane(tid >> 6);
    const int nt = 2 * qb + 2; const size_t rowb = (size_t)b * SEQ; const int hoff = h * 256;
    const int qpos = 128 * qb + 16 * w + c; const size_t t = rowb + qpos;
    const float lg = log2f(1.f - exp2f(-5.f - (float)h));
    bf16x8 qf[8];
#pragma unroll
    for (int ks = 0; ks < 8; ++ks) qf[ks] = *(const bf16x8*)(QR + t * 1024 + hoff + ks * 32 + 8 * g);
    f32x4 o[16];
#pragma unroll
    for (int db = 0; db < 16; ++db) o[db] = (f32x4){0.f, 0.f, 0.f, 0.f};
    u32x4 pk[4], pv[4];
#define RET_LOAD(kt) do { _Pragma("unroll") for (int i = 0; i < 4; ++i) { const int id = tid + 512 * i, key = id >> 5, ch = id & 31; const size_t off = (rowb + 64 * (kt) + key) * 1024 + hoff + ch * 8; \
        pk[i] = *(const u32x4*)(KR + off); pv[i] = *(const u32x4*)(VR + off); } } while (0)
#define RET_WRITE(buf) do { _Pragma("unroll") for (int i = 0; i < 4; ++i) { const int id = tid + 512 * i, key = id >> 5, ch = id & 31; \
        *(LAS u32x4*)(lds + (buf) * 2 * TB + key * RS + ch * 16) = pk[i]; *(LAS u32x4*)(lds + (buf) * 2 * TB + TB + key * RS + ch * 16) = pv[i]; } } while (0)
    RET_LOAD(0); RET_WRITE(0); __syncthreads();
    for (int kt = 0; kt < nt; ++kt) {
        const int buf = kt & 1;
        if (kt + 1 < nt) RET_LOAD(kt + 1);
        if (64 * kt <= 128 * qb + 16 * w + 15) {
            LAS const unsigned char* Kl = lds + buf * 2 * TB; LAS const unsigned char* Vl = Kl + TB;
            f32x4 s[4];
#pragma unroll
            for (int blk = 0; blk < 4; ++blk) { f32x4 acc = {0.f, 0.f, 0.f, 0.f};
#pragma unroll
                for (int ks = 0; ks < 8; ++ks) { const bf16x8 kf = *(LAS const bf16x8*)(Kl + (16 * blk + c) * RS + (ks * 32 + 8 * g) * 2); acc = MFMA16(kf, qf[ks], acc); }
#pragma unroll
                for (int r = 0; r < 4; ++r) { const int d = qpos - (64 * kt + 16 * blk + 4 * g + r); const float dec = __builtin_amdgcn_exp2f((float)d * lg); acc[r] = (d >= 0) ? acc[r] * dec : 0.f; }
                s[blk] = acc; }
#pragma unroll
            for (int kp = 0; kp < 2; ++kp) { const bf16x8 pf = pack_p(s[2 * kp], s[2 * kp + 1]);
#pragma unroll
                for (int db = 0; db < 16; ++db) { const bf16x8 af = vt_frag(Vl + (32 * kp + 4 * g + (c >> 2)) * RS + (16 * db + 4 * (c & 3)) * 2, 16 * RS); o[db] = MFMA16(af, pf, o[db]); }
                __builtin_amdgcn_sched_barrier(0); }
        }
        if (kt + 1 < nt) RET_WRITE(buf ^ 1);
        __syncthreads();
    }
#undef RET_LOAD
#undef RET_WRITE
    float s1 = 0.f;
#pragma unroll
    for (int db = 0; db < 16; ++db) s1 += (o[db][0] + o[db][1]) + (o[db][2] + o[db][3]);
    s1 += __shfl_xor(s1, 16); s1 += __shfl_xor(s1, 32);
    const float mu = s1 * (1.f / 256.f); float s2 = 0.f;
#pragma unroll
    for (int db = 0; db < 16; ++db) { o[db] = o[db] - mu; s2 += (o[db][0] * o[db][0] + o[db][1] * o[db][1]) + (o[db][2] * o[db][2] + o[db][3] * o[db][3]); }
    s2 += __shfl_xor(s2, 16); s2 += __shfl_xor(s2, 32);
    const float rstd = rsqrtf(s2 * (1.f / 256.f) + GN_EPS);
#pragma unroll
    for (int db = 0; db < 16; ++db) { const int col = hoff + 16 * db + 4 * g; const f32x4 gn = *(const f32x4*)(ret_gain + col); const u32x2 gw = *(const u32x2*)(GR + t * 1024 + col);
        const float z0 = bf_lo(gw.x), z1 = bf_hi(gw.x), z2 = bf_lo(gw.y), z3 = bf_hi(gw.y);
        f32x4 v = o[db] * rstd * gn;
        v[0] *= z0 / (1.f + __expf(-z0)); v[1] *= z1 / (1.f + __expf(-z1)); v[2] *= z2 / (1.f + __expf(-z2)); v[3] *= z3 / (1.f + __expf(-z3));
        u32x2 wv; wv.x = pk2(v[0], v[1]); wv.y = pk2(v[2], v[3]); *(u32x2*)(Y + t * DM + 1024 + col) = wv; }
}

__device__ __forceinline__ void xattn_unit(LAS unsigned char* lds, int b, int hx, int qblk, const bf16_t* QX, const bf16_t* KX, const bf16_t* VX, bf16_t* OX) {
    constexpr int KS = 288;
    const int tid = threadIdx.x, lane = tid & 63, c = lane & 15, g = lane >> 4; const int w = __builtin_amdgcn_readfirstlane(tid >> 6);
    LAS unsigned char* Kl = lds; LAS unsigned char* Vl = lds + 256 * KS;
    for (int i = tid; i < 4096; i += 512) { const int key = i >> 4, ch = i & 15; const size_t off = (size_t)(b * MEML + key) * 512 + hx * 128 + ch * 8;
        *(LAS u32x4*)(Kl + key * KS + ch * 16) = *(const u32x4*)(KX + off); *(LAS u32x4*)(Vl + key * KS + ch * 16) = *(const u32x4*)(VX + off); }
    __syncthreads();
    bf16x8 qn[4];
#pragma unroll
    for (int ks = 0; ks < 4; ++ks) qn[ks] = *(const bf16x8*)(QX + ((size_t)b * SEQ + 256 * qblk + 16 * w + c) * 512 + hx * 128 + ks * 32 + 8 * g);
#pragma unroll 1
    for (int pass = 0; pass < 2; ++pass) {
        const size_t t = (size_t)b * SEQ + 256 * qblk + 128 * pass + 16 * w + c;
        bf16x8 qf[4];
#pragma unroll
        for (int ks = 0; ks < 4; ++ks) { qf[ks] = qn[ks]; qn[ks] = *(const bf16x8*)(QX + (t + (pass == 0 ? 128 : 0)) * 512 + hx * 128 + ks * 32 + 8 * g); }
        f32x4 s[16]; float m = -INFINITY;
#pragma unroll
        for (int blk = 0; blk < 16; ++blk) { f32x4 acc = {0.f, 0.f, 0.f, 0.f};
#pragma unroll
            for (int ks = 0; ks < 4; ++ks) { const bf16x8 kf = *(LAS const bf16x8*)(Kl + (16 * blk + c) * KS + (ks * 32 + 8 * g) * 2); acc = MFMA16(kf, qf[ks], acc); }
            m = fmaxf(fmaxf(fmaxf(acc[0], acc[1]), fmaxf(acc[2], acc[3])), m); s[blk] = acc; __builtin_amdgcn_sched_barrier(0); }
        m = fmaxf(m, __shfl_xor(m, 16)); m = fmaxf(m, __shfl_xor(m, 32));
        float l = 0.f;
#pragma unroll
        for (int blk = 0; blk < 16; ++blk)
#pragma unroll
            for (int r = 0; r < 4; ++r) { const float p = __builtin_amdgcn_exp2f(s[blk][r] - m); s[blk][r] = p; l += p; }
        l += __shfl_xor(l, 16); l += __shfl_xor(l, 32);
        f32x4 o[8];
#pragma unroll
        for (int db = 0; db < 8; ++db) o[db] = (f32x4){0.f, 0.f, 0.f, 0.f};
#pragma unroll
        for (int kp = 0; kp < 8; ++kp) { const bf16x8 pf = pack_p(s[2 * kp], s[2 * kp + 1]);
#pragma unroll
            for (int db = 0; db < 8; ++db) { const bf16x8 af = vt_frag(Vl + (32 * kp + 4 * g + (c >> 2)) * KS + (16 * db + 4 * (c & 3)) * 2, 16 * KS); o[db] = MFMA16(af, pf, o[db]); }
            __builtin_amdgcn_sched_barrier(0); }
        const float inv = 1.f / l;
#pragma unroll
        for (int db = 0; db < 8; ++db) { const f32x4 v = o[db] * inv; u32x2 wv; wv.x = pk2(v[0], v[1]); wv.y = pk2(v[2], v[3]); *(u32x2*)(OX + t * 512 + hx * 128 + 16 * db + 4 * g) = wv; }
    }
    __syncthreads();
}

__device__ __forceinline__ int mono_i(float x) { int i = __float_as_int(x); return i ^ ((i >> 31) & 0x7fffffff); }
__device__ __forceinline__ float mono_f(int i) { return __int_as_float(i ^ ((i >> 31) & 0x7fffffff)); }
#define INS16(L, v) do { int _v = (v); _Pragma("unroll") for (int _k = 0; _k < 16; ++_k) { const int _t = max(L[_k], _v); _v = min(L[_k], _v); L[_k] = _t; } } while (0)
#define CE_DESC(x, y) do { const int _h = max((x), (y)), _l = min((x), (y)); (x) = _h; (y) = _l; } while (0)
#define SORT16_DESC(L) do { \
    CE_DESC(L[0], L[1]); \
    CE_DESC(L[2], L[3]); \
    CE_DESC(L[0], L[2]); \
    CE_DESC(L[1], L[3]); \
    CE_DESC(L[1], L[2]); \
    CE_DESC(L[4], L[5]); \
    CE_DESC(L[6], L[7]); \
    CE_DESC(L[4], L[6]); \
    CE_DESC(L[5], L[7]); \
    CE_DESC(L[5], L[6]); \
    CE_DESC(L[0], L[4]); \
    CE_DESC(L[2], L[6]); \
    CE_DESC(L[2], L[4]); \
    CE_DESC(L[1], L[5]); \
    CE_DESC(L[3], L[7]); \
    CE_DESC(L[3], L[5]); \
    CE_DESC(L[1], L[2]); \
    CE_DESC(L[3], L[4]); \
    CE_DESC(L[5], L[6]); \
    CE_DESC(L[8], L[9]); \
    CE_DESC(L[10], L[11]); \
    CE_DESC(L[8], L[10]); \
    CE_DESC(L[9], L[11]); \
    CE_DESC(L[9], L[10]); \
    CE_DESC(L[12], L[13]); \
    CE_DESC(L[14], L[15]); \
    CE_DESC(L[12], L[14]); \
    CE_DESC(L[13], L[15]); \
    CE_DESC(L[13], L[14]); \
    CE_DESC(L[8], L[12]); \
    CE_DESC(L[10], L[14]); \
    CE_DESC(L[10], L[12]); \
    CE_DESC(L[9], L[13]); \
    CE_DESC(L[11], L[15]); \
    CE_DESC(L[11], L[13]); \
    CE_DESC(L[9], L[10]); \
    CE_DESC(L[11], L[12]); \
    CE_DESC(L[13], L[14]); \
    CE_DESC(L[0], L[8]); \
    CE_DESC(L[4], L[12]); \
    CE_DESC(L[4], L[8]); \
    CE_DESC(L[2], L[10]); \
    CE_DESC(L[6], L[14]); \
    CE_DESC(L[6], L[10]); \
    CE_DESC(L[2], L[4]); \
    CE_DESC(L[6], L[8]); \
    CE_DESC(L[10], L[12]); \
    CE_DESC(L[1], L[9]); \
    CE_DESC(L[5], L[13]); \
    CE_DESC(L[5], L[9]); \
    CE_DESC(L[3], L[11]); \
    CE_DESC(L[7], L[15]); \
    CE_DESC(L[7], L[11]); \
    CE_DESC(L[3], L[5]); \
    CE_DESC(L[7], L[9]); \
    CE_DESC(L[11], L[13]); \
    CE_DESC(L[1], L[2]); \
    CE_DESC(L[3], L[4]); \
    CE_DESC(L[5], L[6]); \
    CE_DESC(L[7], L[8]); \
    CE_DESC(L[9], L[10]); \
    CE_DESC(L[11], L[12]); \
    CE_DESC(L[13], L[14]); \
} while (0)

__device__ __forceinline__ void bitonic_fix16(int (&L)[16]) {
    CE_DESC(L[0], L[8]); CE_DESC(L[1], L[9]); CE_DESC(L[2], L[10]); CE_DESC(L[3], L[11]); CE_DESC(L[4], L[12]); CE_DESC(L[5], L[13]); CE_DESC(L[6], L[14]); CE_DESC(L[7], L[15]);
    CE_DESC(L[0], L[4]); CE_DESC(L[1], L[5]); CE_DESC(L[2], L[6]); CE_DESC(L[3], L[7]); CE_DESC(L[8], L[12]); CE_DESC(L[9], L[13]); CE_DESC(L[10], L[14]); CE_DESC(L[11], L[15]);
    CE_DESC(L[0], L[2]); CE_DESC(L[1], L[3]); CE_DESC(L[4], L[6]); CE_DESC(L[5], L[7]); CE_DESC(L[8], L[10]); CE_DESC(L[9], L[11]); CE_DESC(L[12], L[14]); CE_DESC(L[13], L[15]);
    CE_DESC(L[0], L[1]); CE_DESC(L[2], L[3]); CE_DESC(L[4], L[5]); CE_DESC(L[6], L[7]); CE_DESC(L[8], L[9]); CE_DESC(L[10], L[11]); CE_DESC(L[12], L[13]); CE_DESC(L[14], L[15]);
}
__device__ __forceinline__ void merge16(int (&L)[16], int xm) {
    int P[16];
#pragma unroll
    for (int i = 0; i < 16; ++i) P[i] = __shfl_xor(L[i], xm);
#pragma unroll
    for (int i = 0; i < 16; ++i) L[i] = max(L[i], P[15 - i]);
    bitonic_fix16(L);
}
__device__ __forceinline__ void peer_topk_unit(LAS unsigned char* lds, int pm, int h, const bf16_t* PQ, const float* subk, int* EXP, float* GATE) {
    constexpr int KS = 272;
    const int tid = threadIdx.x, lane = tid & 63, c = lane & 15, g = lane >> 4; const int w = __builtin_amdgcn_readfirstlane(tid >> 6);
    const float* sk = subk + (size_t)h * 2 * 128 * 128;
    for (int i = tid; i < 8192; i += 512) { const int row = i >> 5, ch = i & 31; const f32x4 v = *(const f32x4*)(sk + (size_t)row * 128 + ch * 4);
        u32x2 wv; wv.x = pk2(v[0], v[1]); wv.y = pk2(v[2], v[3]); *(LAS u32x2*)(lds + row * KS + ch * 8) = wv; }
    __syncthreads();
#pragma unroll 1
    for (int grp = 0; grp < 2; ++grp) {
        const size_t t = (size_t)pm * 256 + 32 * w + 16 * grp + c;
        int S1[16], S2[16];
        bf16x8 qall[2][4];
#pragma unroll
        for (int p = 0; p < 2; ++p)
#pragma unroll
            for (int ks = 0; ks < 4; ++ks) qall[p][ks] = *(const bf16x8*)(PQ + t * DM + h * 256 + p * 128 + ks * 32 + 8 * g);
#pragma unroll
        for (int p = 0; p < 2; ++p) {
            bf16x8 qf[4];
#pragma unroll
            for (int ks = 0; ks < 4; ++ks) qf[ks] = qall[p][ks];
            int A[16], B[16];
#pragma unroll
            for (int blk = 0; blk < 8; ++blk) { f32x4 acc = {0.f, 0.f, 0.f, 0.f};
#pragma unroll
                for (int ks = 0; ks < 4; ++ks) { const bf16x8 kf = *(LAS const bf16x8*)(lds + (p * 128 + 16 * blk + c) * KS + (ks * 32 + 8 * g) * 2); acc = MFMA16(kf, qf[ks], acc); }
#pragma unroll
                for (int r = 0; r < 4; ++r) { const int idx = 16 * blk + 4 * g + r; const int key = (mono_i(acc[r]) & ~127) | (127 - idx); if (blk < 4) A[4 * blk + r] = key; else B[4 * (blk - 4) + r] = key; }
                __builtin_amdgcn_sched_barrier(0); }
            SORT16_DESC(A); SORT16_DESC(B);
#pragma unroll
            for (int i = 0; i < 16; ++i) A[i] = max(A[i], B[15 - i]);
            bitonic_fix16(A);
            merge16(A, 16); merge16(A, 32);
#pragma unroll
            for (int k = 0; k < 16; ++k) { if (p == 0) S1[k] = A[k]; else S2[k] = A[k]; }
        }
        float s1v[16], s2v[16];
#pragma unroll
        for (int k = 0; k < 16; ++k) { s1v[k] = mono_f(S1[k] & ~127); s2v[k] = mono_f(S2[k] & ~127); }
        int Mx[16];
#pragma unroll
        for (int k = 0; k < 16; ++k) Mx[k] = (int)0x80000000;
#define STAIR4(a0, b0, a1, b1, a2, b2, a3, b3) do { const float _c0 = s1v[a0] + s2v[b0], _c1 = s1v[a1] + s2v[b1], _c2 = s1v[a2] + s2v[b2], _c3 = s1v[a3] + s2v[b3]; \
        const float _m = (g == 0) ? _c0 : (g == 1) ? _c1 : (g == 2) ? _c2 : _c3; const int _cd = (g == 0) ? (255 - (16 * a0 + b0)) : (g == 1) ? (255 - (16 * a1 + b1)) : (g == 2) ? (255 - (16 * a2 + b2)) : (255 - (16 * a3 + b3)); \
        INS16(Mx, (mono_i(_m) & ~255) | _cd); } while (0)
#define STAIR2(a0, b0, a1, b1) do { const float _c0 = s1v[a0] + s2v[b0], _c1 = s1v[a1] + s2v[b1]; const float _m = (g == 0) ? _c0 : _c1; const int _cd = (g == 0) ? (255 - (16 * a0 + b0)) : (255 - (16 * a1 + b1)); \
        const int _key = (mono_i(_m) & ~255) | _cd; INS16(Mx, (g < 2) ? _key : (int)0x80000000); } while (0)
        STAIR4(0, 0, 0, 1, 0, 2, 0, 3);
        STAIR4(0, 4, 0, 5, 0, 6, 0, 7);
        STAIR4(0, 8, 0, 9, 0, 10, 0, 11);
        STAIR4(0, 12, 0, 13, 0, 14, 0, 15);
        STAIR4(1, 0, 1, 1, 1, 2, 1, 3);
        STAIR4(1, 4, 1, 5, 1, 6, 1, 7);
        STAIR4(2, 0, 2, 1, 2, 2, 2, 3);
        STAIR4(2, 4, 3, 0, 3, 1, 3, 2);
        STAIR4(3, 3, 4, 0, 4, 1, 4, 2);
        STAIR4(5, 0, 5, 1, 6, 0, 6, 1);
        STAIR4(7, 0, 7, 1, 8, 0, 9, 0);
        STAIR4(10, 0, 11, 0, 12, 0, 13, 0);
        STAIR2(14, 0, 15, 0);
#undef STAIR4
#undef STAIR2
        merge16(Mx, 16); merge16(Mx, 32);
        const float top = mono_f(Mx[0] & ~255); float wg[4]; int ex[4]; float wsum = 0.f;
#pragma unroll
        for (int i = 0; i < 4; ++i) { const int key = (g == 0) ? Mx[i] : (g == 1) ? Mx[4 + i] : (g == 2) ? Mx[8 + i] : Mx[12 + i];
            wg[i] = __expf(mono_f(key & ~255) - top); wsum += wg[i];
            const int ab = 255 - (key & 255), a = ab >> 4, bb = ab & 15; int e1 = 0, e2 = 0;
#pragma unroll
            for (int k = 0; k < 16; ++k) { e1 = (a == k) ? (127 - (S1[k] & 127)) : e1; e2 = (bb == k) ? (127 - (S2[k] & 127)) : e2; }
            ex[i] = e1 * 128 + e2; }
        wsum += __shfl_xor(wsum, 16); wsum += __shfl_xor(wsum, 32);
        const float inv = 1.f / wsum;
        *(int4*)(EXP + t * 128 + h * 16 + 4 * g) = make_int4(ex[0], ex[1], ex[2], ex[3]);
        *(f32x4*)(GATE + t * 128 + h * 16 + 4 * g) = (f32x4){wg[0] * inv, wg[1] * inv, wg[2] * inv, wg[3] * inv};
    }
    __syncthreads();
}
typedef __bf16 v32bf16 __attribute__((ext_vector_type(32)));
typedef unsigned v6u32 __attribute__((ext_vector_type(6)));
constexpr int ROWB = 1536;
__device__ __forceinline__ float fdot2bf(bf16x2_t a, bf16x2_t b, float c) { return __builtin_amdgcn_fdot2_f32_bf16(a, b, c, false); }
__device__ __forceinline__ void row_to_fp6(const float* src, const float* colgain, unsigned char* dst, float* inv, int lane) {
    f32x4 v[8]; float am = 0.f;
#pragma unroll
    for (int j = 0; j < 8; ++j) { v[j] = *(const f32x4*)(src + 32 * lane + 4 * j); if (colgain) v[j] = v[j] * *(const f32x4*)(colgain + 32 * lane + 4 * j);
        am = fmaxf(am, fmaxf(fmaxf(fabsf(v[j][0]), fabsf(v[j][1])), fmaxf(fabsf(v[j][2]), fabsf(v[j][3])))); }
#pragma unroll
    for (int o = 1; o < 64; o <<= 1) am = fmaxf(am, __shfl_xor(am, o));
    float S = 1.f;
    if (am > 1e-30f) S = __uint_as_float(__float_as_uint(7.5f / am) & 0x7f800000u);
    unsigned pk[6] = {0u, 0u, 0u, 0u, 0u, 0u};
#pragma unroll
    for (int j = 0; j < 8; ++j)
#pragma unroll
        for (int i = 0; i < 4; ++i) { const float t = v[j][i] * S, a = fabsf(t);
            const float cf = (a < 2.f) ? rintf(a * 8.f) : (a < 4.f) ? 16.f + rintf((a - 2.f) * 4.f) : 24.f + rintf((a - 4.f) * 2.f);
            unsigned cd = (unsigned)fminf(cf, 31.f); if (t < 0.f) cd |= 32u;
            const int e = 4 * j + i, bit = 6 * e, dw = bit >> 5, sh = bit & 31;
            pk[dw] |= cd << sh; if (sh > 26) pk[dw + 1] |= cd >> (32 - sh); }
    *(u32x4*)(dst + 16 * lane) = (u32x4){pk[0], pk[1], pk[2], pk[3]}; *(u32x2*)(dst + 1024 + 8 * lane) = (u32x2){pk[4], pk[5]};
    if (lane == 0) *inv = 1.f / S;
}
__device__ __forceinline__ v32bf16 sw_unpack6(v6u32 s) {
    v32bf16 r;
#pragma unroll
    for (int e = 0; e < 32; ++e) { const int bit = 6 * e, dw = bit >> 5, sh = bit & 31; unsigned cd = s[dw] >> sh; if (sh > 26) cd |= s[dw + 1] << (32 - sh); cd &= 63u;
        const unsigned m = cd & 31u; float a = (m < 16u) ? (float)m * 0.125f : (m < 24u) ? 2.f + (float)(m - 16u) * 0.25f : 4.f + (float)(m - 24u) * 0.5f; if (cd & 32u) a = -a; r[e] = (__bf16)a; }
    return r;
}
constexpr int RING = 4;
typedef unsigned v16u32 __attribute__((ext_vector_type(16)));
__device__ __forceinline__ bf16x2_t as_pair(unsigned w) { return __builtin_bit_cast(bf16x2_t, w); }
#define PAIR(r, p) as_pair((r)[(p)])
__device__ __forceinline__ void peer_gather_token(LAS float* cw, LAS int* ew, size_t t, const float* X, const float* g_ffn, const float* g_fin,
                                                  const unsigned char* UB, const unsigned char* VB, const float* SU, const float* SV, const int* EXP, const float* GATE, float* OUT, int lane, LAS f32x4* xstash) {
    f32x4 xv[8]; float ss = 0.f;
    const float* xr = X + t * DM + 32 * lane;
#pragma unroll
    for (int j = 0; j < 8; ++j) xv[j] = *(const f32x4*)(xr + 4 * j);
#pragma unroll
    for (int j = 0; j < 8; ++j) ss += (xv[j][0] * xv[j][0] + xv[j][1] * xv[j][1]) + (xv[j][2] * xv[j][2] + xv[j][3] * xv[j][3]);
    ss = wave_sum(ss);
    const float rs = rsqrtf(ss * (1.f / DM) + EPS);
    bf16x2_t xb[16];
#pragma unroll
    for (int j = 0; j < 8; ++j) { const f32x4 a = xv[j] * rs * *(const f32x4*)(g_ffn + 32 * lane + 4 * j); xb[2 * j] = __builtin_bit_cast(bf16x2_t, pk2(a[0], a[1])); xb[2 * j + 1] = __builtin_bit_cast(bf16x2_t, pk2(a[2], a[3])); }
    {
        int k0 = (EXP[t * 128 + lane] << 7) | lane, k1 = (EXP[t * 128 + 64 + lane] << 7) | (64 + lane);
#pragma unroll
        for (int k = 2; k <= 128; k <<= 1)
#pragma unroll
            for (int j = k >> 1; j > 0; j >>= 1) {
                if (j == 64) { const int a = min(k0, k1), c = max(k0, k1); k0 = a; k1 = c; }
                else { const int p0 = __shfl_xor(k0, j), p1 = __shfl_xor(k1, j); const bool lower = (lane & j) == 0;
                       const bool asc0 = (k >= 64) ? true : ((lane & k) == 0), asc1 = (k == 128) ? true : ((k == 64) ? false : ((lane & k) == 0));
                       k0 = (lower == asc0) ? min(k0, p0) : max(k0, p0); k1 = (lower == asc1) ? min(k1, p1) : max(k1, p1); }
            }
        ew[lane] = k0; ew[lane + 64] = k1; }
#pragma unroll
    for (int j = 0; j < 8; ++j) xstash[j * 64 + lane] = xv[j];
    asm volatile("s_waitcnt lgkmcnt(0)" ::: "memory");
    u32x4 ra[RING]; u32x2 rc[RING];
#define ROWLOAD(BASE, slot, k) do { const int _e = __builtin_amdgcn_readfirstlane(ew[(k)]) >> 7; const unsigned char* _rp = (BASE) + (size_t)_e * ROWB; \
        ra[slot] = *(const u32x4*)(_rp + 16 * lane); rc[slot] = *(const u32x2*)(_rp + 1024 + 8 * lane); } while (0)
#ifdef PROBE_SW_UNPACK
#define ROWCVT(slot) sw_unpack6((v6u32){ra[slot].x, ra[slot].y, ra[slot].z, ra[slot].w, rc[slot].x, rc[slot].y})
#else
#define ROWCVT(slot) __builtin_amdgcn_cvt_scalef32_pk32_bf16_fp6((v6u32){ra[slot].x, ra[slot].y, ra[slot].z, ra[slot].w, rc[slot].x, rc[slot].y}, 1.0f)
#endif
#pragma unroll
    for (int j = 0; j < RING; ++j) ROWLOAD(UB, j, j);
    const int eloc = ((lane >> 5) & 1) * 8 + ((lane >> 4) & 1) * 4 + ((lane >> 3) & 1) * 2 + ((lane >> 2) & 1);
    for (int b = 0; b < 8; ++b) {
        float part[16];
#pragma unroll
        for (int j = 0; j < 16; ++j) { const int slot = j & (RING - 1); const v16u32 r = __builtin_bit_cast(v16u32, ROWCVT(slot)); float a0 = 0.f, a1 = 0.f;
#pragma unroll
            for (int q = 0; q < 8; ++q) { a0 = fdot2bf(PAIR(r, 2 * q), xb[2 * q], a0); a1 = fdot2bf(PAIR(r, 2 * q + 1), xb[2 * q + 1], a1); }
            part[j] = a0 + a1;
            { const int sn = 16 * b + j + RING; const unsigned char* nb = (sn < 128) ? UB : VB; ROWLOAD(nb, slot, sn & 127); } }
        float q8[8], q4[4], q2[2], q1;
#pragma unroll
        for (int i = 0; i < 8; ++i) { const bool up = (lane & 32) != 0; const float snd = up ? part[i] : part[i + 8], kp = up ? part[i + 8] : part[i]; q8[i] = kp + __shfl_xor(snd, 32); }
#pragma unroll
        for (int i = 0; i < 4; ++i) { const bool up = (lane & 16) != 0; const float snd = up ? q8[i] : q8[i + 4], kp = up ? q8[i + 4] : q8[i]; q4[i] = kp + __shfl_xor(snd, 16); }
#pragma unroll
        for (int i = 0; i < 2; ++i) { const bool up = (lane & 8) != 0; const float snd = up ? q4[i] : q4[i + 2], kp = up ? q4[i + 2] : q4[i]; q2[i] = kp + __shfl_xor(snd, 8); }
        { const bool up = (lane & 4) != 0; const float snd = up ? q2[0] : q2[1], kp = up ? q2[1] : q2[0]; q1 = kp + __shfl_xor(snd, 4); }
        q1 += __shfl_xor(q1, 1); q1 += __shfl_xor(q1, 2);
        if ((lane & 3) == 0) { const int k = 16 * b + eloc; const int key = ew[k], e = key >> 7; const float av = q1 * SU[e]; const float gl = 0.5f * av * (1.f + erff(av * 0.70710678118654752f)); cw[k] = gl * GATE[t * 128 + (key & 127)] * SV[e]; }
    }
    asm volatile("s_waitcnt lgkmcnt(0)" ::: "memory");
    float acc[32];
#pragma unroll
    for (int i = 0; i < 32; ++i) acc[i] = 0.f;
    for (int k0 = 0; k0 < 128; k0 += RING) {
#pragma unroll
        for (int j = 0; j < RING; ++j) { const float cv = cw[k0 + j]; const unsigned clo_u = pk2(cv, 0.f); const bf16x2_t clo = __builtin_bit_cast(bf16x2_t, clo_u), chi = __builtin_bit_cast(bf16x2_t, clo_u << 16);
            const v16u32 r = __builtin_bit_cast(v16u32, ROWCVT(j));
#pragma unroll
            for (int q = 0; q < 16; ++q) { acc[2 * q] = fdot2bf(PAIR(r, q), clo, acc[2 * q]); acc[2 * q + 1] = fdot2bf(PAIR(r, q), chi, acc[2 * q + 1]); }
            const int kn = min(k0 + j + RING, 127); ROWLOAD(VB, j, kn); }
    }
#undef ROWLOAD
#undef ROWCVT
#ifdef PROBE_NO_PEER
#pragma unroll
    for (int i = 0; i < 32; ++i) acc[i] = 0.f;
#endif
    float s3 = 0.f;
#pragma unroll
    for (int j = 0; j < 8; ++j) xv[j] = xstash[j * 64 + lane];
#pragma unroll
    for (int j = 0; j < 8; ++j)
#pragma unroll
        for (int i = 0; i < 4; ++i) { xv[j][i] += acc[4 * j + i]; s3 += xv[j][i] * xv[j][i]; }
    s3 = wave_sum(s3);
    const float r3 = rsqrtf(s3 * (1.f / DM) + EPS);
    float* orow = OUT + t * DM + 32 * lane;
#pragma unroll
    for (int j = 0; j < 8; ++j) { const f32x4 g0 = *(const f32x4*)(g_fin + 32 * lane + 4 * j); *(f32x4*)(orow + 4 * j) = xv[j] * r3 * g0; }
}

constexpr unsigned NF1 = 896;
__device__ __forceinline__ void fp8_chunk(int chunk, int wave, int lane, const float* peer_u, const float* peer_v, const float* g_ffn, unsigned char* UB, unsigned char* VB, float* SU, float* SV) {
#pragma unroll 1
    for (int r = 0; r < 2; ++r) { const int row = chunk * 16 + wave * 2 + r;
        if (row < 16384) row_to_fp6(peer_u + (size_t)row * DM, nullptr, UB + (size_t)row * ROWB, SU + row, lane);
        else row_to_fp6(peer_v + (size_t)(row - 16384) * DM, nullptr, VB + (size_t)(row - 16384) * ROWB, SV + (row - 16384), lane); }
}
constexpr int NWAVES = 8, LDS_BYTES = 163840, MISC_OFF = 159744;
constexpr int N_PHASES = 10;
struct Args { const void* in[21]; float* out; unsigned char* ws; int ph_lo, ph_hi; float inv_freq[128]; };

#define IN_x ((const float*)((const float*)args.in[0]))
#define IN_mem ((const float*)((const float*)args.in[1]))
#define IN_positions ((const int*)((const int*)args.in[2]))
#define IN_g_mix ((const float*)((const float*)args.in[3]))
#define IN_w_in ((const float*)((const float*)args.in[4]))
#define IN_sinks ((const float*)((const float*)args.in[5]))
#define IN_att_gain ((const float*)((const float*)args.in[6]))
#define IN_ret_gain ((const float*)((const float*)args.in[7]))
#define IN_w_out ((const float*)((const float*)args.in[8]))
#define IN_g_cross ((const float*)((const float*)args.in[9]))
#define IN_g_mem ((const float*)((const float*)args.in[10]))
#define IN_w_xq ((const float*)((const float*)args.in[11]))
#define IN_w_xk ((const float*)((const float*)args.in[12]))
#define IN_w_xv ((const float*)((const float*)args.in[13]))
#define IN_w_xo ((const float*)((const float*)args.in[14]))
#define IN_g_ffn ((const float*)((const float*)args.in[15]))
#define IN_w_pq ((const float*)((const float*)args.in[16]))
#define IN_subk ((const float*)((const float*)args.in[17]))
#define IN_peer_u ((const float*)((const float*)args.in[18]))
#define IN_peer_v ((const float*)((const float*)args.in[19]))
#define IN_g_fin ((const float*)((const float*)args.in[20]))
#define IN_out ((float*)(args.out))
#define WIN ((bf16_t*)((bf16_t*)(ws + WS_WIN)))
#define WOUT ((bf16_t*)((bf16_t*)(ws + WS_WOUT)))
#define WXQ ((bf16_t*)((bf16_t*)(ws + WS_WXQ)))
#define WXKV ((bf16_t*)((bf16_t*)(ws + WS_WXKV)))
#define WXO ((bf16_t*)((bf16_t*)(ws + WS_WXO)))
#define WPQ ((bf16_t*)((bf16_t*)(ws + WS_WPQ)))
#define XB ((bf16_t*)((bf16_t*)(ws + WS_XB)))
#define MEMB ((bf16_t*)((bf16_t*)(ws + WS_MEMB)))
#define COSA ((float*)((float*)(ws + WS_COSA)))
#define SINA ((float*)((float*)(ws + WS_SINA)))
#define COSR ((float*)((float*)(ws + WS_COSR)))
#define SINR ((float*)((float*)(ws + WS_SINR)))
#define SS0 ((float*)((float*)(ws + WS_SS0)))
#define SS1 ((float*)((float*)(ws + WS_SS1)))
#define SS2 ((float*)((float*)(ws + WS_SS2)))
#define SSM ((float*)((float*)(ws + WS_SSM)))
#define KX ((bf16_t*)((bf16_t*)(ws + WS_KX)))
#define VX ((bf16_t*)((bf16_t*)(ws + WS_VX)))
#define QX ((bf16_t*)((bf16_t*)(ws + WS_QX)))
#define OX ((bf16_t*)((bf16_t*)(ws + WS_OX)))
#define EXPI ((int*)((int*)(ws + WS_EXP)))
#define GATE ((float*)((float*)(ws + WS_GATE)))
#define Y ((bf16_t*)((bf16_t*)(ws + WS_Y)))
#define PQ ((bf16_t*)((bf16_t*)(ws + WS_Y)))
#define QA ((bf16_t*)((bf16_t*)(ws + WS_QA)))
#define KA ((bf16_t*)((bf16_t*)(ws + WS_KA)))
#define VA ((bf16_t*)((bf16_t*)(ws + WS_VA)))
#define QR ((bf16_t*)((bf16_t*)(ws + WS_QR)))
#define KR ((bf16_t*)((bf16_t*)(ws + WS_KR)))
#define VR ((bf16_t*)((bf16_t*)(ws + WS_VR)))
#define GR ((bf16_t*)((bf16_t*)(ws + WS_GR)))
#define UB ((unsigned char*)(ws + WS_UB))
#define VB ((unsigned char*)(ws + WS_VB))
#define SU ((float*)((float*)(ws + WS_SU)))
#define SV ((float*)((float*)(ws + WS_SV)))
__global__ void __launch_bounds__(NWAVES * 64, 2) fwd_kernel(Args args) {
    extern __shared__ __attribute__((aligned(16))) unsigned char lds_raw[];
    LAS unsigned char* lds = (LAS unsigned char*)lds_raw;
    const int tid = threadIdx.x, lane = tid & 63; const int wave = __builtin_amdgcn_readfirstlane(tid >> 6);
    const int G = gridDim.x; const int bx = blockIdx.x; const int vcu = (G % 8 == 0) ? (bx % 8) * (G / 8) + bx / 8 : bx;
    unsigned char* ws = args.ws;
    float* const out_base = args.out;
    for (int u = tid; u < (LDS_BYTES - MISC_OFF) / 4; u += NWAVES * 64) ((LAS unsigned*)(lds + MISC_OFF))[u] = 0u;
    __syncthreads();
    const int lo = args.ph_lo, hi = args.ph_hi;
    const bool use_bar = (hi - lo) > 1;
    XcdBarrier bar; bar.bar = (unsigned*)(ws + WS_CTL) + 1024; bar.x = 0; bar.st = nullptr;
    if (use_bar) bar = xcd_barrier_post((unsigned*)(ws + WS_CTL) + 1024, (volatile LAS unsigned*)(lds + MISC_OFF) + 8);
#ifdef ONLY_PHASE
#define PHASE_ON(k) ((k) == ONLY_PHASE)
#else
#define PHASE_ON(k) true
#endif
#define IN(k) (lo <= (k) && (k) < hi)
#ifdef REPEAT_PHASE
#define REP(k) for (int _rep = 0; _rep < (((k) == REPEAT_PHASE) ? 2 : 1); ++_rep)
#else
#define REP(k)
#endif
#define SEAM(k) do { if (IN(k) && IN((k) + 1)) xcd_barrier(bar); } while (0)
    const int gw = vcu * NWAVES + wave, NGW = G * NWAVES;

    REP(0) if (PHASE_ON(0) && IN(0)) {
        LAS float* scr = (LAS float*)(lds + wave * 8448);
        constexpr int I_IN = 32 * (IN_COLS / 32), I_XQ = 32 * 16;
        constexpr int NITEMS = I_IN + 2 * I_XQ;
        for (int it = gw; it < NITEMS; it += NGW) {
            int r = it;
            if (r < I_IN) { p0_transpose_item<true>(IN_w_in, IN_g_mix, DM, IN_COLS, WIN, 0, scr, r, lane); continue; } r -= I_IN;
            if (r < I_XQ) { p0_transpose_item<false>(IN_w_xk, IN_g_mem, DM, 512, WXKV, 0, scr, r, lane); continue; } r -= I_XQ;
            p0_transpose_item<false>(IN_w_xv, IN_g_mem, DM, 512, WXKV, 512, scr, r, lane);
        }
        for (int m = gw; m < T_TOK; m += 2 * NGW) row2_to_bf16(IN_x + (size_t)m * DM, XB + (size_t)m * DM, SS0 + m, (size_t)NGW, lane);
        for (int m = gw; m < MT; m += NGW) row_to_bf16(IN_mem + (size_t)m * DM, MEMB + (size_t)m * DM, SSM + m, lane);
        const int gt = vcu * (NWAVES * 64) + tid, NGT = G * NWAVES * 64;
        for (int i = gt; i < T_TOK * 128; i += NGT) { const int tok = i >> 7, f = i & 127; const float ang = (float)IN_positions[tok] * args.inv_freq[f]; float cc, sn; sincos_red(ang, cc, sn);
            COSR[i] = cc; SINR[i] = sn; }
        for (int i = gt; i < T_TOK * 32; i += NGT) { const int tok = i >> 5, f = i & 31; const float ang = (float)IN_positions[tok] * args.inv_freq[4 * f]; float cc, sn; sincos_red(ang, cc, sn);
            COSA[i] = cc; SINA[i] = sn; }
        for (int i = gt; i < T_TOK; i += NGT) { SS1[i] = 0.f; SS2[i] = 0.f; }
        __syncthreads();
    }
    SEAM(0);
    REP(1) if (PHASE_ON(1) && IN(1)) {
        pg8::Sched S; S.A = (const char*)XB; S.B = (const char*)WIN; S.nM = T_TOK / 256; S.nN = IN_COLS / 256; S.nwg = S.nM * S.nN;
        S.A2 = (const char*)MEMB; S.B2 = (const char*)WXKV; S.nM2 = MT / 256; S.nwg2 = (MT / 256) * 4; S.G = G; S.c = bx; S.WGM = WGM_P1; S.tstep = (size_t)256 * DM * 2;
        EpiP1 E{ws};
        pg8::gemm_phase<EpiP1>(lds, DM, S, E);
        unsigned* qctr = (unsigned*)(ws + WS_CTL) + 8192 + 64; volatile LAS unsigned* qw = (volatile LAS unsigned*)(lds + MISC_OFF) + 16;
        LAS float* scr = (LAS float*)(lds + wave * 8448);
        for (;;) {
            if (tid == 0) qw[0] = atomicAdd(qctr, 1u);
            __syncthreads(); const unsigned chunk = qw[0]; __syncthreads();
            if (chunk >= 640u + NF1) break;
            if (chunk < 640u) { int r = (int)chunk * 8 + wave;
                if (r < 2048) p0_transpose_item<false>(IN_w_out, nullptr, DM, DM, WOUT, 0, scr, r, lane);
                else if ((r -= 2048) < 512) p0_transpose_item<false>(IN_w_xq, IN_g_cross, DM, 512, WXQ, 0, scr, r, lane);
                else if ((r -= 512) < 512) p0_transpose_item<false>(IN_w_xo, nullptr, 512, DM, WXO, 0, scr, r, lane);
                else p0_transpose_item<false>(IN_w_pq, IN_g_ffn, DM, DM, WPQ, 0, scr, r - 512, lane);
            } else fp8_chunk((int)chunk - 640, wave, lane, IN_peer_u, IN_peer_v, IN_g_ffn, UB, VB, SU, SV);
        }
    }
    SEAM(1);
    REP(2) if (PHASE_ON(2) && IN(2)) {
#ifdef PROBE_RET_X
        for (int rr = 0; rr < PROBE_RET_X; ++rr)
#endif
        for (int u = vcu; u < 256; u += G) { const int bh = u >> 3, s = u & 7; ret_unit(lds, bh >> 2, bh & 3, s, QR, KR, VR, GR, IN_ret_gain, Y); ret_unit(lds, bh >> 2, bh & 3, 15 - s, QR, KR, VR, GR, IN_ret_gain, Y); }
#ifdef PROBE_SWA_X
        for (int rr = 0; rr < PROBE_SWA_X; ++rr)
#endif
        for (int u = vcu; u < 256; u += G) swa_unit(lds, u >> 5, (u >> 1) & 15, u & 1, QA, KA, VA, IN_sinks, IN_att_gain, Y);
    }
    SEAM(2);
    if (PHASE_ON(3) && IN(3)) {
        pg8::Sched S; S.A = (const char*)Y; S.B = (const char*)WOUT; S.WGM = WGM_P3; S.nM = T_TOK / 256; S.nN = DM / 256; S.nwg = S.nM * S.nN; S.A2 = nullptr; S.B2 = nullptr; S.nM2 = 1; S.nwg2 = 0; S.G = G; S.c = bx; S.tstep = (size_t)256 * DM * 2;
        EpiRes1 E{IN_x, XB, SS1};
        pg8::gemm_phase<EpiRes1, false>(lds, DM, S, E);
    }
    SEAM(3);
    REP(4) if (PHASE_ON(4) && IN(4)) {
        pg8::Sched S; S.A = (const char*)XB; S.B = (const char*)WXQ; S.WGM = WGM_P4; S.nM = T_TOK / 256; S.nN = 2; S.nwg = S.nM * S.nN; S.A2 = nullptr; S.B2 = nullptr; S.nM2 = 1; S.nwg2 = 0; S.G = G; S.c = bx; S.tstep = (size_t)256 * DM * 2;
        EpiScale E{QX, 512, SS1, C3Q};
        pg8::gemm_phase<EpiScale>(lds, DM, S, E);
        unsigned* qctr = (unsigned*)(ws + WS_CTL) + 8192; volatile LAS unsigned* qw = (volatile LAS unsigned*)(lds + MISC_OFF) + 16;
        for (;;) {
            if (tid == 0) qw[0] = atomicAdd(qctr, 1u);
            __syncthreads(); const unsigned chunk = qw[0] + NF1; __syncthreads();
            if (chunk >= 2048u) break;
            fp8_chunk((int)chunk, wave, lane, IN_peer_u, IN_peer_v, IN_g_ffn, UB, VB, SU, SV);
        }
    }
    SEAM(4);
    REP(5) if (PHASE_ON(5) && IN(5)) { for (int u = vcu; u < 256; u += G) xattn_unit(lds, u >> 5, (u >> 3) & 3, u & 7, QX, KX, VX, OX); }
    SEAM(5);
    if (PHASE_ON(6) && IN(6)) {
        pg8::Sched S; S.A = (const char*)OX; S.B = (const char*)WXO; S.WGM = WGM_P6; S.nM = T_TOK / 256; S.nN = DM / 256; S.nwg = S.nM * S.nN; S.A2 = nullptr; S.B2 = nullptr; S.nM2 = 1; S.nwg2 = 0; S.G = G; S.c = bx; S.tstep = (size_t)256 * 512 * 2;
        EpiRes2 E{IN_out, XB, SS2};
        pg8::gemm_phase<EpiRes2, false>(lds, 512, S, E);
    }
    SEAM(6);
    REP(7) if (PHASE_ON(7) && IN(7)) {
        pg8::Sched S; S.A = (const char*)XB; S.B = (const char*)WPQ; S.WGM = WGM_P7; S.nM = T_TOK / 256; S.nN = DM / 256; S.nwg = S.nM * S.nN; S.A2 = nullptr; S.B2 = nullptr; S.nM2 = 1; S.nwg2 = 0; S.G = G; S.c = bx; S.tstep = (size_t)256 * DM * 2;
        EpiScale E{PQ, DM, SS2, 1.f};
        pg8::gemm_phase<EpiScale>(lds, DM, S, E);
        asm volatile("s_waitcnt vmcnt(0)" ::: "memory"); __syncthreads();
        { pg8::Unit u; for (int i = 0; S.next(i, u); ++i) peer_topk_unit(lds, u.pm, u.pn, PQ, IN_subk, EXPI, GATE); }
    }
    SEAM(7);
    if (PHASE_ON(9) && IN(9)) {
        LAS float* cw = (LAS float*)(lds + wave * 1024); LAS int* ew = (LAS int*)(lds + wave * 1024 + 512);
        LAS f32x4* xstash = (LAS f32x4*)(lds + 8192 + wave * 8192);
        for (int t = gw; t < T_TOK; t += NGW) peer_gather_token(cw, ew, (size_t)t, IN_out, IN_g_ffn, IN_g_fin, UB, VB, SU, SV, EXPI, GATE, IN_out, lane, xstash);
    }
#undef IN
#undef SEAM
}

extern "C" void kernel_launch(void* const* d_in, const int* in_sizes, int n_in, void* d_out, int out_size, void* d_ws, size_t ws_size, hipStream_t stream) {
    static int grid = 0;
    if (grid == 0) {
        if (n_in != 21 || out_size != T_TOK * DM || ws_size < WS_END) { fprintf(stderr, "kernel_launch: unexpected problem (n_in %d out %d ws %zu)\n", n_in, out_size, ws_size); grid = -1; return; }
        int dev = 0, cus = 0;
        if (hipGetDevice(&dev) != hipSuccess || hipDeviceGetAttribute(&cus, hipDeviceAttributeMultiprocessorCount, dev) != hipSuccess) { grid = -1; return; }
        if (hipFuncSetAttribute((const void*)fwd_kernel, hipFuncAttributeMaxDynamicSharedMemorySize, LDS_BYTES) != hipSuccess) { fprintf(stderr, "kernel_launch: hipFuncSetAttribute failed\n"); grid = -1; return; }
        (void)hipGetLastError();
        grid = cus;
    }
    if (grid < 0) return;
    (void)hipMemsetAsync((char*)d_ws + WS_CTL, 0, CTL_ZERO_BYTES, stream);
    Args a{};
    for (int i = 0; i < 21; ++i) a.in[i] = d_in[i];
    a.out = (float*)d_out; a.ws = (unsigned char*)d_ws;
    for (int i = 0; i < 128; ++i) a.inv_freq[i] = (float)pow(10000.0, -(double)(2 * i) / 256.0);
#ifdef MK_PER_PHASE
    for (int p = 0; p < N_PHASES; ++p) { a.ph_lo = p; a.ph_hi = p + 1;
#ifdef REPEAT_LAUNCH
        if (p == REPEAT_LAUNCH) for (int r = 0; r < 4; ++r) hipLaunchKernelGGL(fwd_kernel, dim3(grid), dim3(NWAVES * 64), LDS_BYTES, stream, a);
#endif
        hipLaunchKernelGGL(fwd_kernel, dim3(grid), dim3(NWAVES * 64), LDS_BYTES, stream, a); }
#else
    a.ph_lo = 0; a.ph_hi = N_PHASES; hipLaunchKernelGGL(fwd_kernel, dim3(grid), dim3(NWAVES * 64), LDS_BYTES, stream, a);
#endif
}
```

```cpp
#include <hip/hip_runtime.h>
#include <cstdio>
#include <cstdint>
#include <cmath>
#ifndef WGM_P1
#define WGM_P1 4
#endif
#ifndef WGM_P3
#define WGM_P3 4
#endif
#ifndef WGM_P4
#define WGM_P4 4
#endif
#ifndef WGM_P6
#define WGM_P6 4
#endif
#ifndef WGM_P7
#define WGM_P7 4
#endif
namespace pg8 {
#define PG8_LAS __attribute__((address_space(3)))
typedef unsigned short bf16_t;
typedef short bf16x8 __attribute__((ext_vector_type(8)));
typedef float f32x4 __attribute__((ext_vector_type(4)));
typedef unsigned u32x4 __attribute__((ext_vector_type(4)));
typedef unsigned u32x2 __attribute__((ext_vector_type(2)));
constexpr int BM = 256, BK = 64, HALF = 128, HTB = HALF * BK * 2  , STAGE_BYTES = 8 * HTB, NXCD = 8;

__host__ __device__ __forceinline__ int lds_byte(int r, int c) { const int st = (r >> 4) * 2 + (c >> 5), rr = r & 15, cc = c & 31, ob = rr * 64 + cc * 2; return st * 1024 + (ob ^ (((ob >> 9) & 1) << 5)); }
__host__ __device__ __forceinline__ void stage_rc(int b, int& R, int& C) { const int st = b / 1024, sb = b % 1024, swz = sb ^ (((sb >> 9) & 1) << 5); R = (st >> 1) * 16 + swz / 64; C = (st & 1) * 32 + (swz % 64) / 2; }
__host__ __device__ __forceinline__ int perm32(int rho) { const int n = rho >> 4, i = rho & 15; return 8 * (i >> 2) + 4 * n + (i & 3); }

struct Unit { int pm, pn, kind; const char* a; const char* b; };

struct Sched {
    const char *A, *B, *A2, *B2; int nM, nN, nwg, nM2, nwg2, G, c, WGM; size_t tstep;
    __device__ __forceinline__ bool next(int i, Unit& u) const {
        const long L = (long)i * G + c;
        if (L < nwg) {
            int wgid = (int)L; { const int q = nwg / NXCD, r = nwg % NXCD, xcd = wgid % NXCD, off = wgid / NXCD; wgid = (xcd < r ? xcd * (q + 1) : r * (q + 1) + (xcd - r) * q) + off; }
            const int nig = WGM * nN, gid = wgid / nig, fm = gid * WGM, gsz = (nM - fm) < WGM ? (nM - fm) : WGM;
            u.pm = fm + ((wgid % nig) % gsz); u.pn = (wgid % nig) / gsz; u.kind = 0; u.a = A + (size_t)u.pm * tstep; u.b = B + (size_t)u.pn * tstep; return true;
        }
        const long L2 = L - nwg; if (L2 >= nwg2) return false;
        u.pm = (int)(L2 % nM2); u.pn = (int)(L2 / nM2); u.kind = 1; u.a = A2 + (size_t)u.pm * tstep; u.b = B2 + (size_t)u.pn * tstep; return true;
    }
};

__device__ __forceinline__ unsigned cvt_pk_bf16(float lo, float hi) { unsigned r; asm volatile("v_cvt_pk_bf16_f32 %0, %1, %2" : "=v"(r) : "v"(lo), "v"(hi)); return r; }

template <class Epi, bool ALIGN_EPI = true, bool SP2 = true>
__device__ __forceinline__ void gemm_phase(PG8_LAS unsigned char* lds, const int K, const Sched& S, const Epi& E) {
    const int tid = threadIdx.x, wid = __builtin_amdgcn_readfirstlane(tid >> 6), lane = tid & 63, wr = wid >> 2, wc = wid & 3, fr = lane & 15, fq = lane >> 4;
    const int nt = K / BK;
    unsigned voffA[2], voffB[2];
#pragma unroll
    for (int i = 0; i < 2; ++i) { int R, C; stage_rc(tid * 16 + i * 8192, R, C); const int Rb = Epi::PERM ? ((R & ~31) + perm32(R & 31)) : R;
        voffA[i] = (unsigned)(R * K + C) * 2u; voffB[i] = (unsigned)(Rb * K + C) * 2u; }
    const size_t kstep = (size_t)(BK * 2);
    const size_t hstep = (size_t)HALF * K * 2;
    const unsigned ldsw = (unsigned)wid * 1024u;
    const int aoff = lds_byte(wr * 64 + fr, fq * 8), boff = lds_byte(wc * 32 + fr, fq * 8);
#define PG8_SA(b, h) (((b) * 2 + (h)) * HTB)
#define PG8_SB(b, h) ((4 + (b) * 2 + (h)) * HTB)
#define PG8_STAGE(bufoff, gbase, voff) do { _Pragma("unroll") for (int _i = 0; _i < 2; ++_i) \
        __builtin_amdgcn_global_load_lds((const unsigned*)((const char*)(gbase) + (voff)[_i]), (PG8_LAS unsigned*)(lds + (bufoff) + ldsw + _i * 8192), 16, 0, 0); } while (0)
#define PG8_LDA(dst, b, h) do { _Pragma("unroll") for (int m = 0; m < 4; ++m) _Pragma("unroll") for (int k = 0; k < 2; ++k) dst[m][k] = *(const PG8_LAS bf16x8*)(lds + PG8_SA(b, h) + aoff + m * 2048 + k * 1024); } while (0)
#define PG8_LDB(dst, b, h) do { _Pragma("unroll") for (int n = 0; n < 2; ++n) _Pragma("unroll") for (int k = 0; k < 2; ++k) dst[n][k] = *(const PG8_LAS bf16x8*)(lds + PG8_SB(b, h) + boff + n * 2048 + k * 1024); } while (0)
#define PG8_MMA(ai, bj, At, Bt) do { __builtin_amdgcn_s_setprio(1); _Pragma("unroll") for (int m = 0; m < 4; ++m) _Pragma("unroll") for (int n = 0; n < 2; ++n) _Pragma("unroll") for (int k = 0; k < 2; ++k) \
        acc[ai][bj][m][n] = __builtin_amdgcn_mfma_f32_16x16x32_bf16(Bt[n][k], At[m][k], acc[ai][bj][m][n], 0, 0, 0); __builtin_amdgcn_s_setprio(0); } while (0)
#define PG8_WAIT_V(n) asm volatile("s_waitcnt vmcnt(" #n ")" ::: "memory")
#define PG8_WAIT_L(n) asm volatile("s_waitcnt lgkmcnt(" #n ")" ::: "memory")
#define PG8_BAR __builtin_amdgcn_s_barrier()
#define PG8_SCHED __builtin_amdgcn_sched_barrier(0)
    Unit cur, nxt; int ui = 0;
    if (!S.next(0, cur)) return;
    f32x4 acc[2][2][4][2];
#pragma unroll
    for (int a = 0; a < 2; ++a)
#pragma unroll
        for (int b = 0; b < 2; ++b)
#pragma unroll
            for (int m = 0; m < 4; ++m)
#pragma unroll
                for (int n = 0; n < 2; ++n) acc[a][b][m][n] = (f32x4){0.f, 0.f, 0.f, 0.f};
    bf16x8 At[4][2], B0[2][2], B1[2][2];
    const char* cA = cur.a; const char* cB = cur.b;
    if constexpr (SP2) {
        PG8_STAGE(PG8_SB(0, 0), cB, voffB); PG8_STAGE(PG8_SB(0, 1), cB + hstep, voffB); PG8_STAGE(PG8_SA(0, 0), cA, voffA); PG8_STAGE(PG8_SA(0, 1), cA + hstep, voffA);
        if (wr == 1) PG8_BAR;
        PG8_WAIT_V(2); PG8_BAR;
        PG8_STAGE(PG8_SB(1, 0), cB + kstep, voffB); PG8_STAGE(PG8_SA(1, 0), cA + kstep, voffA); PG8_STAGE(PG8_SB(1, 1), cB + hstep + kstep, voffB);
        PG8_WAIT_V(6); PG8_BAR;
    } else {
        PG8_STAGE(PG8_SB(0, 0), cB, voffB); PG8_STAGE(PG8_SA(0, 0), cA, voffA); PG8_STAGE(PG8_SB(0, 1), cB + hstep, voffB); PG8_STAGE(PG8_SA(0, 1), cA + hstep, voffA);
        if (wr == 1) PG8_BAR;
        PG8_WAIT_V(4); PG8_BAR;
        PG8_STAGE(PG8_SB(1, 0), cB + kstep, voffB); PG8_STAGE(PG8_SA(1, 0), cA + kstep, voffA); PG8_STAGE(PG8_SB(1, 1), cB + hstep + kstep, voffB);
        PG8_WAIT_V(6); PG8_BAR;
    }
    for (;;) {
        const bool has_next = S.next(ui + 1, nxt);
        const char* nA = has_next ? nxt.a : cA; const char* nB = has_next ? nxt.b : cB;
        for (int t = 0; t < nt; t += 2) {
            const bool last = (t == nt - 2);
            const char* a1 = cA + (size_t)(t + 1) * kstep;
            const char* a2 = last ? nA : cA + (size_t)(t + 2) * kstep; const char* b2 = last ? nB : cB + (size_t)(t + 2) * kstep;
            const char* a3 = a2 + kstep; const char* b3 = b2 + kstep;
            if constexpr (SP2) {
            PG8_LDB(B0, 0, 0); PG8_LDB(B1, 0, 1); PG8_SCHED; PG8_LDA(At, 0, 0); PG8_STAGE(PG8_SA(1, 1), a1 + hstep, voffA);
            PG8_WAIT_V(8); PG8_WAIT_L(0); PG8_BAR; PG8_MMA(0, 0, At, B0); PG8_MMA(0, 1, At, B1); PG8_BAR; PG8_SCHED;
            PG8_LDA(At, 0, 1); PG8_STAGE(PG8_SB(0, 0), b2, voffB); PG8_STAGE(PG8_SB(0, 1), b2 + hstep, voffB); PG8_STAGE(PG8_SA(0, 0), a2, voffA);
            PG8_WAIT_V(8); PG8_WAIT_L(0); PG8_BAR; PG8_MMA(1, 0, At, B0); PG8_MMA(1, 1, At, B1); PG8_BAR; PG8_SCHED;
            PG8_LDB(B0, 1, 0); PG8_LDB(B1, 1, 1); PG8_SCHED; PG8_LDA(At, 1, 0); PG8_STAGE(PG8_SA(0, 1), a2 + hstep, voffA);
            PG8_WAIT_V(8); PG8_WAIT_L(0); PG8_BAR; PG8_MMA(0, 0, At, B0); PG8_MMA(0, 1, At, B1); PG8_BAR; PG8_SCHED;
            PG8_LDA(At, 1, 1); PG8_STAGE(PG8_SB(1, 0), b3, voffB); PG8_STAGE(PG8_SB(1, 1), b3 + hstep, voffB); PG8_STAGE(PG8_SA(1, 0), a3, voffA);
            PG8_WAIT_V(8); PG8_WAIT_L(0); PG8_BAR; PG8_MMA(1, 0, At, B0); PG8_MMA(1, 1, At, B1); PG8_BAR; PG8_SCHED;
            } else {
            PG8_LDB(B0, 0, 0); PG8_SCHED; PG8_LDA(At, 0, 0); PG8_STAGE(PG8_SA(1, 1), a1 + hstep, voffA);
            PG8_WAIT_L(8); PG8_BAR; PG8_WAIT_L(0); PG8_MMA(0, 0, At, B0); PG8_BAR; PG8_SCHED;
            PG8_LDB(B1, 0, 1); PG8_STAGE(PG8_SB(0, 0), b2, voffB);
            PG8_BAR; PG8_WAIT_L(0); PG8_MMA(0, 1, At, B1); PG8_BAR;
            PG8_LDA(At, 0, 1); PG8_STAGE(PG8_SA(0, 0), a2, voffA);
            PG8_BAR; PG8_WAIT_L(0); PG8_MMA(1, 0, At, B0); PG8_BAR; PG8_SCHED;
            PG8_STAGE(PG8_SB(0, 1), b2 + hstep, voffB);
            PG8_WAIT_V(6); PG8_BAR; PG8_MMA(1, 1, At, B1); PG8_BAR;
            PG8_LDB(B0, 1, 0); PG8_SCHED; PG8_LDA(At, 1, 0); PG8_STAGE(PG8_SA(0, 1), a2 + hstep, voffA);
            PG8_WAIT_L(8); PG8_BAR; PG8_WAIT_L(0); PG8_MMA(0, 0, At, B0); PG8_BAR; PG8_SCHED;
            PG8_LDB(B1, 1, 1); PG8_STAGE(PG8_SB(1, 0), b3, voffB);
            PG8_BAR; PG8_WAIT_L(0); PG8_MMA(0, 1, At, B1); PG8_BAR;
            PG8_LDA(At, 1, 1); PG8_STAGE(PG8_SA(1, 0), a3, voffA);
            PG8_BAR; PG8_WAIT_L(0); PG8_MMA(1, 0, At, B0); PG8_BAR; PG8_SCHED;
            PG8_STAGE(PG8_SB(1, 1), b3 + hstep, voffB);
            PG8_WAIT_V(6); PG8_BAR; PG8_MMA(1, 1, At, B1); PG8_BAR;
            }
        }
        if constexpr (ALIGN_EPI) { if (wr == 0) PG8_BAR; }
        E(acc, cur, wr, wc, fr, fq);
        if (!has_next) break;
#pragma unroll
        for (int a = 0; a < 2; ++a)
#pragma unroll
            for (int b = 0; b < 2; ++b)
#pragma unroll
                for (int m = 0; m < 4; ++m)
#pragma unroll
                    for (int n = 0; n < 2; ++n) acc[a][b][m][n] = (f32x4){0.f, 0.f, 0.f, 0.f};
        cur = nxt; cA = nA; cB = nB; ++ui;
        if constexpr (ALIGN_EPI) { if (wr == 1) PG8_BAR; }
    }
    PG8_WAIT_V(0);
    if constexpr (!ALIGN_EPI) { if (wr == 0) PG8_BAR; }
    PG8_BAR;
#undef PG8_SA
#undef PG8_SB
#undef PG8_STAGE
#undef PG8_LDA
#undef PG8_LDB
#undef PG8_MMA
#undef PG8_WAIT_V
#undef PG8_WAIT_L
#undef PG8_BAR
#undef PG8_SCHED
}
}
constexpr int T_TOK = 16384, DM = 2048, SEQ = 2048, NBATCH = 8, MEML = 256, MT = NBATCH * MEML, IN_COLS = 5376;
constexpr float EPS = 1e-6f, GN_EPS = 1e-5f, LOG2E = 1.4426950408889634f;
constexpr float C2Q = 0.125f * LOG2E;
constexpr float C3Q = 0.08838834764831845f * LOG2E;
constexpr size_t MiB = 1u << 20;
constexpr size_t WS_CTL = 0, CTL_ZERO_BYTES = 64 * 1024;
constexpr size_t WS_WIN = 2 * MiB, WS_WOUT = 23 * MiB, WS_WXQ = 31 * MiB, WS_WXKV = 33 * MiB, WS_WXO = 37 * MiB, WS_WPQ = 39 * MiB;
constexpr size_t WS_XB = 48 * MiB, WS_MEMB = 112 * MiB;
constexpr size_t WS_COSA = 120 * MiB, WS_SINA = 122 * MiB, WS_COSR = 124 * MiB, WS_SINR = 132 * MiB;
constexpr size_t WS_SS0 = 140 * MiB, WS_SS1 = WS_SS0 + 65536, WS_SS2 = WS_SS1 + 65536, WS_SSM = WS_SS2 + 65536;
constexpr size_t WS_KX = 141 * MiB, WS_VX = 143 * MiB, WS_QX = 145 * MiB, WS_OX = 161 * MiB, WS_EXP = 177 * MiB, WS_GATE = 185 * MiB;
constexpr size_t WS_Y = 193 * MiB;
constexpr size_t WS_QA = 257 * MiB, WS_KA = 289 * MiB, WS_VA = 293 * MiB, WS_QR = 297 * MiB, WS_KR = 329 * MiB, WS_VR = 361 * MiB, WS_GR = 393 * MiB;
constexpr size_t WS_UB = 425 * MiB, WS_VB = 457 * MiB, WS_SU = 489 * MiB, WS_SV = WS_SU + 65536;
constexpr size_t WS_END = 490 * MiB;

#define GAS __attribute__((address_space(1)))
#define LAS __attribute__((address_space(3)))
typedef unsigned short bf16_t;
typedef short bf16x8 __attribute__((ext_vector_type(8)));
typedef short v4i16 __attribute__((ext_vector_type(4)));
typedef float f32x4 __attribute__((ext_vector_type(4)));
typedef float f32x2 __attribute__((ext_vector_type(2)));
typedef unsigned u32x4 __attribute__((ext_vector_type(4)));
typedef unsigned u32x2 __attribute__((ext_vector_type(2)));
typedef __bf16 bf16x2_t __attribute__((ext_vector_type(2)));

__device__ __forceinline__ unsigned pk2(float lo, float hi) { f32x2 v = {lo, hi}; bf16x2_t b = __builtin_convertvector(v, bf16x2_t); return __builtin_bit_cast(unsigned, b); }
__device__ __forceinline__ float bf_lo(unsigned w) { return __uint_as_float(w << 16); }
__device__ __forceinline__ float bf_hi(unsigned w) { return __uint_as_float(w & 0xffff0000u); }
__device__ __forceinline__ float wave_sum(float v) {
#pragma unroll
    for (int o = 1; o < 64; o <<= 1) v += __shfl_xor(v, o);
    return v;
}

struct EpiP1 {
    static constexpr bool PERM = true;
    unsigned char* ws;
    __device__ __forceinline__ void operator()(const pg8::f32x4 (&acc)[2][2][4][2], const pg8::Unit& u, int wr, int wc, int fr, int fq) const {
        if (u.kind == 1) {
            const float* ssm = (const float*)(ws + WS_SSM);
            bf16_t* O = (bf16_t*)(ws + ((u.pn < 2) ? WS_KX : WS_VX)); const int cb = (u.pn & 1) * 256 + wc * 32 + 8 * fq;
#pragma unroll
            for (int ai = 0; ai < 2; ++ai)
#pragma unroll
                for (int m = 0; m < 4; ++m) { const int row = u.pm * 256 + ai * 128 + wr * 64 + m * 16 + fr; const float rs = rsqrtf(ssm[row] * (1.f / DM) + EPS);
#pragma unroll
                    for (int bj = 0; bj < 2; ++bj) { const f32x4 v0 = acc[ai][bj][m][0] * rs, v1 = acc[ai][bj][m][1] * rs;
                        u32x4 w; w.x = pk2(v0[0], v0[1]); w.y = pk2(v0[2], v0[3]); w.z = pk2(v1[0], v1[1]); w.w = pk2(v1[2], v1[3]);
                        *(u32x4*)(O + (size_t)row * 512 + cb + bj * 128) = w; } }
            return;
        }
        const float* ss0 = (const float*)(ws + WS_SS0);
        const int pn = u.pn;
        size_t ooff, ctoff, stoff; int pitch, colbase, i0, half, tw; float sc; bool rope;
        if (pn < 4)        { ooff = WS_QA; pitch = 1024; colbase = (4 * pn + wc) * 64; i0 = 8 * fq; half = 32; tw = 32; ctoff = WS_COSA; stoff = WS_SINA; sc = C2Q; rope = true; }
        else if (pn == 4)  { if (wc < 2) { ooff = WS_KA; colbase = wc * 64; rope = true; } else { ooff = WS_VA; colbase = (wc - 2) * 64; rope = false; }
                             pitch = 128; i0 = 8 * fq; half = 32; tw = 32; ctoff = WS_COSA; stoff = WS_SINA; sc = 1.f; }
        else { const int q = (pn - 5) >> 2, h = (pn - 5) & 3; ooff = WS_QR + (size_t)q * (32 * MiB); pitch = 1024; colbase = h * 256; i0 = 32 * wc + 8 * fq; half = 128; tw = 128; ctoff = WS_COSR; stoff = WS_SINR;
               sc = (q == 1) ? 0.0625f : 1.f; rope = (q < 2); }
        bf16_t* O = (bf16_t*)(ws + ooff); const float* ct = (const float*)(ws + ctoff); const float* st = (const float*)(ws + stoff);
#pragma unroll
        for (int ai = 0; ai < 2; ++ai)
#pragma unroll
            for (int m = 0; m < 4; ++m) { const int row = u.pm * 256 + ai * 128 + wr * 64 + m * 16 + fr; const float rs = rsqrtf(ss0[row] * (1.f / DM) + EPS) * sc;
                f32x4 a0 = acc[ai][0][m][0] * rs, a1 = acc[ai][0][m][1] * rs, b0 = acc[ai][1][m][0] * rs, b1 = acc[ai][1][m][1] * rs;
                if (rope) { const f32x4 c0 = *(const f32x4*)(ct + (size_t)row * tw + i0), c1 = *(const f32x4*)(ct + (size_t)row * tw + i0 + 4);
                            const f32x4 s0 = *(const f32x4*)(st + (size_t)row * tw + i0), s1 = *(const f32x4*)(st + (size_t)row * tw + i0 + 4);
                            const f32x4 o0 = a0 * c0 - b0 * s0, o1 = a1 * c1 - b1 * s1, p0 = b0 * c0 + a0 * s0, p1 = b1 * c1 + a1 * s1; a0 = o0; a1 = o1; b0 = p0; b1 = p1; }
                bf16_t* rp = O + (size_t)row * pitch + colbase + i0;
                u32x4 w; w.x = pk2(a0[0], a0[1]); w.y = pk2(a0[2], a0[3]); w.z = pk2(a1[0], a1[1]); w.w = pk2(a1[2], a1[3]); *(u32x4*)rp = w;
                w.x = pk2(b0[0], b0[1]); w.y = pk2(b0[2], b0[3]); w.z = pk2(b1[0], b1[1]); w.w = pk2(b1[2], b1[3]); *(u32x4*)(rp + half) = w; }
    }
};
struct EpiRes1 {
    static constexpr bool PERM = true;
    bf16_t* XB; float* ss;
    __device__ __forceinline__ void operator()(const pg8::f32x4 (&acc)[2][2][4][2], const pg8::Unit& u, int wr, int wc, int fr, int fq) const {
        const int col0 = u.pn * 256 + wc * 32 + 8 * fq;
#pragma unroll
        for (int ai = 0; ai < 2; ++ai) {
            u32x4 r[4][2];
#pragma unroll
            for (int m = 0; m < 4; ++m) { const size_t off = (size_t)(u.pm * 256 + ai * 128 + wr * 64 + m * 16 + fr) * DM + col0;
#pragma unroll
                for (int bj = 0; bj < 2; ++bj) r[m][bj] = *(const u32x4*)(XB + off + bj * 128); }
#pragma unroll
            for (int m = 0; m < 4; ++m) { const int row = u.pm * 256 + ai * 128 + wr * 64 + m * 16 + fr; const size_t off = (size_t)row * DM + col0; float s = 0.f;
#pragma unroll
                for (int bj = 0; bj < 2; ++bj) { const size_t o = off + bj * 128;
                    const u32x4 q = r[m][bj];
                    const f32x4 v0 = (f32x4){bf_lo(q.x), bf_hi(q.x), bf_lo(q.y), bf_hi(q.y)} + acc[ai][bj][m][0], v1 = (f32x4){bf_lo(q.z), bf_hi(q.z), bf_lo(q.w), bf_hi(q.w)} + acc[ai][bj][m][1];
                    u32x4 w; w.x = pk2(v0[0], v0[1]); w.y = pk2(v0[2], v0[3]); w.z = pk2(v1[0], v1[1]); w.w = pk2(v1[2], v1[3]); *(u32x4*)(XB + o) = w;
                    s += ((v0[0] * v0[0] + v0[1] * v0[1]) + (v0[2] * v0[2] + v0[3] * v0[3])) + ((v1[0] * v1[0] + v1[1] * v1[1]) + (v1[2] * v1[2] + v1[3] * v1[3])); }
                s += __shfl_xor(s, 16); s += __shfl_xor(s, 32);
                if (fq == 0) atomicAdd(ss + row, s); }
            asm volatile("" ::: "memory");
        }
    }
};
struct EpiRes2 {
    static constexpr bool PERM = true;
    bf16_t* XB; float* ss;
    __device__ __forceinline__ void operator()(const pg8::f32x4 (&acc)[2][2][4][2], const pg8::Unit& u, int wr, int wc, int fr, int fq) const {
        const int col0 = u.pn * 256 + wc * 32 + 8 * fq;
        u32x4 r[2][4][2];
#pragma unroll
        for (int ai = 0; ai < 2; ++ai)
#pragma unroll
            for (int m = 0; m < 4; ++m) { const size_t off = (size_t)(u.pm * 256 + ai * 128 + wr * 64 + m * 16 + fr) * DM + col0;
#pragma unroll
                for (int bj = 0; bj < 2; ++bj) r[ai][m][bj] = *(const u32x4*)(XB + off + bj * 128); }
#pragma unroll
        for (int ai = 0; ai < 2; ++ai)
#pragma unroll
            for (int m = 0; m < 4; ++m) { const int row = u.pm * 256 + ai * 128 + wr * 64 + m * 16 + fr; const size_t off = (size_t)row * DM + col0; float s = 0.f;
#pragma unroll
                for (int bj = 0; bj < 2; ++bj) { const size_t o = off + bj * 128; const u32x4 q = r[ai][m][bj];
                    const f32x4 v0 = (f32x4){bf_lo(q.x), bf_hi(q.x), bf_lo(q.y), bf_hi(q.y)} + acc[ai][bj][m][0], v1 = (f32x4){bf_lo(q.z), bf_hi(q.z), bf_lo(q.w), bf_hi(q.w)} + acc[ai][bj][m][1];
                    u32x4 w; w.x = pk2(v0[0], v0[1]); w.y = pk2(v0[2], v0[3]); w.z = pk2(v1[0], v1[1]); w.w = pk2(v1[2], v1[3]); *(u32x4*)(XB + o) = w;
                    s += ((v0[0] * v0[0] + v0[1] * v0[1]) + (v0[2] * v0[2] + v0[3] * v0[3])) + ((v1[0] * v1[0] + v1[1] * v1[1]) + (v1[2] * v1[2] + v1[3] * v1[3])); }
                s += __shfl_xor(s, 16); s += __shfl_xor(s, 32);
                if (fq == 0) atomicAdd(ss + row, s); }
    }
};
struct EpiScale {
    static constexpr bool PERM = true;
    bf16_t* O; int ldc; const float* ss; float scale;
    __device__ __forceinline__ void operator()(const pg8::f32x4 (&acc)[2][2][4][2], const pg8::Unit& u, int wr, int wc, int fr, int fq) const {
        const int col0 = u.pn * 256 + wc * 32 + 8 * fq;
#pragma unroll
        for (int ai = 0; ai < 2; ++ai)
#pragma unroll
            for (int m = 0; m < 4; ++m) { const int row = u.pm * 256 + ai * 128 + wr * 64 + m * 16 + fr; const float rs = rsqrtf(ss[row] * (1.f / DM) + EPS) * scale;
#pragma unroll
                for (int bj = 0; bj < 2; ++bj) { const f32x4 v0 = acc[ai][bj][m][0] * rs, v1 = acc[ai][bj][m][1] * rs;
                    u32x4 w; w.x = pk2(v0[0], v0[1]); w.y = pk2(v0[2], v0[3]); w.z = pk2(v1[0], v1[1]); w.w = pk2(v1[2], v1[3]);
                    *(u32x4*)(O + (size_t)row * ldc + col0 + bj * 128) = w; } }
    }
};
#define XB_TMO      128
#define XB_XCNT(j)  (256  + 64 * (j))
#define XB_XSUB(j)  (1280 + 64 * (j))
#define XB_XGEN(j)  (2304 + 64 * (j))
#define XB_TOP      3328
#define XB_TOPGEN   3392
#define XCD_BAR_WORDS 3456
#define XB_SPIN_CAP (1u << 18)
__device__ __forceinline__ unsigned xb_ld(unsigned* p)              { return __hip_atomic_load(p, __ATOMIC_RELAXED, __HIP_MEMORY_SCOPE_AGENT); }
__device__ __forceinline__ unsigned xb_add(unsigned* p, unsigned v) { return __hip_atomic_fetch_add(p, v, __ATOMIC_RELAXED, __HIP_MEMORY_SCOPE_AGENT); }
__device__ __forceinline__ unsigned xb_xcc_id() { return (unsigned)__builtin_amdgcn_s_getreg((3 << 11) | 20) & 0xFu; }
#define XB_SPIN(cond, bar) do { unsigned _sp = 0; while (cond) { __builtin_amdgcn_s_sleep(1); \
    if ((++_sp & 255u) == 0u) { if (xb_ld(&(bar)[XB_TMO])) break; if (_sp > XB_SPIN_CAP) { atomicAdd(&(bar)[XB_TMO], 1u); break; } } } } while (0)
struct XcdBarrier { unsigned* bar; unsigned x; volatile LAS unsigned* st; };
__device__ __forceinline__ XcdBarrier xcd_barrier_post(unsigned* bar, volatile LAS unsigned* st) {
    XcdBarrier b; b.bar = bar; b.x = xb_xcc_id(); b.st = st;
    if (threadIdx.x == 0) (void)xb_add(&bar[XB_XCNT(b.x)], 1u);
    return b;
}
__device__ __forceinline__ void xcd_barrier_complete(unsigned* bar, unsigned x, unsigned& nloc, unsigned& nx) {
    const unsigned G = gridDim.x * gridDim.y * gridDim.z;
    unsigned sum, cnt, mine, sp = 0u;
    for (;;) {
        sum = 0u; cnt = 0u; mine = 0u;
#pragma unroll
        for (unsigned j = 0; j < 16; ++j) { const unsigned c = xb_ld(&bar[XB_XCNT(j)]); sum += c; cnt += (c > 0u) ? 1u : 0u; mine = (j == x) ? c : mine; }
        if (sum == G) break;
        __builtin_amdgcn_s_sleep(1);
        if ((++sp & 255u) == 0u) { if (xb_ld(&bar[XB_TMO])) break; if (sp > XB_SPIN_CAP) { atomicAdd(&bar[XB_TMO], 1u); break; } }
    }
    nloc = mine > 0u ? mine : 1u; nx = cnt > 0u ? cnt : 1u;
}
__device__ __forceinline__ void xcd_barrier(const XcdBarrier& b) {
    asm volatile("s_waitcnt vmcnt(0)" ::: "memory");
    __syncthreads();
    if (threadIdx.x == 0) {
        unsigned* bar = b.bar;
        __builtin_amdgcn_s_waitcnt(0);
        unsigned nloc = b.st[0], nx = b.st[1];
        if (nloc == 0u) { xcd_barrier_complete(bar, b.x, nloc, nx); b.st[0] = nloc; b.st[1] = nx; }
        const unsigned old = xb_add(&bar[XB_XSUB(b.x)], 1u);
        const unsigned gen = old / nloc;
        if (old + 1u == (gen + 1u) * nloc) {
            __builtin_amdgcn_fence(__ATOMIC_RELEASE, "agent");
            asm volatile("s_waitcnt vmcnt(0)" ::: "memory");
            const unsigned og = xb_add(&bar[XB_TOP], 1u);
            const unsigned tg = og / nx;
            if (og + 1u == (tg + 1u) * nx) xb_add(&bar[XB_TOPGEN], 1u);
            else XB_SPIN(xb_ld(&bar[XB_TOPGEN]) == tg, bar);
            __builtin_amdgcn_fence(__ATOMIC_ACQUIRE, "agent");
            xb_add(&bar[XB_XGEN(b.x)], 1u);
            asm volatile("s_waitcnt vmcnt(0)" ::: "memory");
        } else {
            XB_SPIN(xb_ld(&bar[XB_XGEN(b.x)]) == gen, bar);
            __builtin_amdgcn_fence(__ATOMIC_ACQUIRE, "agent");
            asm volatile("s_waitcnt vmcnt(0)" ::: "memory");
        }
    }
    __syncthreads();
}

__device__ __forceinline__ int win_phys(int n) {
    if (n < 1024) { const int head = n >> 6, d = n & 63; return (head >> 2) * 256 + (d >> 5) * 128 + (head & 3) * 32 + (d & 31); }
    if (n < 1280) { const int m = n - 1024, kind = m >> 7, hh = (m & 127) >> 6, d = m & 63; return 1024 + (d >> 5) * 128 + (kind * 2 + hh) * 32 + (d & 31); }
    return n;
}
template <bool PERMW>
__device__ __forceinline__ void p0_transpose_item(const float* W, const float* gk, int K, int N, bf16_t* WT, int row_off, LAS float* scr, int item, int lane) {
    const int nblk = N / 32, kb = item / nblk, nb = item % nblk, k0 = 64 * kb, n0 = 32 * nb;
    float wv[32];
#pragma unroll
    for (int i = 0; i < 32; ++i) { const int kk = 2 * i + (lane >> 5); wv[i] = W[(size_t)(k0 + kk) * N + n0 + (lane & 31)]; }
#pragma unroll
    for (int i = 0; i < 32; ++i) { const int kk = 2 * i + (lane >> 5); const float g = gk ? gk[k0 + kk] : 1.f; scr[kk * 33 + (lane & 31)] = wv[i] * g; }
    asm volatile("s_waitcnt lgkmcnt(0)" ::: "memory");
    const int c = lane & 7; const int pr0 = PERMW ? win_phys(n0) : n0;
#pragma unroll
    for (int j = 0; j < 4; ++j) { const int n = (lane >> 3) + 8 * j; const LAS float* s = scr + (8 * c) * 33 + n;
        u32x4 o; o.x = pk2(s[0 * 33], s[1 * 33]); o.y = pk2(s[2 * 33], s[3 * 33]); o.z = pk2(s[4 * 33], s[5 * 33]); o.w = pk2(s[6 * 33], s[7 * 33]);
        *(u32x4*)(WT + (size_t)(row_off + pr0 + n) * K + k0 + 8 * c) = o; }
    asm volatile("s_waitcnt lgkmcnt(0)" ::: "memory");
}
__device__ __forceinline__ void row_to_bf16(const float* xrow, bf16_t* orow, float* ssq, int lane) {
    const f32x4* xr = (const f32x4*)xrow + lane; f32x4 v[8]; float s = 0.f;
#pragma unroll
    for (int j = 0; j < 8; ++j) { v[j] = xr[64 * j]; s += (v[j][0] * v[j][0] + v[j][1] * v[j][1]) + (v[j][2] * v[j][2] + v[j][3] * v[j][3]); }
    s = wave_sum(s);
    u32x2* o8 = (u32x2*)orow + lane;
#pragma unroll
    for (int j = 0; j < 8; ++j) { u32x2 w; w.x = pk2(v[j][0], v[j][1]); w.y = pk2(v[j][2], v[j][3]); o8[64 * j] = w; }
    if (lane == 0) *ssq = s;
}
__device__ __forceinline__ void row2_to_bf16(const float* xrow, bf16_t* orow, float* ssq, size_t rstep, int lane) {
    const f32x4* xr0 = (const f32x4*)xrow + lane; const f32x4* xr1 = (const f32x4*)(xrow + rstep * DM) + lane; f32x4 v[8], q[8]; float s0 = 0.f, s1 = 0.f;
#pragma unroll
    for (int j = 0; j < 8; ++j) { v[j] = xr0[64 * j]; q[j] = xr1[64 * j]; }
#pragma unroll
    for (int j = 0; j < 8; ++j) { s0 += (v[j][0] * v[j][0] + v[j][1] * v[j][1]) + (v[j][2] * v[j][2] + v[j][3] * v[j][3]); s1 += (q[j][0] * q[j][0] + q[j][1] * q[j][1]) + (q[j][2] * q[j][2] + q[j][3] * q[j][3]); }
    s0 = wave_sum(s0); s1 = wave_sum(s1);
    u32x2* o0 = (u32x2*)orow + lane; u32x2* o1 = (u32x2*)(orow + rstep * DM) + lane;
#pragma unroll
    for (int j = 0; j < 8; ++j) { u32x2 w; w.x = pk2(v[j][0], v[j][1]); w.y = pk2(v[j][2], v[j][3]); o0[64 * j] = w; w.x = pk2(q[j][0], q[j][1]); w.y = pk2(q[j][2], q[j][3]); o1[64 * j] = w; }
    if (lane == 0) { ssq[0] = s0; ssq[rstep] = s1; }
}
__device__ __forceinline__ void sincos_red(float ang, float& c, float& s) {
    const float k = rintf(ang * 0.15915494309189535f);
    float r = fmaf(-k, 6.28125f, ang); r = fmaf(-k, 1.9353071795864769e-3f, r);
    const float rev = r * 0.15915494309189535f;
    s = __builtin_amdgcn_sinf(rev); c = __builtin_amdgcn_cosf(rev);
}

#define MFMA16(a, b, c) __builtin_amdgcn_mfma_f32_16x16x32_bf16((a), (b), (c), 0, 0, 0)
__device__ __forceinline__ bf16x8 pack_p(const f32x4& lo, const f32x4& hi) {
    u32x4 w; w.x = pk2(lo[0], lo[1]); w.y = pk2(lo[2], lo[3]); w.z = pk2(hi[0], hi[1]); w.w = pk2(hi[2], hi[3]); return __builtin_bit_cast(bf16x8, w);
}
__device__ __forceinline__ bf16x8 vt_frag(LAS const unsigned char* p, int stride16) {
    const v4i16 lo = __builtin_amdgcn_ds_read_tr16_b64_v4i16((LAS v4i16*)p);
    const v4i16 hi = __builtin_amdgcn_ds_read_tr16_b64_v4i16((LAS v4i16*)(p + stride16));
    return (bf16x8){lo[0], lo[1], lo[2], lo[3], hi[0], hi[1], hi[2], hi[3]};
}

__device__ __forceinline__ void swa_unit(LAS unsigned char* lds, int b, int n, int kvh, const bf16_t* QA, const bf16_t* KA, const bf16_t* VA,
                                         const float* sinks, const float* att_gain, bf16_t* Y) {
    constexpr int KS = 144;
    const int tid = threadIdx.x, lane = tid & 63, c = lane & 15, g = lane >> 4; const int w = __builtin_amdgcn_readfirstlane(tid >> 6);
    LAS unsigned char* Kl = lds; LAS unsigned char* Vl = lds + 256 * KS;
    for (int i = tid; i < 2048; i += 512) { const int key = i >> 3, ch = i & 7, pos = 128 * (n - 1) + key; u32x4 kv = {0u, 0u, 0u, 0u}, vv = {0u, 0u, 0u, 0u};
        if (pos >= 0) { const size_t off = (size_t)(b * SEQ + pos) * 128 + kvh * 64 + ch * 8; kv = *(const u32x4*)(KA + off); vv = *(const u32x4*)(VA + off); }
        *(LAS u32x4*)(Kl + key * KS + ch * 16) = kv; *(LAS u32x4*)(Vl + key * KS + ch * 16) = vv; }
    __syncthreads();
    const int hq = kvh * 8 + w; const float sink = sinks[hq] * LOG2E;
    bf16x8 qn[2];
#pragma unroll
    for (int ks = 0; ks < 2; ++ks) qn[ks] = *(const bf16x8*)(QA + (size_t)(b * SEQ + 128 * n + c) * 1024 + hq * 64 + ks * 32 + 8 * g);
    for (int a = 0; a < 8; ++a) {
        const int t = b * SEQ + 128 * n + 16 * a + c; const int kb0 = (a & ~1) * 16; const int qi = 128 + 16 * a + c;
        bf16x8 qf[2];
#pragma unroll
        for (int ks = 0; ks < 2; ++ks) { qf[ks] = qn[ks]; qn[ks] = *(const bf16x8*)(QA + (size_t)(t + (a < 7 ? 16 : 0)) * 1024 + hq * 64 + ks * 32 + 8 * g); }
        f32x4 s[10]; float m = sink;
#pragma unroll
        for (int blk = 0; blk < 10; ++blk) { const int key0 = kb0 + 16 * blk; f32x4 acc = {0.f, 0.f, 0.f, 0.f};
#pragma unroll
            for (int ks = 0; ks < 2; ++ks) { const bf16x8 kf = *(LAS const bf16x8*)(Kl + (key0 + c) * KS + (ks * 32 + 8 * g) * 2); acc = MFMA16(kf, qf[ks], acc); }
#pragma unroll
            for (int r = 0; r < 4; ++r) { const int j = key0 + 4 * g + r; const bool ok = (j <= qi) && (j > qi - 128) && (n > 0 || j >= 128);
                acc[r] = ok ? acc[r] : -INFINITY; m = fmaxf(m, acc[r]); }
            s[blk] = acc; }
        m = fmaxf(m, __shfl_xor(m, 16)); m = fmaxf(m, __shfl_xor(m, 32));
        float l = 0.f;
#pragma unroll
        for (int blk = 0; blk < 10; ++blk)
#pragma unroll
            for (int r = 0; r < 4; ++r) { const float p = __builtin_amdgcn_exp2f(s[blk][r] - m); s[blk][r] = p; l += p; }
        l += __shfl_xor(l, 16); l += __shfl_xor(l, 32); l += __builtin_amdgcn_exp2f(sink - m);
        f32x4 o[4];
#pragma unroll
        for (int db = 0; db < 4; ++db) o[db] = (f32x4){0.f, 0.f, 0.f, 0.f};
#pragma unroll
        for (int kp = 0; kp < 5; ++kp) { const bf16x8 pf = pack_p(s[2 * kp], s[2 * kp + 1]); const int key0 = kb0 + 32 * kp;
#pragma unroll
            for (int db = 0; db < 4; ++db) { const bf16x8 af = vt_frag(Vl + (key0 + 4 * g + (c >> 2)) * KS + (16 * db + 4 * (c & 3)) * 2, 16 * KS); o[db] = MFMA16(af, pf, o[db]); } }
        const float inv = 1.f / l; float q2 = 0.f;
#pragma unroll
        for (int db = 0; db < 4; ++db) { o[db] = o[db] * inv; q2 += (o[db][0] * o[db][0] + o[db][1] * o[db][1]) + (o[db][2] * o[db][2] + o[db][3] * o[db][3]); }
        q2 += __shfl_xor(q2, 16); q2 += __shfl_xor(q2, 32);
        const float rms = rsqrtf(q2 * (1.f / 64.f) + EPS);
#pragma unroll
        for (int db = 0; db < 4; ++db) { const int col = hq * 64 + 16 * db + 4 * g; const f32x4 gn = *(const f32x4*)(att_gain + col); const f32x4 v = o[db] * rms * gn;
            u32x2 wv; wv.x = pk2(v[0], v[1]); wv.y = pk2(v[2], v[3]); *(u32x2*)(Y + (size_t)t * DM + col) = wv; }
    }
    __syncthreads();
}

__device__ __forceinline__ void ret_unit(LAS unsigned char* lds, int b, int h, int qb, const bf16_t* QR, const bf16_t* KR, const bf16_t* VR, const bf16_t* GR,
                                         const float* ret_gain, bf16_t* Y) {
    constexpr int RS = 544, TB = 64 * RS;
    const int tid = threadIdx.x, lane = tid & 63, c = lane & 15, g = lane >> 4; const int w = __builtin_amdgcn_readfirstlane(tid >> 6);
    const int nt = 2 * qb + 2; const size_t rowb = (size_t)b * SEQ; const int hoff = h * 256;
    const int qpos = 128 * qb + 16 * w + c; const size_t t = rowb + qpos;
    const float lg = log2f(1.f - exp2f(-5.f - (float)h));
    bf16x8 qf[8];
#pragma unroll
    for (int ks = 0; ks < 8; ++ks) qf[ks] = *(const bf16x8*)(QR + t * 1024 + hoff + ks * 32 + 8 * g);
    f32x4 o[16];
#pragma unroll
    for (int db = 0; db < 16; ++db) o[db] = (f32x4){0.f, 0.f, 0.f, 0.f};
    u32x4 pk[4], pv[4];
#define RET_LOAD(kt) do { _Pragma("unroll") for (int i = 0; i < 4; ++i) { const int id = tid + 512 * i, key = id >> 5, ch = id & 31; const size_t off = (rowb + 64 * (kt) + key) * 1024 + hoff + ch * 8; \
        pk[i] = *(const u32x4*)(KR + off); pv[i] = *(const u32x4*)(VR + off); } } while (0)
#define RET_WRITE(buf) do { _Pragma("unroll") for (int i = 0; i < 4; ++i) { const int id = tid + 512 * i, key = id >> 5, ch = id & 31; \
        *(LAS u32x4*)(lds + (buf) * 2 * TB + key * RS + ch * 16) = pk[i]; *(LAS u32x4*)(lds + (buf) * 2 * TB + TB + key * RS + ch * 16) = pv[i]; } } while (0)
    RET_LOAD(0); RET_WRITE(0); __syncthreads();
    for (int kt = 0; kt < nt; ++kt) {
        const int buf = kt & 1;
        if (kt + 1 < nt) RET_LOAD(kt + 1);
        if (64 * kt <= 128 * qb + 16 * w + 15) {
            LAS const unsigned char* Kl = lds + buf * 2 * TB; LAS const unsigned char* Vl = Kl + TB;
            f32x4 s[4];
#pragma unroll
            for (int blk = 0; blk < 4; ++blk) { f32x4 acc = {0.f, 0.f, 0.f, 0.f};
#pragma unroll
                for (int ks = 0; ks < 8; ++ks) { const bf16x8 kf = *(LAS const bf16x8*)(Kl + (16 * blk + c) * RS + (ks * 32 + 8 * g) * 2); acc = MFMA16(kf, qf[ks], acc); }
#pragma unroll
                for (int r = 0; r < 4; ++r) { const int d = qpos - (64 * kt + 16 * blk + 4 * g + r); const float dec = __builtin_amdgcn_exp2f((float)d * lg); acc[r] = (d >= 0) ? acc[r] * dec : 0.f; }
                s[blk] = acc; }
#pragma unroll
            for (int kp = 0; kp < 2; ++kp) { const bf16x8 pf = pack_p(s[2 * kp], s[2 * kp + 1]);
#pragma unroll
                for (int db = 0; db < 16; ++db) { const bf16x8 af = vt_frag(Vl + (32 * kp + 4 * g + (c >> 2)) * RS + (16 * db + 4 * (c & 3)) * 2, 16 * RS); o[db] = MFMA16(af, pf, o[db]); }
                __builtin_amdgcn_sched_barrier(0); }
        }
        if (kt + 1 < nt) RET_WRITE(buf ^ 1);
        __syncthreads();
    }
#undef RET_LOAD
#undef RET_WRITE
    float s1 = 0.f;
#pragma unroll
    for (int db = 0; db < 16; ++db) s1 += (o[db][0] + o[db][1]) + (o[db][2] + o[db][3]);
    s1 += __shfl_xor(s1, 16); s1 += __shfl_xor(s1, 32);
    const float mu = s1 * (1.f / 256.f); float s2 = 0.f;
#pragma unroll
    for (int db = 0; db < 16; ++db) { o[db] = o[db] - mu; s2 += (o[db][0] * o[db][0] + o[db][1] * o[db][1]) + (o[db][2] * o[db][2] + o[db][3] * o[db][3]); }
    s2 += __shfl_xor(s2, 16); s2 += __shfl_xor(s2, 32);
    const float rstd = rsqrtf(s2 * (1.f / 256.f) + GN_EPS);
#pragma unroll
    for (int db = 0; db < 16; ++db) { const int col = hoff + 16 * db + 4 * g; const f32x4 gn = *(const f32x4*)(ret_gain + col); const u32x2 gw = *(const u32x2*)(GR + t * 1024 + col);
        const float z0 = bf_lo(gw.x), z1 = bf_hi(gw.x), z2 = bf_lo(gw.y), z3 = bf_hi(gw.y);
        f32x4 v = o[db] * rstd * gn;
        v[0] *= z0 / (1.f + __expf(-z0)); v[1] *= z1 / (1.f + __expf(-z1)); v[2] *= z2 / (1.f + __expf(-z2)); v[3] *= z3 / (1.f + __expf(-z3));
        u32x2 wv; wv.x = pk2(v[0], v[1]); wv.y = pk2(v[2], v[3]); *(u32x2*)(Y + t * DM + 1024 + col) = wv; }
}

__device__ __forceinline__ void xattn_unit(LAS unsigned char* lds, int b, int hx, int qblk, const bf16_t* QX, const bf16_t* KX, const bf16_t* VX, bf16_t* OX) {
    constexpr int KS = 288;
    const int tid = threadIdx.x, lane = tid & 63, c = lane & 15, g = lane >> 4; const int w = __builtin_amdgcn_readfirstlane(tid >> 6);
    LAS unsigned char* Kl = lds; LAS unsigned char* Vl = lds + 256 * KS;
    for (int i = tid; i < 4096; i += 512) { const int key = i >> 4, ch = i & 15; const size_t off = (size_t)(b * MEML + key) * 512 + hx * 128 + ch * 8;
        *(LAS u32x4*)(Kl + key * KS + ch * 16) = *(const u32x4*)(KX + off); *(LAS u32x4*)(Vl + key * KS + ch * 16) = *(const u32x4*)(VX + off); }
    __syncthreads();
    bf16x8 qn[4];
#pragma unroll
    for (int ks = 0; ks < 4; ++ks) qn[ks] = *(const bf16x8*)(QX + ((size_t)b * SEQ + 256 * qblk + 16 * w + c) * 512 + hx * 128 + ks * 32 + 8 * g);
#pragma unroll 1
    for (int pass = 0; pass < 2; ++pass) {
        const size_t t = (size_t)b * SEQ + 256 * qblk + 128 * pass + 16 * w + c;
        bf16x8 qf[4];
#pragma unroll
        for (int ks = 0; ks < 4; ++ks) { qf[ks] = qn[ks]; qn[ks] = *(const bf16x8*)(QX + (t + (pass == 0 ? 128 : 0)) * 512 + hx * 128 + ks * 32 + 8 * g); }
        f32x4 s[16]; float m = -INFINITY;
#pragma unroll
        for (int blk = 0; blk < 16; ++blk) { f32x4 acc = {0.f, 0.f, 0.f, 0.f};
#pragma unroll
            for (int ks = 0; ks < 4; ++ks) { const bf16x8 kf = *(LAS const bf16x8*)(Kl + (16 * blk + c) * KS + (ks * 32 + 8 * g) * 2); acc = MFMA16(kf, qf[ks], acc); }
            m = fmaxf(fmaxf(fmaxf(acc[0], acc[1]), fmaxf(acc[2], acc[3])), m); s[blk] = acc; __builtin_amdgcn_sched_barrier(0); }
        m = fmaxf(m, __shfl_xor(m, 16)); m = fmaxf(m, __shfl_xor(m, 32));
        float l = 0.f;
#pragma unroll
        for (int blk = 0; blk < 16; ++blk)
#pragma unroll
            for (int r = 0; r < 4; ++r) { const float p = __builtin_amdgcn_exp2f(s[blk][r] - m); s[blk][r] = p; l += p; }
        l += __shfl_xor(l, 16); l += __shfl_xor(l, 32);
        f32x4 o[8];
#pragma unroll
        for (int db = 0; db < 8; ++db) o[db] = (f32x4){0.f, 0.f, 0.f, 0.f};
#pragma unroll
        for (int kp = 0; kp < 8; ++kp) { const bf16x8 pf = pack_p(s[2 * kp], s[2 * kp + 1]);
#pragma unroll
            for (int db = 0; db < 8; ++db) { const bf16x8 af = vt_frag(Vl + (32 * kp + 4 * g + (c >> 2)) * KS + (16 * db + 4 * (c & 3)) * 2, 16 * KS); o[db] = MFMA16(af, pf, o[db]); }
            __builtin_amdgcn_sched_barrier(0); }
        const float inv = 1.f / l;
#pragma unroll
        for (int db = 0; db < 8; ++db) { const f32x4 v = o[db] * inv; u32x2 wv; wv.x = pk2(v[0], v[1]); wv.y = pk2(v[2], v[3]); *(u32x2*)(OX + t * 512 + hx * 128 + 16 * db + 4 * g) = wv; }
    }
    __syncthreads();
}

__device__ __forceinline__ int mono_i(float x) { int i = __float_as_int(x); return i ^ ((i >> 31) & 0x7fffffff); }
__device__ __forceinline__ float mono_f(int i) { return __int_as_float(i ^ ((i >> 31) & 0x7fffffff)); }
#define INS16(L, v) do { int _v = (v); _Pragma("unroll") for (int _k = 0; _k < 16; ++_k) { const int _t = max(L[_k], _v); _v = min(L[_k], _v); L[_k] = _t; } } while (0)
#define CE_DESC(x, y) do { const int _h = max((x), (y)), _l = min((x), (y)); (x) = _h; (y) = _l; } while (0)
#define SORT16_DESC(L) do { \
    CE_DESC(L[0], L[1]); \
    CE_DESC(L[2], L[3]); \
    CE_DESC(L[0], L[2]); \
    CE_DESC(L[1], L[3]); \
    CE_DESC(L[1], L[2]); \
    CE_DESC(L[4], L[5]); \
    CE_DESC(L[6], L[7]); \
    CE_DESC(L[4], L[6]); \
    CE_DESC(L[5], L[7]); \
    CE_DESC(L[5], L[6]); \
    CE_DESC(L[0], L[4]); \
    CE_DESC(L[2], L[6]); \
    CE_DESC(L[2], L[4]); \
    CE_DESC(L[1], L[5]); \
    CE_DESC(L[3], L[7]); \
    CE_DESC(L[3], L[5]); \
    CE_DESC(L[1], L[2]); \
    CE_DESC(L[3], L[4]); \
    CE_DESC(L[5], L[6]); \
    CE_DESC(L[8], L[9]); \
    CE_DESC(L[10], L[11]); \
    CE_DESC(L[8], L[10]); \
    CE_DESC(L[9], L[11]); \
    CE_DESC(L[9], L[10]); \
    CE_DESC(L[12], L[13]); \
    CE_DESC(L[14], L[15]); \
    CE_DESC(L[12], L[14]); \
    CE_DESC(L[13], L[15]); \
    CE_DESC(L[13], L[14]); \
    CE_DESC(L[8], L[12]); \
    CE_DESC(L[10], L[14]); \
    CE_DESC(L[10], L[12]); \
    CE_DESC(L[9], L[13]); \
    CE_DESC(L[11], L[15]); \
    CE_DESC(L[11], L[13]); \
    CE_DESC(L[9], L[10]); \
    CE_DESC(L[11], L[12]); \
    CE_DESC(L[13], L[14]); \
    CE_DESC(L[0], L[8]); \
    CE_DESC(L[4], L[12]); \
    CE_DESC(L[4], L[8]); \
    CE_DESC(L[2], L[10]); \
    CE_DESC(L[6], L[14]); \
    CE_DESC(L[6], L[10]); \
    CE_DESC(L[2], L[4]); \
    CE_DESC(L[6], L[8]); \
    CE_DESC(L[10], L[12]); \
    CE_DESC(L[1], L[9]); \
    CE_DESC(L[5], L[13]); \
    CE_DESC(L[5], L[9]); \
    CE_DESC(L[3], L[11]); \
    CE_DESC(L[7], L[15]); \
    CE_DESC(L[7], L[11]); \
    CE_DESC(L[3], L[5]); \
    CE_DESC(L[7], L[9]); \
    CE_DESC(L[11], L[13]); \
    CE_DESC(L[1], L[2]); \
    CE_DESC(L[3], L[4]); \
    CE_DESC(L[5], L[6]); \
    CE_DESC(L[7], L[8]); \
    CE_DESC(L[9], L[10]); \
    CE_DESC(L[11], L[12]); \
    CE_DESC(L[13], L[14]); \
} while (0)

__device__ __forceinline__ void bitonic_fix16(int (&L)[16]) {
    CE_DESC(L[0], L[8]); CE_DESC(L[1], L[9]); CE_DESC(L[2], L[10]); CE_DESC(L[3], L[11]); CE_DESC(L[4], L[12]); CE_DESC(L[5], L[13]); CE_DESC(L[6], L[14]); CE_DESC(L[7], L[15]);
    CE_DESC(L[0], L[4]); CE_DESC(L[1], L[5]); CE_DESC(L[2], L[6]); CE_DESC(L[3], L[7]); CE_DESC(L[8], L[12]); CE_DESC(L[9], L[13]); CE_DESC(L[10], L[14]); CE_DESC(L[11], L[15]);
    CE_DESC(L[0], L[2]); CE_DESC(L[1], L[3]); CE_DESC(L[4], L[6]); CE_DESC(L[5], L[7]); CE_DESC(L[8], L[10]); CE_DESC(L[9], L[11]); CE_DESC(L[12], L[14]); CE_DESC(L[13], L[15]);
    CE_DESC(L[0], L[1]); CE_DESC(L[2], L[3]); CE_DESC(L[4], L[5]); CE_DESC(L[6], L[7]); CE_DESC(L[8], L[9]); CE_DESC(L[10], L[11]); CE_DESC(L[12], L[13]); CE_DESC(L[14], L[15]);
}
__device__ __forceinline__ void merge16(int (&L)[16], int xm) {
    int P[16];
#pragma unroll
    for (int i = 0; i < 16; ++i) P[i] = __shfl_xor(L[i], xm);
#pragma unroll
    for (int i = 0; i < 16; ++i) L[i] = max(L[i], P[15 - i]);
    bitonic_fix16(L);
}
__device__ __forceinline__ void peer_topk_unit(LAS unsigned char* lds, int pm, int h, const bf16_t* PQ, const float* subk, int* EXP, float* GATE) {
    constexpr int KS = 272;
    const int tid = threadIdx.x, lane = tid & 63, c = lane & 15, g = lane >> 4; const int w = __builtin_amdgcn_readfirstlane(tid >> 6);
    const float* sk = subk + (size_t)h * 2 * 128 * 128;
    for (int i = tid; i < 8192; i += 512) { const int row = i >> 5, ch = i & 31; const f32x4 v = *(const f32x4*)(sk + (size_t)row * 128 + ch * 4);
        u32x2 wv; wv.x = pk2(v[0], v[1]); wv.y = pk2(v[2], v[3]); *(LAS u32x2*)(lds + row * KS + ch * 8) = wv; }
    __syncthreads();
#pragma unroll 1
    for (int grp = 0; grp < 2; ++grp) {
        const size_t t = (size_t)pm * 256 + 32 * w + 16 * grp + c;
        int S1[16], S2[16];
        bf16x8 qall[2][4];
#pragma unroll
        for (int p = 0; p < 2; ++p)
#pragma unroll
            for (int ks = 0; ks < 4; ++ks) qall[p][ks] = *(const bf16x8*)(PQ + t * DM + h * 256 + p * 128 + ks * 32 + 8 * g);
#pragma unroll
        for (int p = 0; p < 2; ++p) {
            bf16x8 qf[4];
#pragma unroll
            for (int ks = 0; ks < 4; ++ks) qf[ks] = qall[p][ks];
            int A[16], B[16];
#pragma unroll
            for (int blk = 0; blk < 8; ++blk) { f32x4 acc = {0.f, 0.f, 0.f, 0.f};
#pragma unroll
                for (int ks = 0; ks < 4; ++ks) { const bf16x8 kf = *(LAS const bf16x8*)(lds + (p * 128 + 16 * blk + c) * KS + (ks * 32 + 8 * g) * 2); acc = MFMA16(kf, qf[ks], acc); }
#pragma unroll
                for (int r = 0; r < 4; ++r) { const int idx = 16 * blk + 4 * g + r; const int key = (mono_i(acc[r]) & ~127) | (127 - idx); if (blk < 4) A[4 * blk + r] = key; else B[4 * (blk - 4) + r] = key; }
                __builtin_amdgcn_sched_barrier(0); }
            SORT16_DESC(A); SORT16_DESC(B);
#pragma unroll
            for (int i = 0; i < 16; ++i) A[i] = max(A[i], B[15 - i]);
            bitonic_fix16(A);
            merge16(A, 16); merge16(A, 32);
#pragma unroll
            for (int k = 0; k < 16; ++k) { if (p == 0) S1[k] = A[k]; else S2[k] = A[k]; }
        }
        float s1v[16], s2v[16];
#pragma unroll
        for (int k = 0; k < 16; ++k) { s1v[k] = mono_f(S1[k] & ~127); s2v[k] = mono_f(S2[k] & ~127); }
        int Mx[16];
#pragma unroll
        for (int k = 0; k < 16; ++k) Mx[k] = (int)0x80000000;
#define STAIR4(a0, b0, a1, b1, a2, b2, a3, b3) do { const float _c0 = s1v[a0] + s2v[b0], _c1 = s1v[a1] + s2v[b1], _c2 = s1v[a2] + s2v[b2], _c3 = s1v[a3] + s2v[b3]; \
        const float _m = (g == 0) ? _c0 : (g == 1) ? _c1 : (g == 2) ? _c2 : _c3; const int _cd = (g == 0) ? (255 - (16 * a0 + b0)) : (g == 1) ? (255 - (16 * a1 + b1)) : (g == 2) ? (255 - (16 * a2 + b2)) : (255 - (16 * a3 + b3)); \
        INS16(Mx, (mono_i(_m) & ~255) | _cd); } while (0)
#define STAIR2(a0, b0, a1, b1) do { const float _c0 = s1v[a0] + s2v[b0], _c1 = s1v[a1] + s2v[b1]; const float _m = (g == 0) ? _c0 : _c1; const int _cd = (g == 0) ? (255 - (16 * a0 + b0)) : (255 - (16 * a1 + b1)); \
        const int _key = (mono_i(_m) & ~255) | _cd; INS16(Mx, (g < 2) ? _key : (int)0x80000000); } while (0)
        STAIR4(0, 0, 0, 1, 0, 2, 0, 3);
        STAIR4(0, 4, 0, 5, 0, 6, 0, 7);
        STAIR4(0, 8, 0, 9, 0, 10, 0, 11);
        STAIR4(0, 12, 0, 13, 0, 14, 0, 15);
        STAIR4(1, 0, 1, 1, 1, 2, 1, 3);
        STAIR4(1, 4, 1, 5, 1, 6, 1, 7);
        STAIR4(2, 0, 2, 1, 2, 2, 2, 3);
        STAIR4(2, 4, 3, 0, 3, 1, 3, 2);
        STAIR4(3, 3, 4, 0, 4, 1, 4, 2);
        STAIR4(5, 0, 5, 1, 6, 0, 6, 1);
        STAIR4(7, 0, 7, 1, 8, 0, 9, 0);
        STAIR4(10, 0, 11, 0, 12, 0, 13, 0);
        STAIR2(14, 0, 15, 0);
#undef STAIR4
#undef STAIR2
        merge16(Mx, 16); merge16(Mx, 32);
        const float top = mono_f(Mx[0] & ~255); float wg[4]; int ex[4]; float wsum = 0.f;
#pragma unroll
        for (int i = 0; i < 4; ++i) { const int key = (g == 0) ? Mx[i] : (g == 1) ? Mx[4 + i] : (g == 2) ? Mx[8 + i] : Mx[12 + i];
            wg[i] = __expf(mono_f(key & ~255) - top); wsum += wg[i];
            const int ab = 255 - (key & 255), a = ab >> 4, bb = ab & 15; int e1 = 0, e2 = 0;
#pragma unroll
            for (int k = 0; k < 16; ++k) { e1 = (a == k) ? (127 - (S1[k] & 127)) : e1; e2 = (bb == k) ? (127 - (S2[k] & 127)) : e2; }
            ex[i] = e1 * 128 + e2; }
        wsum += __shfl_xor(wsum, 16); wsum += __shfl_xor(wsum, 32);
        const float inv = 1.f / wsum;
        *(int4*)(EXP + t * 128 + h * 16 + 4 * g) = make_int4(ex[0], ex[1], ex[2], ex[3]);
        *(f32x4*)(GATE + t * 128 + h * 16 + 4 * g) = (f32x4){wg[0] * inv, wg[1] * inv, wg[2] * inv, wg[3] * inv};
    }
    __syncthreads();
}
typedef __bf16 v32bf16 __attribute__((ext_vector_type(32)));
typedef unsigned v6u32 __attribute__((ext_vector_type(6)));
constexpr int ROWB = 1536;
__device__ __forceinline__ float fdot2bf(bf16x2_t a, bf16x2_t b, float c) { return __builtin_amdgcn_fdot2_f32_bf16(a, b, c, false); }
__device__ __forceinline__ void row_to_fp6(const float* src, const float* colgain, unsigned char* dst, float* inv, int lane) {
    f32x4 v[8]; float am = 0.f;
#pragma unroll
    for (int j = 0; j < 8; ++j) { v[j] = *(const f32x4*)(src + 32 * lane + 4 * j); if (colgain) v[j] = v[j] * *(const f32x4*)(colgain + 32 * lane + 4 * j);
        am = fmaxf(am, fmaxf(fmaxf(fabsf(v[j][0]), fabsf(v[j][1])), fmaxf(fabsf(v[j][2]), fabsf(v[j][3])))); }
#pragma unroll
    for (int o = 1; o < 64; o <<= 1) am = fmaxf(am, __shfl_xor(am, o));
    float S = 1.f;
    if (am > 1e-30f) S = __uint_as_float(__float_as_uint(7.5f / am) & 0x7f800000u);
    unsigned pk[6] = {0u, 0u, 0u, 0u, 0u, 0u};
#pragma unroll
    for (int j = 0; j < 8; ++j)
#pragma unroll
        for (int i = 0; i < 4; ++i) { const float t = v[j][i] * S, a = fabsf(t);
            const float cf = (a < 2.f) ? rintf(a * 8.f) : (a < 4.f) ? 16.f + rintf((a - 2.f) * 4.f) : 24.f + rintf((a - 4.f) * 2.f);
            unsigned cd = (unsigned)fminf(cf, 31.f); if (t < 0.f) cd |= 32u;
            const int e = 4 * j + i, bit = 6 * e, dw = bit >> 5, sh = bit & 31;
            pk[dw] |= cd << sh; if (sh > 26) pk[dw + 1] |= cd >> (32 - sh); }
    *(u32x4*)(dst + 16 * lane) = (u32x4){pk[0], pk[1], pk[2], pk[3]}; *(u32x2*)(dst + 1024 + 8 * lane) = (u32x2){pk[4], pk[5]};
    if (lane == 0) *inv = 1.f / S;
}
__device__ __forceinline__ v32bf16 sw_unpack6(v6u32 s) {
    v32bf16 r;
#pragma unroll
    for (int e = 0; e < 32; ++e) { const int bit = 6 * e, dw = bit >> 5, sh = bit & 31; unsigned cd = s[dw] >> sh; if (sh > 26) cd |= s[dw + 1] << (32 - sh); cd &= 63u;
        const unsigned m = cd & 31u; float a = (m < 16u) ? (float)m * 0.125f : (m < 24u) ? 2.f + (float)(m - 16u) * 0.25f : 4.f + (float)(m - 24u) * 0.5f; if (cd & 32u) a = -a; r[e] = (__bf16)a; }
    return r;
}
constexpr int RING = 4;
typedef unsigned v16u32 __attribute__((ext_vector_type(16)));
__device__ __forceinline__ bf16x2_t as_pair(unsigned w) { return __builtin_bit_cast(bf16x2_t, w); }
#define PAIR(r, p) as_pair((r)[(p)])
__device__ __forceinline__ void peer_gather_token(LAS float* cw, LAS int* ew, size_t t, const bf16_t* X, const float* g_ffn, const float* g_fin,
                                                  const unsigned char* UB, const unsigned char* VB, const float* SU, const float* SV, const int* EXP, const float* GATE, float* OUT, int lane, LAS f32x4* xstash) {
    f32x4 xv[8]; float ss = 0.f; u32x4 xq[4];
    const bf16_t* xr = X + t * DM + 32 * lane;
#pragma unroll
    for (int j = 0; j < 4; ++j) xq[j] = *(const u32x4*)(xr + 8 * j);
#pragma unroll
    for (int j = 0; j < 4; ++j) { xv[2 * j] = (f32x4){bf_lo(xq[j].x), bf_hi(xq[j].x), bf_lo(xq[j].y), bf_hi(xq[j].y)}; xv[2 * j + 1] = (f32x4){bf_lo(xq[j].z), bf_hi(xq[j].z), bf_lo(xq[j].w), bf_hi(xq[j].w)}; }
#pragma unroll
    for (int j = 0; j < 8; ++j) ss += (xv[j][0] * xv[j][0] + xv[j][1] * xv[j][1]) + (xv[j][2] * xv[j][2] + xv[j][3] * xv[j][3]);
    ss = wave_sum(ss);
    const float rs = rsqrtf(ss * (1.f / DM) + EPS);
    bf16x2_t xb[16];
#pragma unroll
    for (int j = 0; j < 8; ++j) { const f32x4 a = xv[j] * rs * *(const f32x4*)(g_ffn + 32 * lane + 4 * j); xb[2 * j] = __builtin_bit_cast(bf16x2_t, pk2(a[0], a[1])); xb[2 * j + 1] = __builtin_bit_cast(bf16x2_t, pk2(a[2], a[3])); }
    {
        int k0 = (EXP[t * 128 + lane] << 7) | lane, k1 = (EXP[t * 128 + 64 + lane] << 7) | (64 + lane);
#pragma unroll
        for (int k = 2; k <= 128; k <<= 1)
#pragma unroll
            for (int j = k >> 1; j > 0; j >>= 1) {
                if (j == 64) { const int a = min(k0, k1), c = max(k0, k1); k0 = a; k1 = c; }
                else { const int p0 = __shfl_xor(k0, j), p1 = __shfl_xor(k1, j); const bool lower = (lane & j) == 0;
                       const bool asc0 = (k >= 64) ? true : ((lane & k) == 0), asc1 = (k == 128) ? true : ((k == 64) ? false : ((lane & k) == 0));
                       k0 = (lower == asc0) ? min(k0, p0) : max(k0, p0); k1 = (lower == asc1) ? min(k1, p1) : max(k1, p1); }
            }
        ew[lane] = k0; ew[lane + 64] = k1; }
#pragma unroll
    for (int j = 0; j < 4; ++j) xstash[j * 64 + lane] = __builtin_bit_cast(f32x4, xq[j]);
    asm volatile("s_waitcnt lgkmcnt(0)" ::: "memory");
    u32x4 ra[RING]; u32x2 rc[RING];
#define ROWLOAD(BASE, slot, k) do { const int _e = __builtin_amdgcn_readfirstlane(ew[(k)]) >> 7; const unsigned char* _rp = (BASE) + (size_t)_e * ROWB; \
        ra[slot] = *(const u32x4*)(_rp + 16 * lane); rc[slot] = *(const u32x2*)(_rp + 1024 + 8 * lane); } while (0)
#ifdef PROBE_SW_UNPACK
#define ROWCVT(slot) sw_unpack6((v6u32){ra[slot].x, ra[slot].y, ra[slot].z, ra[slot].w, rc[slot].x, rc[slot].y})
#else
#define ROWCVT(slot) __builtin_amdgcn_cvt_scalef32_pk32_bf16_fp6((v6u32){ra[slot].x, ra[slot].y, ra[slot].z, ra[slot].w, rc[slot].x, rc[slot].y}, 1.0f)
#endif
#pragma unroll
    for (int j = 0; j < RING; ++j) ROWLOAD(UB, j, j);
    const int eloc = ((lane >> 5) & 1) * 8 + ((lane >> 4) & 1) * 4 + ((lane >> 3) & 1) * 2 + ((lane >> 2) & 1);
    for (int b = 0; b < 8; ++b) {
        float part[16];
#pragma unroll
        for (int j = 0; j < 16; ++j) { const int slot = j & (RING - 1); const v16u32 r = __builtin_bit_cast(v16u32, ROWCVT(slot)); float a0 = 0.f, a1 = 0.f;
#pragma unroll
            for (int q = 0; q < 8; ++q) { a0 = fdot2bf(PAIR(r, 2 * q), xb[2 * q], a0); a1 = fdot2bf(PAIR(r, 2 * q + 1), xb[2 * q + 1], a1); }
            part[j] = a0 + a1;
            { const int sn = 16 * b + j + RING; const unsigned char* nb = (sn < 128) ? UB : VB; ROWLOAD(nb, slot, sn & 127); } }
        float q8[8], q4[4], q2[2], q1;
#pragma unroll
        for (int i = 0; i < 8; ++i) { const bool up = (lane & 32) != 0; const float snd = up ? part[i] : part[i + 8], kp = up ? part[i + 8] : part[i]; q8[i] = kp + __shfl_xor(snd, 32); }
#pragma unroll
        for (int i = 0; i < 4; ++i) { const bool up = (lane & 16) != 0; const float snd = up ? q8[i] : q8[i + 4], kp = up ? q8[i + 4] : q8[i]; q4[i] = kp + __shfl_xor(snd, 16); }
#pragma unroll
        for (int i = 0; i < 2; ++i) { const bool up = (lane & 8) != 0; const float snd = up ? q4[i] : q4[i + 2], kp = up ? q4[i + 2] : q4[i]; q2[i] = kp + __shfl_xor(snd, 8); }
        { const bool up = (lane & 4) != 0; const float snd = up ? q2[0] : q2[1], kp = up ? q2[1] : q2[0]; q1 = kp + __shfl_xor(snd, 4); }
        q1 += __shfl_xor(q1, 1); q1 += __shfl_xor(q1, 2);
        if ((lane & 3) == 0) { const int k = 16 * b + eloc; const int key = ew[k], e = key >> 7; const float av = q1 * SU[e]; const float gl = 0.5f * av * (1.f + erff(av * 0.70710678118654752f)); cw[k] = gl * GATE[t * 128 + (key & 127)] * SV[e]; }
    }
    asm volatile("s_waitcnt lgkmcnt(0)" ::: "memory");
    float acc[32];
#pragma unroll
    for (int i = 0; i < 32; ++i) acc[i] = 0.f;
    for (int k0 = 0; k0 < 128; k0 += RING) {
#pragma unroll
        for (int j = 0; j < RING; ++j) { const float cv = cw[k0 + j]; const unsigned clo_u = pk2(cv, 0.f); const bf16x2_t clo = __builtin_bit_cast(bf16x2_t, clo_u), chi = __builtin_bit_cast(bf16x2_t, clo_u << 16);
            const v16u32 r = __builtin_bit_cast(v16u32, ROWCVT(j));
#pragma unroll
            for (int q = 0; q < 16; ++q) { acc[2 * q] = fdot2bf(PAIR(r, q), clo, acc[2 * q]); acc[2 * q + 1] = fdot2bf(PAIR(r, q), chi, acc[2 * q + 1]); }
            const int kn = min(k0 + j + RING, 127); ROWLOAD(VB, j, kn); }
    }
#undef ROWLOAD
#undef ROWCVT
#ifdef PROBE_NO_PEER
#pragma unroll
    for (int i = 0; i < 32; ++i) acc[i] = 0.f;
#endif
    float s3 = 0.f;
#pragma unroll
    for (int j = 0; j < 4; ++j) { const u32x4 q = __builtin_bit_cast(u32x4, xstash[j * 64 + lane]); xv[2 * j] = (f32x4){bf_lo(q.x), bf_hi(q.x), bf_lo(q.y), bf_hi(q.y)}; xv[2 * j + 1] = (f32x4){bf_lo(q.z), bf_hi(q.z), bf_lo(q.w), bf_hi(q.w)}; }
#pragma unroll
    for (int j = 0; j < 8; ++j)
#pragma unroll
        for (int i = 0; i < 4; ++i) { xv[j][i] += acc[4 * j + i]; s3 += xv[j][i] * xv[j][i]; }
    s3 = wave_sum(s3);
    const float r3 = rsqrtf(s3 * (1.f / DM) + EPS);
    float* orow = OUT + t * DM + 32 * lane;
#pragma unroll
    for (int j = 0; j < 8; ++j) { const f32x4 g0 = *(const f32x4*)(g_fin + 32 * lane + 4 * j); *(f32x4*)(orow + 4 * j) = xv[j] * r3 * g0; }
}

constexpr unsigned NF1 = 896;
__device__ __forceinline__ void fp8_chunk(int chunk, int wave, int lane, const float* peer_u, const float* peer_v, const float* g_ffn, unsigned char* UB, unsigned char* VB, float* SU, float* SV) {
#pragma unroll 1
    for (int r = 0; r < 2; ++r) { const int row = chunk * 16 + wave * 2 + r;
        if (row < 16384) row_to_fp6(peer_u + (size_t)row * DM, nullptr, UB + (size_t)row * ROWB, SU + row, lane);
        else row_to_fp6(peer_v + (size_t)(row - 16384) * DM, nullptr, VB + (size_t)(row - 16384) * ROWB, SV + (row - 16384), lane); }
}
constexpr int NWAVES = 8, LDS_BYTES = 163840, MISC_OFF = 159744;
constexpr int N_PHASES = 10;
struct Args { const void* in[21]; float* out; unsigned char* ws; int ph_lo, ph_hi; float inv_freq[128]; };

#define IN_x ((const float*)((const float*)args.in[0]))
#define IN_mem ((const float*)((const float*)args.in[1]))
#define IN_positions ((const int*)((const int*)args.in[2]))
#define IN_g_mix ((const float*)((const float*)args.in[3]))
#define IN_w_in ((const float*)((const float*)args.in[4]))
#define IN_sinks ((const float*)((const float*)args.in[5]))
#define IN_att_gain ((const float*)((const float*)args.in[6]))
#define IN_ret_gain ((const float*)((const float*)args.in[7]))
#define IN_w_out ((const float*)((const float*)args.in[8]))
#define IN_g_cross ((const float*)((const float*)args.in[9]))
#define IN_g_mem ((const float*)((const float*)args.in[10]))
#define IN_w_xq ((const float*)((const float*)args.in[11]))
#define IN_w_xk ((const float*)((const float*)args.in[12]))
#define IN_w_xv ((const float*)((const float*)args.in[13]))
#define IN_w_xo ((const float*)((const float*)args.in[14]))
#define IN_g_ffn ((const float*)((const float*)args.in[15]))
#define IN_w_pq ((const float*)((const float*)args.in[16]))
#define IN_subk ((const float*)((const float*)args.in[17]))
#define IN_peer_u ((const float*)((const float*)args.in[18]))
#define IN_peer_v ((const float*)((const float*)args.in[19]))
#define IN_g_fin ((const float*)((const float*)args.in[20]))
#define IN_out ((float*)(args.out))
#define WIN ((bf16_t*)((bf16_t*)(ws + WS_WIN)))
#define WOUT ((bf16_t*)((bf16_t*)(ws + WS_WOUT)))
#define WXQ ((bf16_t*)((bf16_t*)(ws + WS_WXQ)))
#define WXKV ((bf16_t*)((bf16_t*)(ws + WS_WXKV)))
#define WXO ((bf16_t*)((bf16_t*)(ws + WS_WXO)))
#define WPQ ((bf16_t*)((bf16_t*)(ws + WS_WPQ)))
#define XB ((bf16_t*)((bf16_t*)(ws + WS_XB)))
#define MEMB ((bf16_t*)((bf16_t*)(ws + WS_MEMB)))
#define COSA ((float*)((float*)(ws + WS_COSA)))
#define SINA ((float*)((float*)(ws + WS_SINA)))
#define COSR ((float*)((float*)(ws + WS_COSR)))
#define SINR ((float*)((float*)(ws + WS_SINR)))
#define SS0 ((float*)((float*)(ws + WS_SS0)))
#define SS1 ((float*)((float*)(ws + WS_SS1)))
#define SS2 ((float*)((float*)(ws + WS_SS2)))
#define SSM ((float*)((float*)(ws + WS_SSM)))
#define KX ((bf16_t*)((bf16_t*)(ws + WS_KX)))
#define VX ((bf16_t*)((bf16_t*)(ws + WS_VX)))
#define QX ((bf16_t*)((bf16_t*)(ws + WS_QX)))
#define OX ((bf16_t*)((bf16_t*)(ws + WS_OX)))
#define EXPI ((int*)((int*)(ws + WS_EXP)))
#define GATE ((float*)((float*)(ws + WS_GATE)))
#define Y ((bf16_t*)((bf16_t*)(ws + WS_Y)))
#define PQ ((bf16_t*)((bf16_t*)(ws + WS_Y)))
#define QA ((bf16_t*)((bf16_t*)(ws + WS_QA)))
#define KA ((bf16_t*)((bf16_t*)(ws + WS_KA)))
#define VA ((bf16_t*)((bf16_t*)(ws + WS_VA)))
#define QR ((bf16_t*)((bf16_t*)(ws + WS_QR)))
#define KR ((bf16_t*)((bf16_t*)(ws + WS_KR)))
#define VR ((bf16_t*)((bf16_t*)(ws + WS_VR)))
#define GR ((bf16_t*)((bf16_t*)(ws + WS_GR)))
#define UB ((unsigned char*)(ws + WS_UB))
#define VB ((unsigned char*)(ws + WS_VB))
#define SU ((float*)((float*)(ws + WS_SU)))
#define SV ((float*)((float*)(ws + WS_SV)))
__global__ void __launch_bounds__(NWAVES * 64, 2) fwd_kernel(Args args) {
    extern __shared__ __attribute__((aligned(16))) unsigned char lds_raw[];
    LAS unsigned char* lds = (LAS unsigned char*)lds_raw;
    const int tid = threadIdx.x, lane = tid & 63; const int wave = __builtin_amdgcn_readfirstlane(tid >> 6);
    const int G = gridDim.x; const int bx = blockIdx.x; const int vcu = (G % 8 == 0) ? (bx % 8) * (G / 8) + bx / 8 : bx;
    unsigned char* ws = args.ws;
    float* const out_base = args.out;
    for (int u = tid; u < (LDS_BYTES - MISC_OFF) / 4; u += NWAVES * 64) ((LAS unsigned*)(lds + MISC_OFF))[u] = 0u;
    __syncthreads();
    const int lo = args.ph_lo, hi = args.ph_hi;
    const bool use_bar = (hi - lo) > 1;
    XcdBarrier bar; bar.bar = (unsigned*)(ws + WS_CTL) + 1024; bar.x = 0; bar.st = nullptr;
    if (use_bar) bar = xcd_barrier_post((unsigned*)(ws + WS_CTL) + 1024, (volatile LAS unsigned*)(lds + MISC_OFF) + 8);
#ifdef ONLY_PHASE
#define PHASE_ON(k) ((k) == ONLY_PHASE)
#else
#define PHASE_ON(k) true
#endif
#define IN(k) (lo <= (k) && (k) < hi)
#ifdef REPEAT_PHASE
#define REP(k) for (int _rep = 0; _rep < (((k) == REPEAT_PHASE) ? 2 : 1); ++_rep)
#else
#define REP(k)
#endif
#define SEAM(k) do { if (IN(k) && IN((k) + 1)) xcd_barrier(bar); } while (0)
    const int gw = vcu * NWAVES + wave, NGW = G * NWAVES;

    REP(0) if (PHASE_ON(0) && IN(0)) {
        LAS float* scr = (LAS float*)(lds + wave * 8448);
        constexpr int I_IN = 32 * (IN_COLS / 32), I_XQ = 32 * 16;
        constexpr int NITEMS = I_IN + 2 * I_XQ;
        for (int it = gw; it < NITEMS; it += NGW) {
            int r = it;
            if (r < I_IN) { p0_transpose_item<true>(IN_w_in, IN_g_mix, DM, IN_COLS, WIN, 0, scr, r, lane); continue; } r -= I_IN;
            if (r < I_XQ) { p0_transpose_item<false>(IN_w_xk, IN_g_mem, DM, 512, WXKV, 0, scr, r, lane); continue; } r -= I_XQ;
            p0_transpose_item<false>(IN_w_xv, IN_g_mem, DM, 512, WXKV, 512, scr, r, lane);
        }
        for (int m = gw; m < T_TOK; m += 2 * NGW) row2_to_bf16(IN_x + (size_t)m * DM, XB + (size_t)m * DM, SS0 + m, (size_t)NGW, lane);
        for (int m = gw; m < MT; m += NGW) row_to_bf16(IN_mem + (size_t)m * DM, MEMB + (size_t)m * DM, SSM + m, lane);
        const int gt = vcu * (NWAVES * 64) + tid, NGT = G * NWAVES * 64;
        for (int i = gt; i < T_TOK * 128; i += NGT) { const int tok = i >> 7, f = i & 127; const float ang = (float)IN_positions[tok] * args.inv_freq[f]; float cc, sn; sincos_red(ang, cc, sn);
            COSR[i] = cc; SINR[i] = sn; }
        for (int i = gt; i < T_TOK * 32; i += NGT) { const int tok = i >> 5, f = i & 31; const float ang = (float)IN_positions[tok] * args.inv_freq[4 * f]; float cc, sn; sincos_red(ang, cc, sn);
            COSA[i] = cc; SINA[i] = sn; }
        for (int i = gt; i < T_TOK; i += NGT) { SS1[i] = 0.f; SS2[i] = 0.f; }
        __syncthreads();
    }
    SEAM(0);
    REP(1) if (PHASE_ON(1) && IN(1)) {
        pg8::Sched S; S.A = (const char*)XB; S.B = (const char*)WIN; S.nM = T_TOK / 256; S.nN = IN_COLS / 256; S.nwg = S.nM * S.nN;
        S.A2 = (const char*)MEMB; S.B2 = (const char*)WXKV; S.nM2 = MT / 256; S.nwg2 = (MT / 256) * 4; S.G = G; S.c = bx; S.WGM = WGM_P1; S.tstep = (size_t)256 * DM * 2;
        EpiP1 E{ws};
        pg8::gemm_phase<EpiP1>(lds, DM, S, E);
        unsigned* qctr = (unsigned*)(ws + WS_CTL) + 8192 + 64; volatile LAS unsigned* qw = (volatile LAS unsigned*)(lds + MISC_OFF) + 16;
        LAS float* scr = (LAS float*)(lds + wave * 8448);
        for (;;) {
            if (tid == 0) qw[0] = atomicAdd(qctr, 1u);
            __syncthreads(); const unsigned chunk = qw[0]; __syncthreads();
            if (chunk >= 640u + NF1) break;
            if (chunk < 640u) { int r = (int)chunk * 8 + wave;
                if (r < 2048) p0_transpose_item<false>(IN_w_out, nullptr, DM, DM, WOUT, 0, scr, r, lane);
                else if ((r -= 2048) < 512) p0_transpose_item<false>(IN_w_xq, IN_g_cross, DM, 512, WXQ, 0, scr, r, lane);
                else if ((r -= 512) < 512) p0_transpose_item<false>(IN_w_xo, nullptr, 512, DM, WXO, 0, scr, r, lane);
                else p0_transpose_item<false>(IN_w_pq, IN_g_ffn, DM, DM, WPQ, 0, scr, r - 512, lane);
            } else fp8_chunk((int)chunk - 640, wave, lane, IN_peer_u, IN_peer_v, IN_g_ffn, UB, VB, SU, SV);
        }
    }
    SEAM(1);
    REP(2) if (PHASE_ON(2) && IN(2)) {
#ifdef PROBE_RET_X
        for (int rr = 0; rr < PROBE_RET_X; ++rr)
#endif
        for (int u = vcu; u < 256; u += G) { const int bh = u >> 3, s = u & 7; ret_unit(lds, bh >> 2, bh & 3, s, QR, KR, VR, GR, IN_ret_gain, Y); ret_unit(lds, bh >> 2, bh & 3, 15 - s, QR, KR, VR, GR, IN_ret_gain, Y); }
#ifdef PROBE_SWA_X
        for (int rr = 0; rr < PROBE_SWA_X; ++rr)
#endif
        for (int u = vcu; u < 256; u += G) swa_unit(lds, u >> 5, (u >> 1) & 15, u & 1, QA, KA, VA, IN_sinks, IN_att_gain, Y);
    }
    SEAM(2);
    if (PHASE_ON(3) && IN(3)) {
        pg8::Sched S; S.A = (const char*)Y; S.B = (const char*)WOUT; S.WGM = WGM_P3; S.nM = T_TOK / 256; S.nN = DM / 256; S.nwg = S.nM * S.nN; S.A2 = nullptr; S.B2 = nullptr; S.nM2 = 1; S.nwg2 = 0; S.G = G; S.c = bx; S.tstep = (size_t)256 * DM * 2;
        EpiRes1 E{XB, SS1};
        pg8::gemm_phase<EpiRes1, false>(lds, DM, S, E);
    }
    SEAM(3);
    REP(4) if (PHASE_ON(4) && IN(4)) {
        pg8::Sched S; S.A = (const char*)XB; S.B = (const char*)WXQ; S.WGM = WGM_P4; S.nM = T_TOK / 256; S.nN = 2; S.nwg = S.nM * S.nN; S.A2 = nullptr; S.B2 = nullptr; S.nM2 = 1; S.nwg2 = 0; S.G = G; S.c = bx; S.tstep = (size_t)256 * DM * 2;
        EpiScale E{QX, 512, SS1, C3Q};
        pg8::gemm_phase<EpiScale>(lds, DM, S, E);
        unsigned* qctr = (unsigned*)(ws + WS_CTL) + 8192; volatile LAS unsigned* qw = (volatile LAS unsigned*)(lds + MISC_OFF) + 16;
        for (;;) {
            if (tid == 0) qw[0] = atomicAdd(qctr, 1u);
            __syncthreads(); const unsigned chunk = qw[0] + NF1; __syncthreads();
            if (chunk >= 2048u) break;
            fp8_chunk((int)chunk, wave, lane, IN_peer_u, IN_peer_v, IN_g_ffn, UB, VB, SU, SV);
        }
    }
    SEAM(4);
    REP(5) if (PHASE_ON(5) && IN(5)) { for (int u = vcu; u < 256; u += G) xattn_unit(lds, u >> 5, (u >> 3) & 3, u & 7, QX, KX, VX, OX); }
    SEAM(5);
    if (PHASE_ON(6) && IN(6)) {
        pg8::Sched S; S.A = (const char*)OX; S.B = (const char*)WXO; S.WGM = WGM_P6; S.nM = T_TOK / 256; S.nN = DM / 256; S.nwg = S.nM * S.nN; S.A2 = nullptr; S.B2 = nullptr; S.nM2 = 1; S.nwg2 = 0; S.G = G; S.c = bx; S.tstep = (size_t)256 * 512 * 2;
        EpiRes2 E{XB, SS2};
        pg8::gemm_phase<EpiRes2, false>(lds, 512, S, E);
    }
    SEAM(6);
    REP(7) if (PHASE_ON(7) && IN(7)) {
        pg8::Sched S; S.A = (const char*)XB; S.B = (const char*)WPQ; S.WGM = WGM_P7; S.nM = T_TOK / 256; S.nN = DM / 256; S.nwg = S.nM * S.nN; S.A2 = nullptr; S.B2 = nullptr; S.nM2 = 1; S.nwg2 = 0; S.G = G; S.c = bx; S.tstep = (size_t)256 * DM * 2;
        EpiScale E{PQ, DM, SS2, 1.f};
        pg8::gemm_phase<EpiScale>(lds, DM, S, E);
        asm volatile("s_waitcnt vmcnt(0)" ::: "memory"); __syncthreads();
        { pg8::Unit u; for (int i = 0; S.next(i, u); ++i) peer_topk_unit(lds, u.pm, u.pn, PQ, IN_subk, EXPI, GATE); }
    }
    SEAM(7);
    if (PHASE_ON(9) && IN(9)) {
        LAS float* cw = (LAS float*)(lds + wave * 1024); LAS int* ew = (LAS int*)(lds + wave * 1024 + 512);
        LAS f32x4* xstash = (LAS f32x4*)(lds + 8192 + wave * 8192);
        for (int t = gw; t < T_TOK; t += NGW) peer_gather_token(cw, ew, (size_t)t, XB, IN_g_ffn, IN_g_fin, UB, VB, SU, SV, EXPI, GATE, IN_out, lane, xstash);
    }
#undef IN
#undef SEAM
}

extern "C" void kernel_launch(void* const* d_in, const int* in_sizes, int n_in, void* d_out, int out_size, void* d_ws, size_t ws_size, hipStream_t stream) {
    static int grid = 0;
    if (grid == 0) {
        if (n_in != 21 || out_size != T_TOK * DM || ws_size < WS_END) { fprintf(stderr, "kernel_launch: unexpected problem (n_in %d out %d ws %zu)\n", n_in, out_size, ws_size); grid = -1; return; }
        int dev = 0, cus = 0;
        if (hipGetDevice(&dev) != hipSuccess || hipDeviceGetAttribute(&cus, hipDeviceAttributeMultiprocessorCount, dev) != hipSuccess) { grid = -1; return; }
        if (hipFuncSetAttribute((const void*)fwd_kernel, hipFuncAttributeMaxDynamicSharedMemorySize, LDS_BYTES) != hipSuccess) { fprintf(stderr, "kernel_launch: hipFuncSetAttribute failed\n"); grid = -1; return; }
        (void)hipGetLastError();
        grid = cus;
    }
    if (grid < 0) return;
    (void)hipMemsetAsync((char*)d_ws + WS_CTL, 0, CTL_ZERO_BYTES, stream);
    Args a{};
    for (int i = 0; i < 21; ++i) a.in[i] = d_in[i];
    a.out = (float*)d_out; a.ws = (unsigned char*)d_ws;
    for (int i = 0; i < 128; ++i) a.inv_freq[i] = (float)pow(10000.0, -(double)(2 * i) / 256.0);
#ifdef MK_PER_PHASE
    for (int p = 0; p < N_PHASES; ++p) { a.ph_lo = p; a.ph_hi = p + 1;
#ifdef REPEAT_LAUNCH
        if (p == REPEAT_LAUNCH) for (int r = 0; r < 4; ++r) hipLaunchKernelGGL(fwd_kernel, dim3(grid), dim3(NWAVES * 64), LDS_BYTES, stream, a);
#endif
        hipLaunchKernelGGL(fwd_kernel, dim3(grid), dim3(NWAVES * 64), LDS_BYTES, stream, a); }
#else
    a.ph_lo = 0; a.ph_hi = N_PHASES; hipLaunchKernelGGL(fwd_kernel, dim3(grid), dim3(NWAVES * 64), LDS_BYTES, stream, a);
#endif
}
```

```cpp
#include <hip/hip_runtime.h>
#include <cstdio>
#include <cstdint>
#include <cmath>
#ifndef WGM_P1
#define WGM_P1 4
#endif
#ifndef WGM_P3
#define WGM_P3 4
#endif
#ifndef WGM_P4
#define WGM_P4 4
#endif
#ifndef WGM_P6
#define WGM_P6 4
#endif
#ifndef WGM_P7
#define WGM_P7 4
#endif
namespace pg8 {
#define PG8_LAS __attribute__((address_space(3)))
typedef unsigned short bf16_t;
typedef short bf16x8 __attribute__((ext_vector_type(8)));
typedef float f32x4 __attribute__((ext_vector_type(4)));
typedef unsigned u32x4 __attribute__((ext_vector_type(4)));
typedef unsigned u32x2 __attribute__((ext_vector_type(2)));
constexpr int BM = 256, BK = 64, HALF = 128, HTB = HALF * BK * 2  , STAGE_BYTES = 8 * HTB, NXCD = 8;

__host__ __device__ __forceinline__ int lds_byte(int r, int c) { const int st = (r >> 4) * 2 + (c >> 5), rr = r & 15, cc = c & 31, ob = rr * 64 + cc * 2; return st * 1024 + (ob ^ (((ob >> 9) & 1) << 5)); }
__host__ __device__ __forceinline__ void stage_rc(int b, int& R, int& C) { const int st = b / 1024, sb = b % 1024, swz = sb ^ (((sb >> 9) & 1) << 5); R = (st >> 1) * 16 + swz / 64; C = (st & 1) * 32 + (swz % 64) / 2; }
__host__ __device__ __forceinline__ int perm32(int rho) { const int n = rho >> 4, i = rho & 15; return 8 * (i >> 2) + 4 * n + (i & 3); }

struct Unit { int pm, pn, kind; const char* a; const char* b; };

struct Sched {
    const char *A, *B, *A2, *B2; int nM, nN, nwg, nM2, nwg2, G, c, WGM; size_t tstep;
    __device__ __forceinline__ bool next(int i, Unit& u) const {
        const long L = (long)i * G + c;
        if (L < nwg) {
            int wgid = (int)L; { const int q = nwg / NXCD, r = nwg % NXCD, xcd = wgid % NXCD, off = wgid / NXCD; wgid = (xcd < r ? xcd * (q + 1) : r * (q + 1) + (xcd - r) * q) + off; }
            const int nig = WGM * nN, gid = wgid / nig, fm = gid * WGM, gsz = (nM - fm) < WGM ? (nM - fm) : WGM;
            u.pm = fm + ((wgid % nig) % gsz); u.pn = (wgid % nig) / gsz; u.kind = 0; u.a = A + (size_t)u.pm * tstep; u.b = B + (size_t)u.pn * tstep; return true;
        }
        const long L2 = L - nwg; if (L2 >= nwg2) return false;
        u.pm = (int)(L2 % nM2); u.pn = (int)(L2 / nM2); u.kind = 1; u.a = A2 + (size_t)u.pm * tstep; u.b = B2 + (size_t)u.pn * tstep; return true;
    }
};

__device__ __forceinline__ unsigned cvt_pk_bf16(float lo, float hi) { unsigned r; asm volatile("v_cvt_pk_bf16_f32 %0, %1, %2" : "=v"(r) : "v"(lo), "v"(hi)); return r; }

template <class Epi, bool ALIGN_EPI = true, bool SP2 = true>
__device__ __forceinline__ void gemm_phase(PG8_LAS unsigned char* lds, const int K, const Sched& S, const Epi& E) {
    const int tid = threadIdx.x, wid = __builtin_amdgcn_readfirstlane(tid >> 6), lane = tid & 63, wr = wid >> 2, wc = wid & 3, fr = lane & 15, fq = lane >> 4;
    const int nt = K / BK;
    unsigned voffA[2], voffB[2];
#pragma unroll
    for (int i = 0; i < 2; ++i) { int R, C; stage_rc(tid * 16 + i * 8192, R, C); const int Rb = Epi::PERM ? ((R & ~31) + perm32(R & 31)) : R;
        voffA[i] = (unsigned)(R * K + C) * 2u; voffB[i] = (unsigned)(Rb * K + C) * 2u; }
    const size_t kstep = (size_t)(BK * 2);
    const size_t hstep = (size_t)HALF * K * 2;
    const unsigned ldsw = (unsigned)wid * 1024u;
    const int aoff = lds_byte(wr * 64 + fr, fq * 8), boff = lds_byte(wc * 32 + fr, fq * 8);
#define PG8_SA(b, h) (((b) * 2 + (h)) * HTB)
#define PG8_SB(b, h) ((4 + (b) * 2 + (h)) * HTB)
#define PG8_STAGE(bufoff, gbase, voff) do { _Pragma("unroll") for (int _i = 0; _i < 2; ++_i) \
        __builtin_amdgcn_global_load_lds((const unsigned*)((const char*)(gbase) + (voff)[_i]), (PG8_LAS unsigned*)(lds + (bufoff) + ldsw + _i * 8192), 16, 0, 0); } while (0)
#define PG8_LDA(dst, b, h) do { _Pragma("unroll") for (int m = 0; m < 4; ++m) _Pragma("unroll") for (int k = 0; k < 2; ++k) dst[m][k] = *(const PG8_LAS bf16x8*)(lds + PG8_SA(b, h) + aoff + m * 2048 + k * 1024); } while (0)
#define PG8_LDB(dst, b, h) do { _Pragma("unroll") for (int n = 0; n < 2; ++n) _Pragma("unroll") for (int k = 0; k < 2; ++k) dst[n][k] = *(const PG8_LAS bf16x8*)(lds + PG8_SB(b, h) + boff + n * 2048 + k * 1024); } while (0)
#define PG8_MMA(ai, bj, At, Bt) do { __builtin_amdgcn_s_setprio(1); _Pragma("unroll") for (int m = 0; m < 4; ++m) _Pragma("unroll") for (int n = 0; n < 2; ++n) _Pragma("unroll") for (int k = 0; k < 2; ++k) \
        acc[ai][bj][m][n] = __builtin_amdgcn_mfma_f32_16x16x32_bf16(Bt[n][k], At[m][k], acc[ai][bj][m][n], 0, 0, 0); __builtin_amdgcn_s_setprio(0); } while (0)
#define PG8_WAIT_V(n) asm volatile("s_waitcnt vmcnt(" #n ")" ::: "memory")
#define PG8_WAIT_L(n) asm volatile("s_waitcnt lgkmcnt(" #n ")" ::: "memory")
#define PG8_BAR __builtin_amdgcn_s_barrier()
#define PG8_SCHED __builtin_amdgcn_sched_barrier(0)
    Unit cur, nxt; int ui = 0;
    if (!S.next(0, cur)) return;
    f32x4 acc[2][2][4][2];
#pragma unroll
    for (int a = 0; a < 2; ++a)
#pragma unroll
        for (int b = 0; b < 2; ++b)
#pragma unroll
            for (int m = 0; m < 4; ++m)
#pragma unroll
                for (int n = 0; n < 2; ++n) acc[a][b][m][n] = (f32x4){0.f, 0.f, 0.f, 0.f};
    bf16x8 At[4][2], B0[2][2], B1[2][2];
    const char* cA = cur.a; const char* cB = cur.b;
    if constexpr (SP2) {
        PG8_STAGE(PG8_SB(0, 0), cB, voffB); PG8_STAGE(PG8_SB(0, 1), cB + hstep, voffB); PG8_STAGE(PG8_SA(0, 0), cA, voffA); PG8_STAGE(PG8_SA(0, 1), cA + hstep, voffA);
        if (wr == 1) PG8_BAR;
        PG8_WAIT_V(2); PG8_BAR;
        PG8_STAGE(PG8_SB(1, 0), cB + kstep, voffB); PG8_STAGE(PG8_SA(1, 0), cA + kstep, voffA); PG8_STAGE(PG8_SB(1, 1), cB + hstep + kstep, voffB);
        PG8_WAIT_V(6); PG8_BAR;
    } else {
        PG8_STAGE(PG8_SB(0, 0), cB, voffB); PG8_STAGE(PG8_SA(0, 0), cA, voffA); PG8_STAGE(PG8_SB(0, 1), cB + hstep, voffB); PG8_STAGE(PG8_SA(0, 1), cA + hstep, voffA);
        if (wr == 1) PG8_BAR;
        PG8_WAIT_V(4); PG8_BAR;
        PG8_STAGE(PG8_SB(1, 0), cB + kstep, voffB); PG8_STAGE(PG8_SA(1, 0), cA + kstep, voffA); PG8_STAGE(PG8_SB(1, 1), cB + hstep + kstep, voffB);
        PG8_WAIT_V(6); PG8_BAR;
    }
    for (;;) {
        const bool has_next = S.next(ui + 1, nxt);
        const char* nA = has_next ? nxt.a : cA; const char* nB = has_next ? nxt.b : cB;
        for (int t = 0; t < nt; t += 2) {
            const bool last = (t == nt - 2);
            const char* a1 = cA + (size_t)(t + 1) * kstep;
            const char* a2 = last ? nA : cA + (size_t)(t + 2) * kstep; const char* b2 = last ? nB : cB + (size_t)(t + 2) * kstep;
            const char* a3 = a2 + kstep; const char* b3 = b2 + kstep;
            if constexpr (SP2) {
            PG8_LDB(B0, 0, 0); PG8_LDB(B1, 0, 1); PG8_SCHED; PG8_LDA(At, 0, 0); PG8_STAGE(PG8_SA(1, 1), a1 + hstep, voffA);
            PG8_WAIT_V(8); PG8_WAIT_L(0); PG8_BAR; PG8_MMA(0, 0, At, B0); PG8_MMA(0, 1, At, B1); PG8_BAR; PG8_SCHED;
            PG8_LDA(At, 0, 1); PG8_STAGE(PG8_SB(0, 0), b2, voffB); PG8_STAGE(PG8_SB(0, 1), b2 + hstep, voffB); PG8_STAGE(PG8_SA(0, 0), a2, voffA);
            PG8_WAIT_V(8); PG8_WAIT_L(0); PG8_BAR; PG8_MMA(1, 0, At, B0); PG8_MMA(1, 1, At, B1); PG8_BAR; PG8_SCHED;
            PG8_LDB(B0, 1, 0); PG8_LDB(B1, 1, 1); PG8_SCHED; PG8_LDA(At, 1, 0); PG8_STAGE(PG8_SA(0, 1), a2 + hstep, voffA);
            PG8_WAIT_V(8); PG8_WAIT_L(0); PG8_BAR; PG8_MMA(0, 0, At, B0); PG8_MMA(0, 1, At, B1); PG8_BAR; PG8_SCHED;
            PG8_LDA(At, 1, 1); PG8_STAGE(PG8_SB(1, 0), b3, voffB); PG8_STAGE(PG8_SB(1, 1), b3 + hstep, voffB); PG8_STAGE(PG8_SA(1, 0), a3, voffA);
            PG8_WAIT_V(8); PG8_WAIT_L(0); PG8_BAR; PG8_MMA(1, 0, At, B0); PG8_MMA(1, 1, At, B1); PG8_BAR; PG8_SCHED;
            } else {
            PG8_LDB(B0, 0, 0); PG8_SCHED; PG8_LDA(At, 0, 0); PG8_STAGE(PG8_SA(1, 1), a1 + hstep, voffA);
            PG8_WAIT_L(8); PG8_BAR; PG8_WAIT_L(0); PG8_MMA(0, 0, At, B0); PG8_BAR; PG8_SCHED;
            PG8_LDB(B1, 0, 1); PG8_STAGE(PG8_SB(0, 0), b2, voffB);
            PG8_BAR; PG8_WAIT_L(0); PG8_MMA(0, 1, At, B1); PG8_BAR;
            PG8_LDA(At, 0, 1); PG8_STAGE(PG8_SA(0, 0), a2, voffA);
            PG8_BAR; PG8_WAIT_L(0); PG8_MMA(1, 0, At, B0); PG8_BAR; PG8_SCHED;
            PG8_STAGE(PG8_SB(0, 1), b2 + hstep, voffB);
            PG8_WAIT_V(6); PG8_BAR; PG8_MMA(1, 1, At, B1); PG8_BAR;
            PG8_LDB(B0, 1, 0); PG8_SCHED; PG8_LDA(At, 1, 0); PG8_STAGE(PG8_SA(0, 1), a2 + hstep, voffA);
            PG8_WAIT_L(8); PG8_BAR; PG8_WAIT_L(0); PG8_MMA(0, 0, At, B0); PG8_BAR; PG8_SCHED;
            PG8_LDB(B1, 1, 1); PG8_STAGE(PG8_SB(1, 0), b3, voffB);
            PG8_BAR; PG8_WAIT_L(0); PG8_MMA(0, 1, At, B1); PG8_BAR;
            PG8_LDA(At, 1, 1); PG8_STAGE(PG8_SA(1, 0), a3, voffA);
            PG8_BAR; PG8_WAIT_L(0); PG8_MMA(1, 0, At, B0); PG8_BAR; PG8_SCHED;
            PG8_STAGE(PG8_SB(1, 1), b3 + hstep, voffB);
            PG8_WAIT_V(6); PG8_BAR; PG8_MMA(1, 1, At, B1); PG8_BAR;
            }
        }
        if constexpr (ALIGN_EPI) { if (wr == 0) PG8_BAR; }
        E(acc, cur, wr, wc, fr, fq);
        if (!has_next) break;
#pragma unroll
        for (int a = 0; a < 2; ++a)
#pragma unroll
            for (int b = 0; b < 2; ++b)
#pragma unroll
                for (int m = 0; m < 4; ++m)
#pragma unroll
                    for (int n = 0; n < 2; ++n) acc[a][b][m][n] = (f32x4){0.f, 0.f, 0.f, 0.f};
        cur = nxt; cA = nA; cB = nB; ++ui;
        if constexpr (ALIGN_EPI) { if (wr == 1) PG8_BAR; }
    }
    PG8_WAIT_V(0);
    if constexpr (!ALIGN_EPI) { if (wr == 0) PG8_BAR; }
    PG8_BAR;
#undef PG8_SA
#undef PG8_SB
#undef PG8_STAGE
#undef PG8_LDA
#undef PG8_LDB
#undef PG8_MMA
#undef PG8_WAIT_V
#undef PG8_WAIT_L
#undef PG8_BAR
#undef PG8_SCHED
}
}
constexpr int T_TOK = 16384, DM = 2048, SEQ = 2048, NBATCH = 8, MEML = 256, MT = NBATCH * MEML, IN_COLS = 5376;
constexpr float EPS = 1e-6f, GN_EPS = 1e-5f, LOG2E = 1.4426950408889634f;
constexpr float C2Q = 0.125f * LOG2E;
constexpr float C3Q = 0.08838834764831845f * LOG2E;
constexpr size_t MiB = 1u << 20;
constexpr size_t WS_CTL = 0, CTL_ZERO_BYTES = 64 * 1024;
constexpr size_t WS_WIN = 2 * MiB, WS_WOUT = 23 * MiB, WS_WXQ = 31 * MiB, WS_WXKV = 33 * MiB, WS_WXO = 37 * MiB, WS_WPQ = 39 * MiB;
constexpr size_t WS_XB = 48 * MiB, WS_MEMB = 112 * MiB;
constexpr size_t WS_COSA = 120 * MiB, WS_SINA = 122 * MiB, WS_COSR = 124 * MiB, WS_SINR = 132 * MiB;
constexpr size_t WS_SS0 = 140 * MiB, WS_SS1 = WS_SS0 + 65536, WS_SS2 = WS_SS1 + 65536, WS_SSM = WS_SS2 + 65536;
constexpr size_t WS_KX = 141 * MiB, WS_VX = 143 * MiB, WS_QX = 145 * MiB, WS_OX = 161 * MiB, WS_EXP = 177 * MiB, WS_GATE = 185 * MiB;
constexpr size_t WS_Y = 193 * MiB;
constexpr size_t WS_QA = 257 * MiB, WS_KA = 289 * MiB, WS_VA = 293 * MiB, WS_QR = 297 * MiB, WS_KR = 329 * MiB, WS_VR = 361 * MiB, WS_GR = 393 * MiB;
constexpr size_t WS_UB = 425 * MiB, WS_VB = 457 * MiB, WS_SU = 489 * MiB, WS_SV = WS_SU + 65536;
constexpr size_t WS_END = 490 * MiB;

#define GAS __attribute__((address_space(1)))
#define LAS __attribute__((address_space(3)))
typedef unsigned short bf16_t;
typedef short bf16x8 __attribute__((ext_vector_type(8)));
typedef short v4i16 __attribute__((ext_vector_type(4)));
typedef float f32x4 __attribute__((ext_vector_type(4)));
typedef float f32x2 __attribute__((ext_vector_type(2)));
typedef unsigned u32x4 __attribute__((ext_vector_type(4)));
typedef unsigned u32x2 __attribute__((ext_vector_type(2)));
typedef __bf16 bf16x2_t __attribute__((ext_vector_type(2)));

__device__ __forceinline__ unsigned pk2(float lo, float hi) { f32x2 v = {lo, hi}; bf16x2_t b = __builtin_convertvector(v, bf16x2_t); return __builtin_bit_cast(unsigned, b); }
__device__ __forceinline__ float bf_lo(unsigned w) { return __uint_as_float(w << 16); }
__device__ __forceinline__ float bf_hi(unsigned w) { return __uint_as_float(w & 0xffff0000u); }
__device__ __forceinline__ float wave_sum(float v) {
#pragma unroll
    for (int o = 1; o < 64; o <<= 1) v += __shfl_xor(v, o);
    return v;
}

struct EpiP1 {
    static constexpr bool PERM = true;
    unsigned char* ws;
    __device__ __forceinline__ void operator()(const pg8::f32x4 (&acc)[2][2][4][2], const pg8::Unit& u, int wr, int wc, int fr, int fq) const {
        if (u.kind == 1) {
            const float* ssm = (const float*)(ws + WS_SSM);
            bf16_t* O = (bf16_t*)(ws + ((u.pn < 2) ? WS_KX : WS_VX)); const int cb = (u.pn & 1) * 256 + wc * 32 + 8 * fq;
#pragma unroll
            for (int ai = 0; ai < 2; ++ai)
#pragma unroll
                for (int m = 0; m < 4; ++m) { const int row = u.pm * 256 + ai * 128 + wr * 64 + m * 16 + fr; const float rs = rsqrtf(ssm[row] * (1.f / DM) + EPS);
#pragma unroll
                    for (int bj = 0; bj < 2; ++bj) { const f32x4 v0 = acc[ai][bj][m][0] * rs, v1 = acc[ai][bj][m][1] * rs;
                        u32x4 w; w.x = pk2(v0[0], v0[1]); w.y = pk2(v0[2], v0[3]); w.z = pk2(v1[0], v1[1]); w.w = pk2(v1[2], v1[3]);
                        *(u32x4*)(O + (size_t)row * 512 + cb + bj * 128) = w; } }
            return;
        }
        const float* ss0 = (const float*)(ws + WS_SS0);
        const int pn = u.pn;
        size_t ooff, ctoff, stoff; int pitch, colbase, i0, half, tw; float sc; bool rope;
        if (pn < 4)        { ooff = WS_QA; pitch = 1024; colbase = (4 * pn + wc) * 64; i0 = 8 * fq; half = 32; tw = 32; ctoff = WS_COSA; stoff = WS_SINA; sc = C2Q; rope = true; }
        else if (pn == 4)  { if (wc < 2) { ooff = WS_KA; colbase = wc * 64; rope = true; } else { ooff = WS_VA; colbase = (wc - 2) * 64; rope = false; }
                             pitch = 128; i0 = 8 * fq; half = 32; tw = 32; ctoff = WS_COSA; stoff = WS_SINA; sc = 1.f; }
        else { const int q = (pn - 5) >> 2, h = (pn - 5) & 3; ooff = WS_QR + (size_t)q * (32 * MiB); pitch = 1024; colbase = h * 256; i0 = 32 * wc + 8 * fq; half = 128; tw = 128; ctoff = WS_COSR; stoff = WS_SINR;
               sc = (q == 1) ? 0.0625f : 1.f; rope = (q < 2); }
        bf16_t* O = (bf16_t*)(ws + ooff); const float* ct = (const float*)(ws + ctoff); const float* st = (const float*)(ws + stoff);
#pragma unroll
        for (int ai = 0; ai < 2; ++ai)
#pragma unroll
            for (int m = 0; m < 4; ++m) { const int row = u.pm * 256 + ai * 128 + wr * 64 + m * 16 + fr; const float rs = rsqrtf(ss0[row] * (1.f / DM) + EPS) * sc;
                f32x4 a0 = acc[ai][0][m][0] * rs, a1 = acc[ai][0][m][1] * rs, b0 = acc[ai][1][m][0] * rs, b1 = acc[ai][1][m][1] * rs;
                if (rope) { const f32x4 c0 = *(const f32x4*)(ct + (size_t)row * tw + i0), c1 = *(const f32x4*)(ct + (size_t)row * tw + i0 + 4);
                            const f32x4 s0 = *(const f32x4*)(st + (size_t)row * tw + i0), s1 = *(const f32x4*)(st + (size_t)row * tw + i0 + 4);
                            const f32x4 o0 = a0 * c0 - b0 * s0, o1 = a1 * c1 - b1 * s1, p0 = b0 * c0 + a0 * s0, p1 = b1 * c1 + a1 * s1; a0 = o0; a1 = o1; b0 = p0; b1 = p1; }
                bf16_t* rp = O + (size_t)row * pitch + colbase + i0;
                u32x4 w; w.x = pk2(a0[0], a0[1]); w.y = pk2(a0[2], a0[3]); w.z = pk2(a1[0], a1[1]); w.w = pk2(a1[2], a1[3]); *(u32x4*)rp = w;
                w.x = pk2(b0[0], b0[1]); w.y = pk2(b0[2], b0[3]); w.z = pk2(b1[0], b1[1]); w.w = pk2(b1[2], b1[3]); *(u32x4*)(rp + half) = w; }
    }
};
struct EpiRes1 {
    static constexpr bool PERM = true;
    bf16_t* XB; float* ss;
    __device__ __forceinline__ void operator()(const pg8::f32x4 (&acc)[2][2][4][2], const pg8::Unit& u, int wr, int wc, int fr, int fq) const {
        const int col0 = u.pn * 256 + wc * 32 + 8 * fq;
#pragma unroll
        for (int ai = 0; ai < 2; ++ai) {
            u32x4 r[4][2];
#pragma unroll
            for (int m = 0; m < 4; ++m) { const size_t off = (size_t)(u.pm * 256 + ai * 128 + wr * 64 + m * 16 + fr) * DM + col0;
#pragma unroll
                for (int bj = 0; bj < 2; ++bj) r[m][bj] = *(const u32x4*)(XB + off + bj * 128); }
#pragma unroll
            for (int m = 0; m < 4; ++m) { const int row = u.pm * 256 + ai * 128 + wr * 64 + m * 16 + fr; const size_t off = (size_t)row * DM + col0; float s = 0.f;
#pragma unroll
                for (int bj = 0; bj < 2; ++bj) { const size_t o = off + bj * 128;
                    const u32x4 q = r[m][bj];
                    const f32x4 v0 = (f32x4){bf_lo(q.x), bf_hi(q.x), bf_lo(q.y), bf_hi(q.y)} + acc[ai][bj][m][0], v1 = (f32x4){bf_lo(q.z), bf_hi(q.z), bf_lo(q.w), bf_hi(q.w)} + acc[ai][bj][m][1];
                    u32x4 w; w.x = pk2(v0[0], v0[1]); w.y = pk2(v0[2], v0[3]); w.z = pk2(v1[0], v1[1]); w.w = pk2(v1[2], v1[3]); *(u32x4*)(XB + o) = w;
                    s += ((v0[0] * v0[0] + v0[1] * v0[1]) + (v0[2] * v0[2] + v0[3] * v0[3])) + ((v1[0] * v1[0] + v1[1] * v1[1]) + (v1[2] * v1[2] + v1[3] * v1[3])); }
                s += __shfl_xor(s, 16); s += __shfl_xor(s, 32);
                if (fq == 0) atomicAdd(ss + row, s); }
            asm volatile("" ::: "memory");
        }
    }
};
struct EpiRes2 {
    static constexpr bool PERM = true;
    bf16_t* XB; float* ss;
    __device__ __forceinline__ void operator()(const pg8::f32x4 (&acc)[2][2][4][2], const pg8::Unit& u, int wr, int wc, int fr, int fq) const {
        const int col0 = u.pn * 256 + wc * 32 + 8 * fq;
        u32x4 r[2][4][2];
#pragma unroll
        for (int ai = 0; ai < 2; ++ai)
#pragma unroll
            for (int m = 0; m < 4; ++m) { const size_t off = (size_t)(u.pm * 256 + ai * 128 + wr * 64 + m * 16 + fr) * DM + col0;
#pragma unroll
                for (int bj = 0; bj < 2; ++bj) r[ai][m][bj] = *(const u32x4*)(XB + off + bj * 128); }
#pragma unroll
        for (int ai = 0; ai < 2; ++ai)
#pragma unroll
            for (int m = 0; m < 4; ++m) { const int row = u.pm * 256 + ai * 128 + wr * 64 + m * 16 + fr; const size_t off = (size_t)row * DM + col0; float s = 0.f;
#pragma unroll
                for (int bj = 0; bj < 2; ++bj) { const size_t o = off + bj * 128; const u32x4 q = r[ai][m][bj];
                    const f32x4 v0 = (f32x4){bf_lo(q.x), bf_hi(q.x), bf_lo(q.y), bf_hi(q.y)} + acc[ai][bj][m][0], v1 = (f32x4){bf_lo(q.z), bf_hi(q.z), bf_lo(q.w), bf_hi(q.w)} + acc[ai][bj][m][1];
                    u32x4 w; w.x = pk2(v0[0], v0[1]); w.y = pk2(v0[2], v0[3]); w.z = pk2(v1[0], v1[1]); w.w = pk2(v1[2], v1[3]); *(u32x4*)(XB + o) = w;
                    s += ((v0[0] * v0[0] + v0[1] * v0[1]) + (v0[2] * v0[2] + v0[3] * v0[3])) + ((v1[0] * v1[0] + v1[1] * v1[1]) + (v1[2] * v1[2] + v1[3] * v1[3])); }
                s += __shfl_xor(s, 16); s += __shfl_xor(s, 32);
                if (fq == 0) atomicAdd(ss + row, s); }
    }
};
struct EpiScale {
    static constexpr bool PERM = true;
    bf16_t* O; int ldc; const float* ss; float scale;
    __device__ __forceinline__ void operator()(const pg8::f32x4 (&acc)[2][2][4][2], const pg8::Unit& u, int wr, int wc, int fr, int fq) const {
        const int col0 = u.pn * 256 + wc * 32 + 8 * fq;
#pragma unroll
        for (int ai = 0; ai < 2; ++ai)
#pragma unroll
            for (int m = 0; m < 4; ++m) { const int row = u.pm * 256 + ai * 128 + wr * 64 + m * 16 + fr; const float rs = rsqrtf(ss[row] * (1.f / DM) + EPS) * scale;
#pragma unroll
                for (int bj = 0; bj < 2; ++bj) { const f32x4 v0 = acc[ai][bj][m][0] * rs, v1 = acc[ai][bj][m][1] * rs;
                    u32x4 w; w.x = pk2(v0[0], v0[1]); w.y = pk2(v0[2], v0[3]); w.z = pk2(v1[0], v1[1]); w.w = pk2(v1[2], v1[3]);
                    *(u32x4*)(O + (size_t)row * ldc + col0 + bj * 128) = w; } }
    }
};
#define XB_TMO      128
#define XB_XCNT(j)  (256  + 64 * (j))
#define XB_XSUB(j)  (1280 + 64 * (j))
#define XB_XGEN(j)  (2304 + 64 * (j))
#define XB_TOP      3328
#define XB_TOPGEN   3392
#define XCD_BAR_WORDS 3456
#define XB_SPIN_CAP (1u << 18)
__device__ __forceinline__ unsigned xb_ld(unsigned* p)              { return __hip_atomic_load(p, __ATOMIC_RELAXED, __HIP_MEMORY_SCOPE_AGENT); }
__device__ __forceinline__ unsigned xb_add(unsigned* p, unsigned v) { return __hip_atomic_fetch_add(p, v, __ATOMIC_RELAXED, __HIP_MEMORY_SCOPE_AGENT); }
__device__ __forceinline__ unsigned xb_xcc_id() { return (unsigned)__builtin_amdgcn_s_getreg((3 << 11) | 20) & 0xFu; }
#define XB_SPIN(cond, bar) do { unsigned _sp = 0; while (cond) { __builtin_amdgcn_s_sleep(1); \
    if ((++_sp & 255u) == 0u) { if (xb_ld(&(bar)[XB_TMO])) break; if (_sp > XB_SPIN_CAP) { atomicAdd(&(bar)[XB_TMO], 1u); break; } } } } while (0)
struct XcdBarrier { unsigned* bar; unsigned x; volatile LAS unsigned* st; };
__device__ __forceinline__ XcdBarrier xcd_barrier_post(unsigned* bar, volatile LAS unsigned* st) {
    XcdBarrier b; b.bar = bar; b.x = xb_xcc_id(); b.st = st;
    if (threadIdx.x == 0) (void)xb_add(&bar[XB_XCNT(b.x)], 1u);
    return b;
}
__device__ __forceinline__ void xcd_barrier_complete(unsigned* bar, unsigned x, unsigned& nloc, unsigned& nx) {
    const unsigned G = gridDim.x * gridDim.y * gridDim.z;
    unsigned sum, cnt, mine, sp = 0u;
    for (;;) {
        sum = 0u; cnt = 0u; mine = 0u;
#pragma unroll
        for (unsigned j = 0; j < 16; ++j) { const unsigned c = xb_ld(&bar[XB_XCNT(j)]); sum += c; cnt += (c > 0u) ? 1u : 0u; mine = (j == x) ? c : mine; }
        if (sum == G) break;
        __builtin_amdgcn_s_sleep(1);
        if ((++sp & 255u) == 0u) { if (xb_ld(&bar[XB_TMO])) break; if (sp > XB_SPIN_CAP) { atomicAdd(&bar[XB_TMO], 1u); break; } }
    }
    nloc = mine > 0u ? mine : 1u; nx = cnt > 0u ? cnt : 1u;
}
__device__ __forceinline__ void xcd_barrier(const XcdBarrier& b) {
    asm volatile("s_waitcnt vmcnt(0)" ::: "memory");
    __syncthreads();
    if (threadIdx.x == 0) {
        unsigned* bar = b.bar;
        __builtin_amdgcn_s_waitcnt(0);
        unsigned nloc = b.st[0], nx = b.st[1];
        if (nloc == 0u) { xcd_barrier_complete(bar, b.x, nloc, nx); b.st[0] = nloc; b.st[1] = nx; }
        const unsigned old = xb_add(&bar[XB_XSUB(b.x)], 1u);
        const unsigned gen = old / nloc;
        if (old + 1u == (gen + 1u) * nloc) {
            __builtin_amdgcn_fence(__ATOMIC_RELEASE, "agent");
            asm volatile("s_waitcnt vmcnt(0)" ::: "memory");
            const unsigned og = xb_add(&bar[XB_TOP], 1u);
            const unsigned tg = og / nx;
            if (og + 1u == (tg + 1u) * nx) xb_add(&bar[XB_TOPGEN], 1u);
            else XB_SPIN(xb_ld(&bar[XB_TOPGEN]) == tg, bar);
            __builtin_amdgcn_fence(__ATOMIC_ACQUIRE, "agent");
            xb_add(&bar[XB_XGEN(b.x)], 1u);
            asm volatile("s_waitcnt vmcnt(0)" ::: "memory");
        } else {
            XB_SPIN(xb_ld(&bar[XB_XGEN(b.x)]) == gen, bar);
            __builtin_amdgcn_fence(__ATOMIC_ACQUIRE, "agent");
            asm volatile("s_waitcnt vmcnt(0)" ::: "memory");
        }
    }
    __syncthreads();
}

__device__ __forceinline__ int win_phys(int n) {
    if (n < 1024) { const int head = n >> 6, d = n & 63; return (head >> 2) * 256 + (d >> 5) * 128 + (head & 3) * 32 + (d & 31); }
    if (n < 1280) { const int m = n - 1024, kind = m >> 7, hh = (m & 127) >> 6, d = m & 63; return 1024 + (d >> 5) * 128 + (kind * 2 + hh) * 32 + (d & 31); }
    return n;
}
template <bool PERMW>
__device__ __forceinline__ void p0_transpose_item(const float* W, const float* gk, int K, int N, bf16_t* WT, int row_off, LAS float* scr, int item, int lane) {
    const int nblk = N / 32, kb = item / nblk, nb = item % nblk, k0 = 64 * kb, n0 = 32 * nb;
    float wv[32];
#pragma unroll
    for (int i = 0; i < 32; ++i) { const int kk = 2 * i + (lane >> 5); wv[i] = W[(size_t)(k0 + kk) * N + n0 + (lane & 31)]; }
#pragma unroll
    for (int i = 0; i < 32; ++i) { const int kk = 2 * i + (lane >> 5); const float g = gk ? gk[k0 + kk] : 1.f; scr[kk * 33 + (lane & 31)] = wv[i] * g; }
    asm volatile("s_waitcnt lgkmcnt(0)" ::: "memory");
    const int c = lane & 7; const int pr0 = PERMW ? win_phys(n0) : n0;
#pragma unroll
    for (int j = 0; j < 4; ++j) { const int n = (lane >> 3) + 8 * j; const LAS float* s = scr + (8 * c) * 33 + n;
        u32x4 o; o.x = pk2(s[0 * 33], s[1 * 33]); o.y = pk2(s[2 * 33], s[3 * 33]); o.z = pk2(s[4 * 33], s[5 * 33]); o.w = pk2(s[6 * 33], s[7 * 33]);
        *(u32x4*)(WT + (size_t)(row_off + pr0 + n) * K + k0 + 8 * c) = o; }
    asm volatile("s_waitcnt lgkmcnt(0)" ::: "memory");
}
__device__ __forceinline__ void row_to_bf16(const float* xrow, bf16_t* orow, float* ssq, int lane) {
    const f32x4* xr = (const f32x4*)xrow + lane; f32x4 v[8]; float s = 0.f;
#pragma unroll
    for (int j = 0; j < 8; ++j) { v[j] = xr[64 * j]; s += (v[j][0] * v[j][0] + v[j][1] * v[j][1]) + (v[j][2] * v[j][2] + v[j][3] * v[j][3]); }
    s = wave_sum(s);
    u32x2* o8 = (u32x2*)orow + lane;
#pragma unroll
    for (int j = 0; j < 8; ++j) { u32x2 w; w.x = pk2(v[j][0], v[j][1]); w.y = pk2(v[j][2], v[j][3]); o8[64 * j] = w; }
    if (lane == 0) *ssq = s;
}
__device__ __forceinline__ void row2_to_bf16(const float* xrow, bf16_t* orow, float* ssq, size_t rstep, int lane) {
    const f32x4* xr0 = (const f32x4*)xrow + lane; const f32x4* xr1 = (const f32x4*)(xrow + rstep * DM) + lane; f32x4 v[8], q[8]; float s0 = 0.f, s1 = 0.f;
#pragma unroll
    for (int j = 0; j < 8; ++j) { v[j] = xr0[64 * j]; q[j] = xr1[64 * j]; }
#pragma unroll
    for (int j = 0; j < 8; ++j) { s0 += (v[j][0] * v[j][0] + v[j][1] * v[j][1]) + (v[j][2] * v[j][2] + v[j][3] * v[j][3]); s1 += (q[j][0] * q[j][0] + q[j][1] * q[j][1]) + (q[j][2] * q[j][2] + q[j][3] * q[j][3]); }
    s0 = wave_sum(s0); s1 = wave_sum(s1);
    u32x2* o0 = (u32x2*)orow + lane; u32x2* o1 = (u32x2*)(orow + rstep * DM) + lane;
#pragma unroll
    for (int j = 0; j < 8; ++j) { u32x2 w; w.x = pk2(v[j][0], v[j][1]); w.y = pk2(v[j][2], v[j][3]); o0[64 * j] = w; w.x = pk2(q[j][0], q[j][1]); w.y = pk2(q[j][2], q[j][3]); o1[64 * j] = w; }
    if (lane == 0) { ssq[0] = s0; ssq[rstep] = s1; }
}
__device__ __forceinline__ void sincos_red(float ang, float& c, float& s) {
    const float k = rintf(ang * 0.15915494309189535f);
    float r = fmaf(-k, 6.28125f, ang); r = fmaf(-k, 1.9353071795864769e-3f, r);
    const float rev = r * 0.15915494309189535f;
    s = __builtin_amdgcn_sinf(rev); c = __builtin_amdgcn_cosf(rev);
}

#define MFMA16(a, b, c) __builtin_amdgcn_mfma_f32_16x16x32_bf16((a), (b), (c), 0, 0, 0)
__device__ __forceinline__ bf16x8 pack_p(const f32x4& lo, const f32x4& hi) {
    u32x4 w; w.x = pk2(lo[0], lo[1]); w.y = pk2(lo[2], lo[3]); w.z = pk2(hi[0], hi[1]); w.w = pk2(hi[2], hi[3]); return __builtin_bit_cast(bf16x8, w);
}
__device__ __forceinline__ bf16x8 vt_frag(LAS const unsigned char* p, int stride16) {
    const v4i16 lo = __builtin_amdgcn_ds_read_tr16_b64_v4i16((LAS v4i16*)p);
    const v4i16 hi = __builtin_amdgcn_ds_read_tr16_b64_v4i16((LAS v4i16*)(p + stride16));
    return (bf16x8){lo[0], lo[1], lo[2], lo[3], hi[0], hi[1], hi[2], hi[3]};
}

__device__ __forceinline__ void swa_unit(LAS unsigned char* lds, int b, int n, int kvh, const bf16_t* QA, const bf16_t* KA, const bf16_t* VA,
                                         const float* sinks, const float* att_gain, bf16_t* Y) {
    constexpr int KS = 144;
    const int tid = threadIdx.x, lane = tid & 63, c = lane & 15, g = lane >> 4; const int w = __builtin_amdgcn_readfirstlane(tid >> 6);
    LAS unsigned char* Kl = lds; LAS unsigned char* Vl = lds + 256 * KS;
    for (int i = tid; i < 2048; i += 512) { const int key = i >> 3, ch = i & 7, pos = 128 * (n - 1) + key; u32x4 kv = {0u, 0u, 0u, 0u}, vv = {0u, 0u, 0u, 0u};
        if (pos >= 0) { const size_t off = (size_t)(b * SEQ + pos) * 128 + kvh * 64 + ch * 8; kv = *(const u32x4*)(KA + off); vv = *(const u32x4*)(VA + off); }
        *(LAS u32x4*)(Kl + key * KS + ch * 16) = kv; *(LAS u32x4*)(Vl + key * KS + ch * 16) = vv; }
    __syncthreads();
    const int hq = kvh * 8 + w; const float sink = sinks[hq] * LOG2E;
    bf16x8 qn[2];
#pragma unroll
    for (int ks = 0; ks < 2; ++ks) qn[ks] = *(const bf16x8*)(QA + (size_t)(b * SEQ + 128 * n + c) * 1024 + hq * 64 + ks * 32 + 8 * g);
    for (int a = 0; a < 8; ++a) {
        const int t = b * SEQ + 128 * n + 16 * a + c; const int kb0 = (a & ~1) * 16; const int qi = 128 + 16 * a + c;
        bf16x8 qf[2];
#pragma unroll
        for (int ks = 0; ks < 2; ++ks) { qf[ks] = qn[ks]; qn[ks] = *(const bf16x8*)(QA + (size_t)(t + (a < 7 ? 16 : 0)) * 1024 + hq * 64 + ks * 32 + 8 * g); }
        f32x4 s[10]; float m = sink;
#pragma unroll
        for (int blk = 0; blk < 10; ++blk) { const int key0 = kb0 + 16 * blk; f32x4 acc = {0.f, 0.f, 0.f, 0.f};
#pragma unroll
            for (int ks = 0; ks < 2; ++ks) { const bf16x8 kf = *(LAS const bf16x8*)(Kl + (key0 + c) * KS + (ks * 32 + 8 * g) * 2); acc = MFMA16(kf, qf[ks], acc); }
#pragma unroll
            for (int r = 0; r < 4; ++r) { const int j = key0 + 4 * g + r; const bool ok = (j <= qi) && (j > qi - 128) && (n > 0 || j >= 128);
                acc[r] = ok ? acc[r] : -INFINITY; m = fmaxf(m, acc[r]); }
            s[blk] = acc; }
        m = fmaxf(m, __shfl_xor(m, 16)); m = fmaxf(m, __shfl_xor(m, 32));
        float l = 0.f;
#pragma unroll
        for (int blk = 0; blk < 10; ++blk)
#pragma unroll
            for (int r = 0; r < 4; ++r) { const float p = __builtin_amdgcn_exp2f(s[blk][r] - m); s[blk][r] = p; l += p; }
        l += __shfl_xor(l, 16); l += __shfl_xor(l, 32); l += __builtin_amdgcn_exp2f(sink - m);
        f32x4 o[4];
#pragma unroll
        for (int db = 0; db < 4; ++db) o[db] = (f32x4){0.f, 0.f, 0.f, 0.f};
#pragma unroll
        for (int kp = 0; kp < 5; ++kp) { const bf16x8 pf = pack_p(s[2 * kp], s[2 * kp + 1]); const int key0 = kb0 + 32 * kp;
#pragma unroll
            for (int db = 0; db < 4; ++db) { const bf16x8 af = vt_frag(Vl + (key0 + 4 * g + (c >> 2)) * KS + (16 * db + 4 * (c & 3)) * 2, 16 * KS); o[db] = MFMA16(af, pf, o[db]); } }
        const float inv = 1.f / l; float q2 = 0.f;
#pragma unroll
        for (int db = 0; db < 4; ++db) { o[db] = o[db] * inv; q2 += (o[db][0] * o[db][0] + o[db][1] * o[db][1]) + (o[db][2] * o[db][2] + o[db][3] * o[db][3]); }
        q2 += __shfl_xor(q2, 16); q2 += __shfl_xor(q2, 32);
        const float rms = rsqrtf(q2 * (1.f / 64.f) + EPS);
#pragma unroll
        for (int db = 0; db < 4; ++db) { const int col = hq * 64 + 16 * db + 4 * g; const f32x4 gn = *(const f32x4*)(att_gain + col); const f32x4 v = o[db] * rms * gn;
            u32x2 wv; wv.x = pk2(v[0], v[1]); wv.y = pk2(v[2], v[3]); *(u32x2*)(Y + (size_t)t * DM + col) = wv; }
    }
    __syncthreads();
}

__device__ __forceinline__ void ret_unit(LAS unsigned char* lds, int b, int h, int qb, const bf16_t* QR, const bf16_t* KR, const bf16_t* VR, const bf16_t* GR,
                                         const float* ret_gain, bf16_t* Y) {
    constexpr int RS = 544, TB = 64 * RS;
    const int tid = threadIdx.x, lane = tid & 63, c = lane & 15, g = lane >> 4; const int w = __builtin_amdgcn_readfirstlane(tid >> 6);
    const int nt = 2 * qb + 2; const size_t rowb = (size_t)b * SEQ; const int hoff = h * 256;
    const int qpos = 128 * qb + 16 * w + c; const size_t t = rowb + qpos;
    const float lg = log2f(1.f - exp2f(-5.f - (float)h));
    bf16x8 qf[8];
#pragma unroll
    for (int ks = 0; ks < 8; ++ks) qf[ks] = *(const bf16x8*)(QR + t * 1024 + hoff + ks * 32 + 8 * g);
    f32x4 o[16];
#pragma unroll
    for (int db = 0; db < 16; ++db) o[db] = (f32x4){0.f, 0.f, 0.f, 0.f};
    u32x4 pk[4], pv[4];
#define RET_LOAD(kt) do { _Pragma("unroll") for (int i = 0; i < 4; ++i) { const int id = tid + 512 * i, key = id >> 5, ch = id & 31; const size_t off = (rowb + 64 * (kt) + key) * 1024 + hoff + ch * 8; \
        pk[i] = *(const u32x4*)(KR + off); pv[i] = *(const u32x4*)(VR + off); } } while (0)
#define RET_WRITE(buf) do { _Pragma("unroll") for (int i = 0; i < 4; ++i) { const int id = tid + 512 * i, key = id >> 5, ch = id & 31; \
        *(LAS u32x4*)(lds + (buf) * 2 * TB + key * RS + ch * 16) = pk[i]; *(LAS u32x4*)(lds + (buf) * 2 * TB + TB + key * RS + ch * 16) = pv[i]; } } while (0)
    RET_LOAD(0); RET_WRITE(0); __syncthreads();
    for (int kt = 0; kt < nt; ++kt) {
        const int buf = kt & 1;
        if (kt + 1 < nt) RET_LOAD(kt + 1);
        if (64 * kt <= 128 * qb + 16 * w + 15) {
            LAS const unsigned char* Kl = lds + buf * 2 * TB; LAS const unsigned char* Vl = Kl + TB;
            f32x4 s[4];
#pragma unroll
            for (int blk = 0; blk < 4; ++blk) { f32x4 acc = {0.f, 0.f, 0.f, 0.f};
#pragma unroll
                for (int ks = 0; ks < 8; ++ks) { const bf16x8 kf = *(LAS const bf16x8*)(Kl + (16 * blk + c) * RS + (ks * 32 + 8 * g) * 2); acc = MFMA16(kf, qf[ks], acc); }
#pragma unroll
                for (int r = 0; r < 4; ++r) { const int d = qpos - (64 * kt + 16 * blk + 4 * g + r); const float dec = __builtin_amdgcn_exp2f((float)d * lg); acc[r] = (d >= 0) ? acc[r] * dec : 0.f; }
                s[blk] = acc; }
#pragma unroll
            for (int kp = 0; kp < 2; ++kp) { const bf16x8 pf = pack_p(s[2 * kp], s[2 * kp + 1]);
#pragma unroll
                for (int db = 0; db < 16; ++db) { const bf16x8 af = vt_frag(Vl + (32 * kp + 4 * g + (c >> 2)) * RS + (16 * db + 4 * (c & 3)) * 2, 16 * RS); o[db] = MFMA16(af, pf, o[db]); }
                __builtin_amdgcn_sched_barrier(0); }
        }
        if (kt + 1 < nt) RET_WRITE(buf ^ 1);
        __syncthreads();
    }
#undef RET_LOAD
#undef RET_WRITE
    float s1 = 0.f;
#pragma unroll
    for (int db = 0; db < 16; ++db) s1 += (o[db][0] + o[db][1]) + (o[db][2] + o[db][3]);
    s1 += __shfl_xor(s1, 16); s1 += __shfl_xor(s1, 32);
    const float mu = s1 * (1.f / 256.f); float s2 = 0.f;
#pragma unroll
    for (int db = 0; db < 16; ++db) { o[db] = o[db] - mu; s2 += (o[db][0] * o[db][0] + o[db][1] * o[db][1]) + (o[db][2] * o[db][2] + o[db][3] * o[db][3]); }
    s2 += __shfl_xor(s2, 16); s2 += __shfl_xor(s2, 32);
    const float rstd = rsqrtf(s2 * (1.f / 256.f) + GN_EPS);
#pragma unroll
    for (int db = 0; db < 16; ++db) { const int col = hoff + 16 * db + 4 * g; const f32x4 gn = *(const f32x4*)(ret_gain + col); const u32x2 gw = *(const u32x2*)(GR + t * 1024 + col);
        const float z0 = bf_lo(gw.x), z1 = bf_hi(gw.x), z2 = bf_lo(gw.y), z3 = bf_hi(gw.y);
        f32x4 v = o[db] * rstd * gn;
        v[0] *= z0 / (1.f + __expf(-z0)); v[1] *= z1 / (1.f + __expf(-z1)); v[2] *= z2 / (1.f + __expf(-z2)); v[3] *= z3 / (1.f + __expf(-z3));
        u32x2 wv; wv.x = pk2(v[0], v[1]); wv.y = pk2(v[2], v[3]); *(u32x2*)(Y + t * DM + 1024 + col) = wv; }
}

__device__ __forceinline__ void xattn_unit(LAS unsigned char* lds, int b, int hx, int qblk, const bf16_t* QX, const bf16_t* KX, const bf16_t* VX, bf16_t* OX) {
    constexpr int KS = 288;
    const int tid = threadIdx.x, lane = tid & 63, c = lane & 15, g = lane >> 4; const int w = __builtin_amdgcn_readfirstlane(tid >> 6);
    LAS unsigned char* Kl = lds; LAS unsigned char* Vl = lds + 256 * KS;
    for (int i = tid; i < 4096; i += 512) { const int key = i >> 4, ch = i & 15; const size_t off = (size_t)(b * MEML + key) * 512 + hx * 128 + ch * 8;
        *(LAS u32x4*)(Kl + key * KS + ch * 16) = *(const u32x4*)(KX + off); *(LAS u32x4*)(Vl + key * KS + ch * 16) = *(const u32x4*)(VX + off); }
    __syncthreads();
    bf16x8 qn[4];
#pragma unroll
    for (int ks = 0; ks < 4; ++ks) qn[ks] = *(const bf16x8*)(QX + ((size_t)b * SEQ + 256 * qblk + 16 * w + c) * 512 + hx * 128 + ks * 32 + 8 * g);
#pragma unroll 1
    for (int pass = 0; pass < 2; ++pass) {
        const size_t t = (size_t)b * SEQ + 256 * qblk + 128 * pass + 16 * w + c;
        bf16x8 qf[4];
#pragma unroll
        for (int ks = 0; ks < 4; ++ks) { qf[ks] = qn[ks]; qn[ks] = *(const bf16x8*)(QX + (t + (pass == 0 ? 128 : 0)) * 512 + hx * 128 + ks * 32 + 8 * g); }
        f32x4 s[16]; float m = -INFINITY;
#pragma unroll
        for (int blk = 0; blk < 16; ++blk) { f32x4 acc = {0.f, 0.f, 0.f, 0.f};
#pragma unroll
            for (int ks = 0; ks < 4; ++ks) { const bf16x8 kf = *(LAS const bf16x8*)(Kl + (16 * blk + c) * KS + (ks * 32 + 8 * g) * 2); acc = MFMA16(kf, qf[ks], acc); }
            m = fmaxf(fmaxf(fmaxf(acc[0], acc[1]), fmaxf(acc[2], acc[3])), m); s[blk] = acc; __builtin_amdgcn_sched_barrier(0); }
        m = fmaxf(m, __shfl_xor(m, 16)); m = fmaxf(m, __shfl_xor(m, 32));
        float l = 0.f;
#pragma unroll
        for (int blk = 0; blk < 16; ++blk)
#pragma unroll
            for (int r = 0; r < 4; ++r) { const float p = __builtin_amdgcn_exp2f(s[blk][r] - m); s[blk][r] = p; l += p; }
        l += __shfl_xor(l, 16); l += __shfl_xor(l, 32);
        f32x4 o[8];
#pragma unroll
        for (int db = 0; db < 8; ++db) o[db] = (f32x4){0.f, 0.f, 0.f, 0.f};
#pragma unroll
        for (int kp = 0; kp < 8; ++kp) { const bf16x8 pf = pack_p(s[2 * kp], s[2 * kp + 1]);
#pragma unroll
            for (int db = 0; db < 8; ++db) { const bf16x8 af = vt_frag(Vl + (32 * kp + 4 * g + (c >> 2)) * KS + (16 * db + 4 * (c & 3)) * 2, 16 * KS); o[db] = MFMA16(af, pf, o[db]); }
            __builtin_amdgcn_sched_barrier(0); }
        const float inv = 1.f / l;
#pragma unroll
        for (int db = 0; db < 8; ++db) { const f32x4 v = o[db] * inv; u32x2 wv; wv.x = pk2(v[0], v[1]); wv.y = pk2(v[2], v[3]); *(u32x2*)(OX + t * 512 + hx * 128 + 16 * db + 4 * g) = wv; }
    }
    __syncthreads();
}

__device__ __forceinline__ int mono_i(float x) { int i = __float_as_int(x); return i ^ ((i >> 31) & 0x7fffffff); }
__device__ __forceinline__ float mono_f(int i) { return __int_as_float(i ^ ((i >> 31) & 0x7fffffff)); }
#define INS16(L, v) do { int _v = (v); _Pragma("unroll") for (int _k = 0; _k < 16; ++_k) { const int _t = max(L[_k], _v); _v = min(L[_k], _v); L[_k] = _t; } } while (0)
#define CE_DESC(x, y) do { const int _h = max((x), (y)), _l = min((x), (y)); (x) = _h; (y) = _l; } while (0)
#define SORT16_DESC(L) do { \
    CE_DESC(L[0], L[1]); \
    CE_DESC(L[2], L[3]); \
    CE_DESC(L[0], L[2]); \
    CE_DESC(L[1], L[3]); \
    CE_DESC(L[1], L[2]); \
    CE_DESC(L[4], L[5]); \
    CE_DESC(L[6], L[7]); \
    CE_DESC(L[4], L[6]); \
    CE_DESC(L[5], L[7]); \
    CE_DESC(L[5], L[6]); \
    CE_DESC(L[0], L[4]); \
    CE_DESC(L[2], L[6]); \
    CE_DESC(L[2], L[4]); \
    CE_DESC(L[1], L[5]); \
    CE_DESC(L[3], L[7]); \
    CE_DESC(L[3], L[5]); \
    CE_DESC(L[1], L[2]); \
    CE_DESC(L[3], L[4]); \
    CE_DESC(L[5], L[6]); \
    CE_DESC(L[8], L[9]); \
    CE_DESC(L[10], L[11]); \
    CE_DESC(L[8], L[10]); \
    CE_DESC(L[9], L[11]); \
    CE_DESC(L[9], L[10]); \
    CE_DESC(L[12], L[13]); \
    CE_DESC(L[14], L[15]); \
    CE_DESC(L[12], L[14]); \
    CE_DESC(L[13], L[15]); \
    CE_DESC(L[13], L[14]); \
    CE_DESC(L[8], L[12]); \
    CE_DESC(L[10], L[14]); \
    CE_DESC(L[10], L[12]); \
    CE_DESC(L[9], L[13]); \
    CE_DESC(L[11], L[15]); \
    CE_DESC(L[11], L[13]); \
    CE_DESC(L[9], L[10]); \
    CE_DESC(L[11], L[12]); \
    CE_DESC(L[13], L[14]); \
    CE_DESC(L[0], L[8]); \
    CE_DESC(L[4], L[12]); \
    CE_DESC(L[4], L[8]); \
    CE_DESC(L[2], L[10]); \
    CE_DESC(L[6], L[14]); \
    CE_DESC(L[6], L[10]); \
    CE_DESC(L[2], L[4]); \
    CE_DESC(L[6], L[8]); \
    CE_DESC(L[10], L[12]); \
    CE_DESC(L[1], L[9]); \
    CE_DESC(L[5], L[13]); \
    CE_DESC(L[5], L[9]); \
    CE_DESC(L[3], L[11]); \
    CE_DESC(L[7], L[15]); \
    CE_DESC(L[7], L[11]); \
    CE_DESC(L[3], L[5]); \
    CE_DESC(L[7], L[9]); \
    CE_DESC(L[11], L[13]); \
    CE_DESC(L[1], L[2]); \
    CE_DESC(L[3], L[4]); \
    CE_DESC(L[5], L[6]); \
    CE_DESC(L[7], L[8]); \
    CE_DESC(L[9], L[10]); \
    CE_DESC(L[11], L[12]); \
    CE_DESC(L[13], L[14]); \
} while (0)

__device__ __forceinline__ void bitonic_fix16(int (&L)[16]) {
    CE_DESC(L[0], L[8]); CE_DESC(L[1], L[9]); CE_DESC(L[2], L[10]); CE_DESC(L[3], L[11]); CE_DESC(L[4], L[12]); CE_DESC(L[5], L[13]); CE_DESC(L[6], L[14]); CE_DESC(L[7], L[15]);
    CE_DESC(L[0], L[4]); CE_DESC(L[1], L[5]); CE_DESC(L[2], L[6]); CE_DESC(L[3], L[7]); CE_DESC(L[8], L[12]); CE_DESC(L[9], L[13]); CE_DESC(L[10], L[14]); CE_DESC(L[11], L[15]);
    CE_DESC(L[0], L[2]); CE_DESC(L[1], L[3]); CE_DESC(L[4], L[6]); CE_DESC(L[5], L[7]); CE_DESC(L[8], L[10]); CE_DESC(L[9], L[11]); CE_DESC(L[12], L[14]); CE_DESC(L[13], L[15]);
    CE_DESC(L[0], L[1]); CE_DESC(L[2], L[3]); CE_DESC(L[4], L[5]); CE_DESC(L[6], L[7]); CE_DESC(L[8], L[9]); CE_DESC(L[10], L[11]); CE_DESC(L[12], L[13]); CE_DESC(L[14], L[15]);
}
__device__ __forceinline__ void merge16(int (&L)[16], int xm) {
    int P[16];
#pragma unroll
    for (int i = 0; i < 16; ++i) P[i] = __shfl_xor(L[i], xm);
#pragma unroll
    for (int i = 0; i < 16; ++i) L[i] = max(L[i], P[15 - i]);
    bitonic_fix16(L);
}
__device__ __forceinline__ void peer_topk_unit(LAS unsigned char* lds, int pm, int h, const bf16_t* PQ, const float* subk, int* EXP, float* GATE) {
    constexpr int KS = 272;
    const int tid = threadIdx.x, lane = tid & 63, c = lane & 15, g = lane >> 4; const int w = __builtin_amdgcn_readfirstlane(tid >> 6);
    const float* sk = subk + (size_t)h * 2 * 128 * 128;
    for (int i = tid; i < 8192; i += 512) { const int row = i >> 5, ch = i & 31; const f32x4 v = *(const f32x4*)(sk + (size_t)row * 128 + ch * 4);
        u32x2 wv; wv.x = pk2(v[0], v[1]); wv.y = pk2(v[2], v[3]); *(LAS u32x2*)(lds + row * KS + ch * 8) = wv; }
    __syncthreads();
#pragma unroll 1
    for (int grp = 0; grp < 2; ++grp) {
        const size_t t = (size_t)pm * 256 + 32 * w + 16 * grp + c;
        int S1[16], S2[16];
        bf16x8 qall[2][4];
#pragma unroll
        for (int p = 0; p < 2; ++p)
#pragma unroll
            for (int ks = 0; ks < 4; ++ks) qall[p][ks] = *(const bf16x8*)(PQ + t * DM + h * 256 + p * 128 + ks * 32 + 8 * g);
#pragma unroll
        for (int p = 0; p < 2; ++p) {
            bf16x8 qf[4];
#pragma unroll
            for (int ks = 0; ks < 4; ++ks) qf[ks] = qall[p][ks];
            int A[16], B[16];
#pragma unroll
            for (int blk = 0; blk < 8; ++blk) { f32x4 acc = {0.f, 0.f, 0.f, 0.f};
#pragma unroll
                for (int ks = 0; ks < 4; ++ks) { const bf16x8 kf = *(LAS const bf16x8*)(lds + (p * 128 + 16 * blk + c) * KS + (ks * 32 + 8 * g) * 2); acc = MFMA16(kf, qf[ks], acc); }
#pragma unroll
                for (int r = 0; r < 4; ++r) { const int idx = 16 * blk + 4 * g + r; const int key = (mono_i(acc[r]) & ~127) | (127 - idx); if (blk < 4) A[4 * blk + r] = key; else B[4 * (blk - 4) + r] = key; }
                __builtin_amdgcn_sched_barrier(0); }
            SORT16_DESC(A); SORT16_DESC(B);
#pragma unroll
            for (int i = 0; i < 16; ++i) A[i] = max(A[i], B[15 - i]);
            bitonic_fix16(A);
            merge16(A, 16); merge16(A, 32);
#pragma unroll
            for (int k = 0; k < 16; ++k) { if (p == 0) S1[k] = A[k]; else S2[k] = A[k]; }
        }
        float s1v[16], s2v[16];
#pragma unroll
        for (int k = 0; k < 16; ++k) { s1v[k] = mono_f(S1[k] & ~127); s2v[k] = mono_f(S2[k] & ~127); }
        int Mx[16];
#pragma unroll
        for (int k = 0; k < 16; ++k) Mx[k] = (int)0x80000000;
#define STAIR4(a0, b0, a1, b1, a2, b2, a3, b3) do { const float _c0 = s1v[a0] + s2v[b0], _c1 = s1v[a1] + s2v[b1], _c2 = s1v[a2] + s2v[b2], _c3 = s1v[a3] + s2v[b3]; \
        const float _m = (g == 0) ? _c0 : (g == 1) ? _c1 : (g == 2) ? _c2 : _c3; const int _cd = (g == 0) ? (255 - (16 * a0 + b0)) : (g == 1) ? (255 - (16 * a1 + b1)) : (g == 2) ? (255 - (16 * a2 + b2)) : (255 - (16 * a3 + b3)); \
        INS16(Mx, (mono_i(_m) & ~255) | _cd); } while (0)
#define STAIR2(a0, b0, a1, b1) do { const float _c0 = s1v[a0] + s2v[b0], _c1 = s1v[a1] + s2v[b1]; const float _m = (g == 0) ? _c0 : _c1; const int _cd = (g == 0) ? (255 - (16 * a0 + b0)) : (255 - (16 * a1 + b1)); \
        const int _key = (mono_i(_m) & ~255) | _cd; INS16(Mx, (g < 2) ? _key : (int)0x80000000); } while (0)
        STAIR4(0, 0, 0, 1, 0, 2, 0, 3);
        STAIR4(0, 4, 0, 5, 0, 6, 0, 7);
        STAIR4(0, 8, 0, 9, 0, 10, 0, 11);
        STAIR4(0, 12, 0, 13, 0, 14, 0, 15);
        STAIR4(1, 0, 1, 1, 1, 2, 1, 3);
        STAIR4(1, 4, 1, 5, 1, 6, 1, 7);
        STAIR4(2, 0, 2, 1, 2, 2, 2, 3);
        STAIR4(2, 4, 3, 0, 3, 1, 3, 2);
        STAIR4(3, 3, 4, 0, 4, 1, 4, 2);
        STAIR4(5, 0, 5, 1, 6, 0, 6, 1);
        STAIR4(7, 0, 7, 1, 8, 0, 9, 0);
        STAIR4(10, 0, 11, 0, 12, 0, 13, 0);
        STAIR2(14, 0, 15, 0);
#undef STAIR4
#undef STAIR2
        merge16(Mx, 16); merge16(Mx, 32);
        const float top = mono_f(Mx[0] & ~255); float wg[4]; int ex[4]; float wsum = 0.f;
#pragma unroll
        for (int i = 0; i < 4; ++i) { const int key = (g == 0) ? Mx[i] : (g == 1) ? Mx[4 + i] : (g == 2) ? Mx[8 + i] : Mx[12 + i];
            wg[i] = __expf(mono_f(key & ~255) - top); wsum += wg[i];
            const int ab = 255 - (key & 255), a = ab >> 4, bb = ab & 15; int e1 = 0, e2 = 0;
#pragma unroll
            for (int k = 0; k < 16; ++k) { e1 = (a == k) ? (127 - (S1[k] & 127)) : e1; e2 = (bb == k) ? (127 - (S2[k] & 127)) : e2; }
            ex[i] = e1 * 128 + e2; }
        wsum += __shfl_xor(wsum, 16); wsum += __shfl_xor(wsum, 32);
        const float inv = 1.f / wsum;
        *(int4*)(EXP + t * 128 + h * 16 + 4 * g) = make_int4(ex[0], ex[1], ex[2], ex[3]);
        *(f32x4*)(GATE + t * 128 + h * 16 + 4 * g) = (f32x4){wg[0] * inv, wg[1] * inv, wg[2] * inv, wg[3] * inv};
    }
    __syncthreads();
}
typedef __bf16 v32bf16 __attribute__((ext_vector_type(32)));
typedef unsigned v6u32 __attribute__((ext_vector_type(6)));
constexpr int ROWB = 1536;
__device__ __forceinline__ float fdot2bf(bf16x2_t a, bf16x2_t b, float c) { return __builtin_amdgcn_fdot2_f32_bf16(a, b, c, false); }
__device__ __forceinline__ void row_to_fp6(const float* src, const float* colgain, unsigned char* dst, float* inv, int lane) {
    f32x4 v[8]; float am = 0.f;
#pragma unroll
    for (int j = 0; j < 8; ++j) { v[j] = *(const f32x4*)(src + 32 * lane + 4 * j); if (colgain) v[j] = v[j] * *(const f32x4*)(colgain + 32 * lane + 4 * j);
        am = fmaxf(am, fmaxf(fmaxf(fabsf(v[j][0]), fabsf(v[j][1])), fmaxf(fabsf(v[j][2]), fabsf(v[j][3])))); }
#pragma unroll
    for (int o = 1; o < 64; o <<= 1) am = fmaxf(am, __shfl_xor(am, o));
    float S = 1.f;
    if (am > 1e-30f) S = __uint_as_float(__float_as_uint(7.5f / am) & 0x7f800000u);
    unsigned pk[6] = {0u, 0u, 0u, 0u, 0u, 0u};
#pragma unroll
    for (int j = 0; j < 8; ++j)
#pragma unroll
        for (int i = 0; i < 4; ++i) { const float t = v[j][i] * S, a = fabsf(t);
            const float cf = (a < 2.f) ? rintf(a * 8.f) : (a < 4.f) ? 16.f + rintf((a - 2.f) * 4.f) : 24.f + rintf((a - 4.f) * 2.f);
            unsigned cd = (unsigned)fminf(cf, 31.f); if (t < 0.f) cd |= 32u;
            const int e = 4 * j + i, bit = 6 * e, dw = bit >> 5, sh = bit & 31;
            pk[dw] |= cd << sh; if (sh > 26) pk[dw + 1] |= cd >> (32 - sh); }
    *(u32x4*)(dst + 16 * lane) = (u32x4){pk[0], pk[1], pk[2], pk[3]}; *(u32x2*)(dst + 1024 + 8 * lane) = (u32x2){pk[4], pk[5]};
    if (lane == 0) *inv = 1.f / S;
}
__device__ __forceinline__ v32bf16 sw_unpack6(v6u32 s) {
    v32bf16 r;
#pragma unroll
    for (int e = 0; e < 32; ++e) { const int bit = 6 * e, dw = bit >> 5, sh = bit & 31; unsigned cd = s[dw] >> sh; if (sh > 26) cd |= s[dw + 1] << (32 - sh); cd &= 63u;
        const unsigned m = cd & 31u; float a = (m < 16u) ? (float)m * 0.125f : (m < 24u) ? 2.f + (float)(m - 16u) * 0.25f : 4.f + (float)(m - 24u) * 0.5f; if (cd & 32u) a = -a; r[e] = (__bf16)a; }
    return r;
}
constexpr int RING = 4;
typedef unsigned v16u32 __attribute__((ext_vector_type(16)));
__device__ __forceinline__ bf16x2_t as_pair(unsigned w) { return __builtin_bit_cast(bf16x2_t, w); }
#define PAIR(r, p) as_pair((r)[(p)])
#define PG_EW(p)  ((LAS int*)(wb + 512 + (p) * 512))
#define PG_SU(p)  ((LAS float*)(wb + 1536 + (p) * 512))
#define PG_GV(p)  ((LAS float*)(wb + 2560 + (p) * 512))
#define PG_ST(p)  ((LAS f32x4*)(wb + 4096 + (p) * 4096))
__device__ __forceinline__ void peer_gather_wave(LAS unsigned char* wb, LAS const float* gl, int tfirst, int tstep, const bf16_t* X,
                                                 const unsigned char* UBp, const unsigned char* VBp, const float* SUp, const float* SVp, const int* EXP, const float* GATEp, float* OUT, int lane) {
    LAS float* cw = (LAS float*)wb;
    u32x4 xq[4]; int kA, kB, s0k, s1k; float su0, su1, sv0, sv1, gt0, gt1; bf16x2_t xb[16];
    u32x4 ra[RING]; u32x2 rc[RING];
    const int eloc = ((lane >> 5) & 1) * 8 + ((lane >> 4) & 1) * 4 + ((lane >> 3) & 1) * 2 + ((lane >> 2) & 1);
#define ROWLOAD(BASE, slot, EW, k) do { const int _e = __builtin_amdgcn_readfirstlane((EW)[(k)]) >> 7; const unsigned char* _rp = (BASE) + (size_t)_e * ROWB; \
        ra[slot] = *(const u32x4*)(_rp + 16 * lane); rc[slot] = *(const u32x2*)(_rp + 1024 + 8 * lane); } while (0)
#define ROWCVT(slot) __builtin_amdgcn_cvt_scalef32_pk32_bf16_fp6((v6u32){ra[slot].x, ra[slot].y, ra[slot].z, ra[slot].w, rc[slot].x, rc[slot].y}, 1.0f)
#define TOK_FETCH(t) do { const bf16_t* _xr = X + (size_t)(t) * DM + 32 * lane; _Pragma("unroll") for (int j = 0; j < 4; ++j) xq[j] = *(const u32x4*)(_xr + 8 * j); \
        kA = EXP[(size_t)(t) * 128 + lane]; kB = EXP[(size_t)(t) * 128 + 64 + lane]; } while (0)
#define TOK_SORT(t) do { int k0 = (kA << 7) | lane, k1 = (kB << 7) | (64 + lane); \
        _Pragma("unroll") for (int k = 2; k <= 128; k <<= 1) _Pragma("unroll") for (int j = k >> 1; j > 0; j >>= 1) { \
            if (j == 64) { const int a_ = min(k0, k1), c_ = max(k0, k1); k0 = a_; k1 = c_; } \
            else { const int p0 = __shfl_xor(k0, j), p1 = __shfl_xor(k1, j); const bool lower = (lane & j) == 0; \
                   const bool asc0 = (k >= 64) ? true : ((lane & k) == 0), asc1 = (k == 128) ? true : ((k == 64) ? false : ((lane & k) == 0)); \
                   k0 = (lower == asc0) ? min(k0, p0) : max(k0, p0); k1 = (lower == asc1) ? min(k1, p1) : max(k1, p1); } } \
        s0k = k0; s1k = k1; su0 = SUp[k0 >> 7]; sv0 = SVp[k0 >> 7]; gt0 = GATEp[(size_t)(t) * 128 + (k0 & 127)]; su1 = SUp[k1 >> 7]; sv1 = SVp[k1 >> 7]; gt1 = GATEp[(size_t)(t) * 128 + (k1 & 127)]; } while (0)
#define TOK_COMMIT(p) do { PG_EW(p)[lane] = s0k; PG_EW(p)[lane + 64] = s1k; PG_SU(p)[lane] = su0; PG_SU(p)[lane + 64] = su1; PG_GV(p)[lane] = gt0 * sv0; PG_GV(p)[lane + 64] = gt1 * sv1; } while (0)
#define TOK_XB(p) do { f32x4 xv[8]; float ss = 0.f; \
        _Pragma("unroll") for (int j = 0; j < 4; ++j) { xv[2 * j] = (f32x4){bf_lo(xq[j].x), bf_hi(xq[j].x), bf_lo(xq[j].y), bf_hi(xq[j].y)}; xv[2 * j + 1] = (f32x4){bf_lo(xq[j].z), bf_hi(xq[j].z), bf_lo(xq[j].w), bf_hi(xq[j].w)}; } \
        _Pragma("unroll") for (int j = 0; j < 8; ++j) ss += (xv[j][0] * xv[j][0] + xv[j][1] * xv[j][1]) + (xv[j][2] * xv[j][2] + xv[j][3] * xv[j][3]); \
        ss = wave_sum(ss); const float rs = rsqrtf(ss * (1.f / DM) + EPS); \
        _Pragma("unroll") for (int j = 0; j < 8; ++j) { const f32x4 a = xv[j] * rs * *(LAS const f32x4*)(gl + 32 * lane + 4 * j); xb[2 * j] = __builtin_bit_cast(bf16x2_t, pk2(a[0], a[1])); xb[2 * j + 1] = __builtin_bit_cast(bf16x2_t, pk2(a[2], a[3])); } \
        _Pragma("unroll") for (int j = 0; j < 4; ++j) PG_ST(p)[j * 64 + lane] = __builtin_bit_cast(f32x4, xq[j]); } while (0)
#define V_ROWS(K0, K1, cur) for (int k0 = (K0); k0 < (K1); k0 += RING) { _Pragma("unroll") for (int j = 0; j < RING; ++j) { \
            const float cv = cw[k0 + j]; const unsigned clo_u = pk2(cv, 0.f); const bf16x2_t clo = __builtin_bit_cast(bf16x2_t, clo_u), chi = __builtin_bit_cast(bf16x2_t, clo_u << 16); \
            const v16u32 r = __builtin_bit_cast(v16u32, ROWCVT(j)); \
            _Pragma("unroll") for (int q = 0; q < 16; ++q) { acc[2 * q] = fdot2bf(PAIR(r, q), clo, acc[2 * q]); acc[2 * q + 1] = fdot2bf(PAIR(r, q), chi, acc[2 * q + 1]); } \
            ROWLOAD(VBp, j, PG_EW(cur), k0 + j + RING); } }

    TOK_FETCH(tfirst); TOK_SORT(tfirst); TOK_COMMIT(0); TOK_XB(0);
    asm volatile("s_waitcnt lgkmcnt(0)" ::: "memory");
#pragma unroll
    for (int j = 0; j < RING; ++j) ROWLOAD(UBp, j, PG_EW(0), j);
    int cur = 0;
#pragma unroll 1
    for (int t = tfirst; t < T_TOK; t += tstep, cur ^= 1) {
        const int nxt = cur ^ 1; const int tn = (t + tstep < T_TOK) ? t + tstep : t;
#pragma unroll 1
        for (int b = 0; b < 8; ++b) {
            float part[16];
#pragma unroll
            for (int j = 0; j < 16; ++j) { const int slot = j & (RING - 1); const v16u32 r = __builtin_bit_cast(v16u32, ROWCVT(slot)); float a0 = 0.f, a1 = 0.f;
#pragma unroll
                for (int q = 0; q < 8; ++q) { a0 = fdot2bf(PAIR(r, 2 * q), xb[2 * q], a0); a1 = fdot2bf(PAIR(r, 2 * q + 1), xb[2 * q + 1], a1); }
                part[j] = a0 + a1;
                { const int sn = 16 * b + j + RING; const unsigned char* nb = (sn < 128) ? UBp : VBp; ROWLOAD(nb, slot, PG_EW(cur), sn & 127); } }
            float q8[8], q4[4], q2[2], q1;
#pragma unroll
            for (int i = 0; i < 8; ++i) { const bool up = (lane & 32) != 0; const float snd = up ? part[i] : part[i + 8], kp = up ? part[i + 8] : part[i]; q8[i] = kp + __shfl_xor(snd, 32); }
#pragma unroll
            for (int i = 0; i < 4; ++i) { const bool up = (lane & 16) != 0; const float snd = up ? q8[i] : q8[i + 4], kp = up ? q8[i + 4] : q8[i]; q4[i] = kp + __shfl_xor(snd, 16); }
#pragma unroll
            for (int i = 0; i < 2; ++i) { const bool up = (lane & 8) != 0; const float snd = up ? q4[i] : q4[i + 2], kp = up ? q4[i + 2] : q4[i]; q2[i] = kp + __shfl_xor(snd, 8); }
            { const bool up = (lane & 4) != 0; const float snd = up ? q2[0] : q2[1], kp = up ? q2[1] : q2[0]; q1 = kp + __shfl_xor(snd, 4); }
            q1 += __shfl_xor(q1, 1); q1 += __shfl_xor(q1, 2);
            if ((lane & 3) == 0) { const int k = 16 * b + eloc; const float av = q1 * PG_SU(cur)[k]; const float gel = 0.5f * av * (1.f + erff(av * 0.70710678118654752f)); cw[k] = gel * PG_GV(cur)[k]; }
        }
        asm volatile("s_waitcnt lgkmcnt(0)" ::: "memory");
        float acc[32];
#pragma unroll
        for (int i = 0; i < 32; ++i) acc[i] = 0.f;
        TOK_FETCH(tn);
        V_ROWS(0, 32, cur)
        TOK_SORT(tn);
        V_ROWS(32, 64, cur)
        TOK_COMMIT(nxt);
        V_ROWS(64, 96, cur)
        TOK_XB(nxt);
        V_ROWS(96, 128 - RING, cur)
        asm volatile("s_waitcnt lgkmcnt(0)" ::: "memory");
#pragma unroll
        for (int j = 0; j < RING; ++j) { const int k = 128 - RING + j;
            const float cv = cw[k]; const unsigned clo_u = pk2(cv, 0.f); const bf16x2_t clo = __builtin_bit_cast(bf16x2_t, clo_u), chi = __builtin_bit_cast(bf16x2_t, clo_u << 16);
            const v16u32 r = __builtin_bit_cast(v16u32, ROWCVT(j));
#pragma unroll
            for (int q = 0; q < 16; ++q) { acc[2 * q] = fdot2bf(PAIR(r, q), clo, acc[2 * q]); acc[2 * q + 1] = fdot2bf(PAIR(r, q), chi, acc[2 * q + 1]); }
            ROWLOAD(UBp, j, PG_EW(nxt), j); }
        f32x4 xo[8]; float s3 = 0.f;
#pragma unroll
        for (int j = 0; j < 4; ++j) { const u32x4 q = __builtin_bit_cast(u32x4, PG_ST(cur)[j * 64 + lane]); xo[2 * j] = (f32x4){bf_lo(q.x), bf_hi(q.x), bf_lo(q.y), bf_hi(q.y)}; xo[2 * j + 1] = (f32x4){bf_lo(q.z), bf_hi(q.z), bf_lo(q.w), bf_hi(q.w)}; }
#pragma unroll
        for (int j = 0; j < 8; ++j)
#pragma unroll
            for (int i = 0; i < 4; ++i) { xo[j][i] += acc[4 * j + i]; s3 += xo[j][i] * xo[j][i]; }
        s3 = wave_sum(s3);
        const float r3 = rsqrtf(s3 * (1.f / DM) + EPS);
        float* orow = OUT + (size_t)t * DM + 32 * lane;
#pragma unroll
        for (int j = 0; j < 8; ++j) { const f32x4 g0 = *(LAS const f32x4*)(gl + DM + 32 * lane + 4 * j); *(f32x4*)(orow + 4 * j) = xo[j] * r3 * g0; }
    }
#undef ROWLOAD
#undef ROWCVT
#undef TOK_FETCH
#undef TOK_SORT
#undef TOK_COMMIT
#undef TOK_XB
#undef V_ROWS
}

constexpr unsigned NF1 = 896;
__device__ __forceinline__ void fp8_chunk(int chunk, int wave, int lane, const float* peer_u, const float* peer_v, const float* g_ffn, unsigned char* UB, unsigned char* VB, float* SU, float* SV) {
#pragma unroll 1
    for (int r = 0; r < 2; ++r) { const int row = chunk * 16 + wave * 2 + r;
        if (row < 16384) row_to_fp6(peer_u + (size_t)row * DM, nullptr, UB + (size_t)row * ROWB, SU + row, lane);
        else row_to_fp6(peer_v + (size_t)(row - 16384) * DM, nullptr, VB + (size_t)(row - 16384) * ROWB, SV + (row - 16384), lane); }
}
constexpr int NWAVES = 8, LDS_BYTES = 163840, MISC_OFF = 159744;
constexpr int N_PHASES = 10;
struct Args { const void* in[21]; float* out; unsigned char* ws; int ph_lo, ph_hi; float inv_freq[128]; };

#define IN_x ((const float*)((const float*)args.in[0]))
#define IN_mem ((const float*)((const float*)args.in[1]))
#define IN_positions ((const int*)((const int*)args.in[2]))
#define IN_g_mix ((const float*)((const float*)args.in[3]))
#define IN_w_in ((const float*)((const float*)args.in[4]))
#define IN_sinks ((const float*)((const float*)args.in[5]))
#define IN_att_gain ((const float*)((const float*)args.in[6]))
#define IN_ret_gain ((const float*)((const float*)args.in[7]))
#define IN_w_out ((const float*)((const float*)args.in[8]))
#define IN_g_cross ((const float*)((const float*)args.in[9]))
#define IN_g_mem ((const float*)((const float*)args.in[10]))
#define IN_w_xq ((const float*)((const float*)args.in[11]))
#define IN_w_xk ((const float*)((const float*)args.in[12]))
#define IN_w_xv ((const float*)((const float*)args.in[13]))
#define IN_w_xo ((const float*)((const float*)args.in[14]))
#define IN_g_ffn ((const float*)((const float*)args.in[15]))
#define IN_w_pq ((const float*)((const float*)args.in[16]))
#define IN_subk ((const float*)((const float*)args.in[17]))
#define IN_peer_u ((const float*)((const float*)args.in[18]))
#define IN_peer_v ((const float*)((const float*)args.in[19]))
#define IN_g_fin ((const float*)((const float*)args.in[20]))
#define IN_out ((float*)(args.out))
#define WIN ((bf16_t*)((bf16_t*)(ws + WS_WIN)))
#define WOUT ((bf16_t*)((bf16_t*)(ws + WS_WOUT)))
#define WXQ ((bf16_t*)((bf16_t*)(ws + WS_WXQ)))
#define WXKV ((bf16_t*)((bf16_t*)(ws + WS_WXKV)))
#define WXO ((bf16_t*)((bf16_t*)(ws + WS_WXO)))
#define WPQ ((bf16_t*)((bf16_t*)(ws + WS_WPQ)))
#define XB ((bf16_t*)((bf16_t*)(ws + WS_XB)))
#define MEMB ((bf16_t*)((bf16_t*)(ws + WS_MEMB)))
#define COSA ((float*)((float*)(ws + WS_COSA)))
#define SINA ((float*)((float*)(ws + WS_SINA)))
#define COSR ((float*)((float*)(ws + WS_COSR)))
#define SINR ((float*)((float*)(ws + WS_SINR)))
#define SS0 ((float*)((float*)(ws + WS_SS0)))
#define SS1 ((float*)((float*)(ws + WS_SS1)))
#define SS2 ((float*)((float*)(ws + WS_SS2)))
#define SSM ((float*)((float*)(ws + WS_SSM)))
#define KX ((bf16_t*)((bf16_t*)(ws + WS_KX)))
#define VX ((bf16_t*)((bf16_t*)(ws + WS_VX)))
#define QX ((bf16_t*)((bf16_t*)(ws + WS_QX)))
#define OX ((bf16_t*)((bf16_t*)(ws + WS_OX)))
#define EXPI ((int*)((int*)(ws + WS_EXP)))
#define GATE ((float*)((float*)(ws + WS_GATE)))
#define Y ((bf16_t*)((bf16_t*)(ws + WS_Y)))
#define PQ ((bf16_t*)((bf16_t*)(ws + WS_Y)))
#define QA ((bf16_t*)((bf16_t*)(ws + WS_QA)))
#define KA ((bf16_t*)((bf16_t*)(ws + WS_KA)))
#define VA ((bf16_t*)((bf16_t*)(ws + WS_VA)))
#define QR ((bf16_t*)((bf16_t*)(ws + WS_QR)))
#define KR ((bf16_t*)((bf16_t*)(ws + WS_KR)))
#define VR ((bf16_t*)((bf16_t*)(ws + WS_VR)))
#define GR ((bf16_t*)((bf16_t*)(ws + WS_GR)))
#define UB ((unsigned char*)(ws + WS_UB))
#define VB ((unsigned char*)(ws + WS_VB))
#define SU ((float*)((float*)(ws + WS_SU)))
#define SV ((float*)((float*)(ws + WS_SV)))
__global__ void __launch_bounds__(NWAVES * 64, 2) fwd_kernel(Args args) {
    extern __shared__ __attribute__((aligned(16))) unsigned char lds_raw[];
    LAS unsigned char* lds = (LAS unsigned char*)lds_raw;
    const int tid = threadIdx.x, lane = tid & 63; const int wave = __builtin_amdgcn_readfirstlane(tid >> 6);
    const int G = gridDim.x; const int bx = blockIdx.x; const int vcu = (G % 8 == 0) ? (bx % 8) * (G / 8) + bx / 8 : bx;
    unsigned char* ws = args.ws;
    float* const out_base = args.out;
    for (int u = tid; u < (LDS_BYTES - MISC_OFF) / 4; u += NWAVES * 64) ((LAS unsigned*)(lds + MISC_OFF))[u] = 0u;
    __syncthreads();
    const int lo = args.ph_lo, hi = args.ph_hi;
    const bool use_bar = (hi - lo) > 1;
    XcdBarrier bar; bar.bar = (unsigned*)(ws + WS_CTL) + 1024; bar.x = 0; bar.st = nullptr;
    if (use_bar) bar = xcd_barrier_post((unsigned*)(ws + WS_CTL) + 1024, (volatile LAS unsigned*)(lds + MISC_OFF) + 8);
#ifdef ONLY_PHASE
#define PHASE_ON(k) ((k) == ONLY_PHASE)
#else
#define PHASE_ON(k) true
#endif
#define IN(k) (lo <= (k) && (k) < hi)
#ifdef REPEAT_PHASE
#define REP(k) for (int _rep = 0; _rep < (((k) == REPEAT_PHASE) ? 2 : 1); ++_rep)
#else
#define REP(k)
#endif
#define SEAM(k) do { if (IN(k) && IN((k) + 1)) xcd_barrier(bar); } while (0)
    const int gw = vcu * NWAVES + wave, NGW = G * NWAVES;

    REP(0) if (PHASE_ON(0) && IN(0)) {
        LAS float* scr = (LAS float*)(lds + wave * 8448);
        constexpr int I_IN = 32 * (IN_COLS / 32), I_XQ = 32 * 16;
        constexpr int NITEMS = I_IN + 2 * I_XQ;
        for (int it = gw; it < NITEMS; it += NGW) {
            int r = it;
            if (r < I_IN) { p0_transpose_item<true>(IN_w_in, IN_g_mix, DM, IN_COLS, WIN, 0, scr, r, lane); continue; } r -= I_IN;
            if (r < I_XQ) { p0_transpose_item<false>(IN_w_xk, IN_g_mem, DM, 512, WXKV, 0, scr, r, lane); continue; } r -= I_XQ;
            p0_transpose_item<false>(IN_w_xv, IN_g_mem, DM, 512, WXKV, 512, scr, r, lane);
        }
        for (int m = gw; m < T_TOK; m += 2 * NGW) row2_to_bf16(IN_x + (size_t)m * DM, XB + (size_t)m * DM, SS0 + m, (size_t)NGW, lane);
        for (int m = gw; m < MT; m += NGW) row_to_bf16(IN_mem + (size_t)m * DM, MEMB + (size_t)m * DM, SSM + m, lane);
        const int gt = vcu * (NWAVES * 64) + tid, NGT = G * NWAVES * 64;
        for (int i = gt; i < T_TOK * 128; i += NGT) { const int tok = i >> 7, f = i & 127; const float ang = (float)IN_positions[tok] * args.inv_freq[f]; float cc, sn; sincos_red(ang, cc, sn);
            COSR[i] = cc; SINR[i] = sn; }
        for (int i = gt; i < T_TOK * 32; i += NGT) { const int tok = i >> 5, f = i & 31; const float ang = (float)IN_positions[tok] * args.inv_freq[4 * f]; float cc, sn; sincos_red(ang, cc, sn);
            COSA[i] = cc; SINA[i] = sn; }
        for (int i = gt; i < T_TOK; i += NGT) { SS1[i] = 0.f; SS2[i] = 0.f; }
        __syncthreads();
    }
    SEAM(0);
    REP(1) if (PHASE_ON(1) && IN(1)) {
        pg8::Sched S; S.A = (const char*)XB; S.B = (const char*)WIN; S.nM = T_TOK / 256; S.nN = IN_COLS / 256; S.nwg = S.nM * S.nN;
        S.A2 = (const char*)MEMB; S.B2 = (const char*)WXKV; S.nM2 = MT / 256; S.nwg2 = (MT / 256) * 4; S.G = G; S.c = bx; S.WGM = WGM_P1; S.tstep = (size_t)256 * DM * 2;
        EpiP1 E{ws};
        pg8::gemm_phase<EpiP1>(lds, DM, S, E);
        unsigned* qctr = (unsigned*)(ws + WS_CTL) + 8192 + 64; volatile LAS unsigned* qw = (volatile LAS unsigned*)(lds + MISC_OFF) + 16;
        LAS float* scr = (LAS float*)(lds + wave * 8448);
        for (;;) {
            if (tid == 0) qw[0] = atomicAdd(qctr, 1u);
            __syncthreads(); const unsigned chunk = qw[0]; __syncthreads();
            if (chunk >= 640u + NF1) break;
            if (chunk < 640u) { int r = (int)chunk * 8 + wave;
                if (r < 2048) p0_transpose_item<false>(IN_w_out, nullptr, DM, DM, WOUT, 0, scr, r, lane);
                else if ((r -= 2048) < 512) p0_transpose_item<false>(IN_w_xq, IN_g_cross, DM, 512, WXQ, 0, scr, r, lane);
                else if ((r -= 512) < 512) p0_transpose_item<false>(IN_w_xo, nullptr, 512, DM, WXO, 0, scr, r, lane);
                else p0_transpose_item<false>(IN_w_pq, IN_g_ffn, DM, DM, WPQ, 0, scr, r - 512, lane);
            } else fp8_chunk((int)chunk - 640, wave, lane, IN_peer_u, IN_peer_v, IN_g_ffn, UB, VB, SU, SV);
        }
    }
    SEAM(1);
    REP(2) if (PHASE_ON(2) && IN(2)) {
#ifdef PROBE_RET_X
        for (int rr = 0; rr < PROBE_RET_X; ++rr)
#endif
        for (int u = vcu; u < 256; u += G) { const int bh = u >> 3, s = u & 7; ret_unit(lds, bh >> 2, bh & 3, s, QR, KR, VR, GR, IN_ret_gain, Y); ret_unit(lds, bh >> 2, bh & 3, 15 - s, QR, KR, VR, GR, IN_ret_gain, Y); }
#ifdef PROBE_SWA_X
        for (int rr = 0; rr < PROBE_SWA_X; ++rr)
#endif
        for (int u = vcu; u < 256; u += G) swa_unit(lds, u >> 5, (u >> 1) & 15, u & 1, QA, KA, VA, IN_sinks, IN_att_gain, Y);
    }
    SEAM(2);
    if (PHASE_ON(3) && IN(3)) {
        pg8::Sched S; S.A = (const char*)Y; S.B = (const char*)WOUT; S.WGM = WGM_P3; S.nM = T_TOK / 256; S.nN = DM / 256; S.nwg = S.nM * S.nN; S.A2 = nullptr; S.B2 = nullptr; S.nM2 = 1; S.nwg2 = 0; S.G = G; S.c = bx; S.tstep = (size_t)256 * DM * 2;
        EpiRes1 E{XB, SS1};
        pg8::gemm_phase<EpiRes1, false>(lds, DM, S, E);
    }
    SEAM(3);
    REP(4) if (PHASE_ON(4) && IN(4)) {
        pg8::Sched S; S.A = (const char*)XB; S.B = (const char*)WXQ; S.WGM = WGM_P4; S.nM = T_TOK / 256; S.nN = 2; S.nwg = S.nM * S.nN; S.A2 = nullptr; S.B2 = nullptr; S.nM2 = 1; S.nwg2 = 0; S.G = G; S.c = bx; S.tstep = (size_t)256 * DM * 2;
        EpiScale E{QX, 512, SS1, C3Q};
        pg8::gemm_phase<EpiScale>(lds, DM, S, E);
        unsigned* qctr = (unsigned*)(ws + WS_CTL) + 8192; volatile LAS unsigned* qw = (volatile LAS unsigned*)(lds + MISC_OFF) + 16;
        for (;;) {
            if (tid == 0) qw[0] = atomicAdd(qctr, 1u);
            __syncthreads(); const unsigned chunk = qw[0] + NF1; __syncthreads();
            if (chunk >= 2048u) break;
            fp8_chunk((int)chunk, wave, lane, IN_peer_u, IN_peer_v, IN_g_ffn, UB, VB, SU, SV);
        }
    }
    SEAM(4);
    REP(5) if (PHASE_ON(5) && IN(5)) { for (int u = vcu; u < 256; u += G) xattn_unit(lds, u >> 5, (u >> 3) & 3, u & 7, QX, KX, VX, OX); }
    SEAM(5);
    if (PHASE_ON(6) && IN(6)) {
        pg8::Sched S; S.A = (const char*)OX; S.B = (const char*)WXO; S.WGM = WGM_P6; S.nM = T_TOK / 256; S.nN = DM / 256; S.nwg = S.nM * S.nN; S.A2 = nullptr; S.B2 = nullptr; S.nM2 = 1; S.nwg2 = 0; S.G = G; S.c = bx; S.tstep = (size_t)256 * 512 * 2;
        EpiRes2 E{XB, SS2};
        pg8::gemm_phase<EpiRes2, false>(lds, 512, S, E);
    }
    SEAM(6);
    REP(7) if (PHASE_ON(7) && IN(7)) {
        pg8::Sched S; S.A = (const char*)XB; S.B = (const char*)WPQ; S.WGM = WGM_P7; S.nM = T_TOK / 256; S.nN = DM / 256; S.nwg = S.nM * S.nN; S.A2 = nullptr; S.B2 = nullptr; S.nM2 = 1; S.nwg2 = 0; S.G = G; S.c = bx; S.tstep = (size_t)256 * DM * 2;
        EpiScale E{PQ, DM, SS2, 1.f};
        pg8::gemm_phase<EpiScale>(lds, DM, S, E);
        asm volatile("s_waitcnt vmcnt(0)" ::: "memory"); __syncthreads();
        { pg8::Unit u; for (int i = 0; S.next(i, u); ++i) peer_topk_unit(lds, u.pm, u.pn, PQ, IN_subk, EXPI, GATE); }
    }
    SEAM(7);
    if (PHASE_ON(9) && IN(9)) {
        LAS float* gl = (LAS float*)(lds + 98304);
        for (int i = tid; i < DM; i += NWAVES * 64) { gl[i] = IN_g_ffn[i]; gl[DM + i] = IN_g_fin[i]; }
        __syncthreads();
        if (gw < T_TOK) peer_gather_wave(lds + wave * 12288, gl, gw, NGW, XB, UB, VB, SU, SV, EXPI, GATE, IN_out, lane);
    }
#undef IN
#undef SEAM
}

extern "C" void kernel_launch(void* const* d_in, const int* in_sizes, int n_in, void* d_out, int out_size, void* d_ws, size_t ws_size, hipStream_t stream) {
    static int grid = 0;
    if (grid == 0) {
        if (n_in != 21 || out_size != T_TOK * DM || ws_size < WS_END) { fprintf(stderr, "kernel_launch: unexpected problem (n_in %d out %d ws %zu)\n", n_in, out_size, ws_size); grid = -1; return; }
        int dev = 0, cus = 0;
        if (hipGetDevice(&dev) != hipSuccess || hipDeviceGetAttribute(&cus, hipDeviceAttributeMultiprocessorCount, dev) != hipSuccess) { grid = -1; return; }
        if (hipFuncSetAttribute((const void*)fwd_kernel, hipFuncAttributeMaxDynamicSharedMemorySize, LDS_BYTES) != hipSuccess) { fprintf(stderr, "kernel_launch: hipFuncSetAttribute failed\n"); grid = -1; return; }
        (void)hipGetLastError();
        grid = cus;
    }
    if (grid < 0) return;
    (void)hipMemsetAsync((char*)d_ws + WS_CTL, 0, CTL_ZERO_BYTES, stream);
    Args a{};
    for (int i = 0; i < 21; ++i) a.in[i] = d_in[i];
    a.out = (float*)d_out; a.ws = (unsigned char*)d_ws;
    for (int i = 0; i < 128; ++i) a.inv_freq[i] = (float)pow(10000.0, -(double)(2 * i) / 256.0);
#ifdef MK_PER_PHASE
    for (int p = 0; p < N_PHASES; ++p) { a.ph_lo = p; a.ph_hi = p + 1;
#ifdef REPEAT_LAUNCH
        if (p == REPEAT_LAUNCH) for (int r = 0; r < 4; ++r) hipLaunchKernelGGL(fwd_kernel, dim3(grid), dim3(NWAVES * 64), LDS_BYTES, stream, a);
#endif
        hipLaunchKernelGGL(fwd_kernel, dim3(grid), dim3(NWAVES * 64), LDS_BYTES, stream, a); }
#else
    a.ph_lo = 0; a.ph_hi = N_PHASES; hipLaunchKernelGGL(fwd_kernel, dim3(grid), dim3(NWAVES * 64), LDS_BYTES, stream, a);
#endif
}
```

```cpp
#include <hip/hip_runtime.h>
#include <cstdio>
#include <cstdint>
#include <cmath>
#ifndef WGM_P1
#define WGM_P1 4
#endif
#ifndef WGM_P3
#define WGM_P3 4
#endif
#ifndef WGM_P4
#define WGM_P4 4
#endif
#ifndef WGM_P6
#define WGM_P6 4
#endif
#ifndef WGM_P7
#define WGM_P7 4
#endif
namespace pg8 {
#define PG8_LAS __attribute__((address_space(3)))
typedef unsigned short bf16_t;
typedef short bf16x8 __attribute__((ext_vector_type(8)));
typedef float f32x4 __attribute__((ext_vector_type(4)));
typedef unsigned u32x4 __attribute__((ext_vector_type(4)));
typedef unsigned u32x2 __attribute__((ext_vector_type(2)));
constexpr int BM = 256, BK = 64, HALF = 128, HTB = HALF * BK * 2  , STAGE_BYTES = 8 * HTB, NXCD = 8;

__host__ __device__ __forceinline__ int lds_byte(int r, int c) { const int st = (r >> 4) * 2 + (c >> 5), rr = r & 15, cc = c & 31, ob = rr * 64 + cc * 2; return st * 1024 + (ob ^ (((ob >> 9) & 1) << 5)); }
__host__ __device__ __forceinline__ void stage_rc(int b, int& R, int& C) { const int st = b / 1024, sb = b % 1024, swz = sb ^ (((sb >> 9) & 1) << 5); R = (st >> 1) * 16 + swz / 64; C = (st & 1) * 32 + (swz % 64) / 2; }
__host__ __device__ __forceinline__ int perm32(int rho) { const int n = rho >> 4, i = rho & 15; return 8 * (i >> 2) + 4 * n + (i & 3); }

struct Unit { int pm, pn, kind; const char* a; const char* b; };

struct Sched {
    const char *A, *B, *A2, *B2; int nM, nN, nwg, nM2, nwg2, G, c, WGM; size_t tstep;
    __device__ __forceinline__ bool next(int i, Unit& u) const {
        const long L = (long)i * G + c;
        if (L < nwg) {
            int wgid = (int)L; { const int q = nwg / NXCD, r = nwg % NXCD, xcd = wgid % NXCD, off = wgid / NXCD; wgid = (xcd < r ? xcd * (q + 1) : r * (q + 1) + (xcd - r) * q) + off; }
            const int nig = WGM * nN, gid = wgid / nig, fm = gid * WGM, gsz = (nM - fm) < WGM ? (nM - fm) : WGM;
            u.pm = fm + ((wgid % nig) % gsz); u.pn = (wgid % nig) / gsz; u.kind = 0; u.a = A + (size_t)u.pm * tstep; u.b = B + (size_t)u.pn * tstep; return true;
        }
        const long L2 = L - nwg; if (L2 >= nwg2) return false;
        u.pm = (int)(L2 % nM2); u.pn = (int)(L2 / nM2); u.kind = 1; u.a = A2 + (size_t)u.pm * tstep; u.b = B2 + (size_t)u.pn * tstep; return true;
    }
};

__device__ __forceinline__ unsigned cvt_pk_bf16(float lo, float hi) { unsigned r; asm volatile("v_cvt_pk_bf16_f32 %0, %1, %2" : "=v"(r) : "v"(lo), "v"(hi)); return r; }

template <class Epi, bool ALIGN_EPI = true, bool SP2 = true>
__device__ __forceinline__ void gemm_phase(PG8_LAS unsigned char* lds, const int K, const Sched& S, const Epi& E) {
    const int tid = threadIdx.x, wid = __builtin_amdgcn_readfirstlane(tid >> 6), lane = tid & 63, wr = wid >> 2, wc = wid & 3, fr = lane & 15, fq = lane >> 4;
    const int nt = K / BK;
    unsigned voffA[2], voffB[2];
#pragma unroll
    for (int i = 0; i < 2; ++i) { int R, C; stage_rc(tid * 16 + i * 8192, R, C); const int Rb = Epi::PERM ? ((R & ~31) + perm32(R & 31)) : R;
        voffA[i] = (unsigned)(R * K + C) * 2u; voffB[i] = (unsigned)(Rb * K + C) * 2u; }
    const size_t kstep = (size_t)(BK * 2);
    const size_t hstep = (size_t)HALF * K * 2;
    const unsigned ldsw = (unsigned)wid * 1024u;
    const int aoff = lds_byte(wr * 64 + fr, fq * 8), boff = lds_byte(wc * 32 + fr, fq * 8);
#define PG8_SA(b, h) (((b) * 2 + (h)) * HTB)
#define PG8_SB(b, h) ((4 + (b) * 2 + (h)) * HTB)
#define PG8_STAGE(bufoff, gbase, voff) do { _Pragma("unroll") for (int _i = 0; _i < 2; ++_i) \
        __builtin_amdgcn_global_load_lds((const unsigned*)((const char*)(gbase) + (voff)[_i]), (PG8_LAS unsigned*)(lds + (bufoff) + ldsw + _i * 8192), 16, 0, 0); } while (0)
#define PG8_LDA(dst, b, h) do { _Pragma("unroll") for (int m = 0; m < 4; ++m) _Pragma("unroll") for (int k = 0; k < 2; ++k) dst[m][k] = *(const PG8_LAS bf16x8*)(lds + PG8_SA(b, h) + aoff + m * 2048 + k * 1024); } while (0)
#define PG8_LDB(dst, b, h) do { _Pragma("unroll") for (int n = 0; n < 2; ++n) _Pragma("unroll") for (int k = 0; k < 2; ++k) dst[n][k] = *(const PG8_LAS bf16x8*)(lds + PG8_SB(b, h) + boff + n * 2048 + k * 1024); } while (0)
#define PG8_MMA(ai, bj, At, Bt) do { __builtin_amdgcn_s_setprio(1); _Pragma("unroll") for (int m = 0; m < 4; ++m) _Pragma("unroll") for (int n = 0; n < 2; ++n) _Pragma("unroll") for (int k = 0; k < 2; ++k) \
        acc[ai][bj][m][n] = __builtin_amdgcn_mfma_f32_16x16x32_bf16(Bt[n][k], At[m][k], acc[ai][bj][m][n], 0, 0, 0); __builtin_amdgcn_s_setprio(0); } while (0)
#define PG8_WAIT_V(n) asm volatile("s_waitcnt vmcnt(" #n ")" ::: "memory")
#define PG8_WAIT_L(n) asm volatile("s_waitcnt lgkmcnt(" #n ")" ::: "memory")
#define PG8_BAR __builtin_amdgcn_s_barrier()
#define PG8_SCHED __builtin_amdgcn_sched_barrier(0)
    Unit cur, nxt; int ui = 0;
    if (!S.next(0, cur)) return;
    f32x4 acc[2][2][4][2];
#pragma unroll
    for (int a = 0; a < 2; ++a)
#pragma unroll
        for (int b = 0; b < 2; ++b)
#pragma unroll
            for (int m = 0; m < 4; ++m)
#pragma unroll
                for (int n = 0; n < 2; ++n) acc[a][b][m][n] = (f32x4){0.f, 0.f, 0.f, 0.f};
    bf16x8 At[4][2], B0[2][2], B1[2][2];
    const char* cA = cur.a; const char* cB = cur.b;
    if constexpr (SP2) {
        PG8_STAGE(PG8_SB(0, 0), cB, voffB); PG8_STAGE(PG8_SB(0, 1), cB + hstep, voffB); PG8_STAGE(PG8_SA(0, 0), cA, voffA); PG8_STAGE(PG8_SA(0, 1), cA + hstep, voffA);
        if (wr == 1) PG8_BAR;
        PG8_WAIT_V(2); PG8_BAR;
        PG8_STAGE(PG8_SB(1, 0), cB + kstep, voffB); PG8_STAGE(PG8_SA(1, 0), cA + kstep, voffA); PG8_STAGE(PG8_SB(1, 1), cB + hstep + kstep, voffB);
        PG8_WAIT_V(6); PG8_BAR;
    } else {
        PG8_STAGE(PG8_SB(0, 0), cB, voffB); PG8_STAGE(PG8_SA(0, 0), cA, voffA); PG8_STAGE(PG8_SB(0, 1), cB + hstep, voffB); PG8_STAGE(PG8_SA(0, 1), cA + hstep, voffA);
        if (wr == 1) PG8_BAR;
        PG8_WAIT_V(4); PG8_BAR;
        PG8_STAGE(PG8_SB(1, 0), cB + kstep, voffB); PG8_STAGE(PG8_SA(1, 0), cA + kstep, voffA); PG8_STAGE(PG8_SB(1, 1), cB + hstep + kstep, voffB);
        PG8_WAIT_V(6); PG8_BAR;
    }
    for (;;) {
        const bool has_next = S.next(ui + 1, nxt);
        const char* nA = has_next ? nxt.a : cA; const char* nB = has_next ? nxt.b : cB;
        for (int t = 0; t < nt; t += 2) {
            const bool last = (t == nt - 2);
            const char* a1 = cA + (size_t)(t + 1) * kstep;
            const char* a2 = last ? nA : cA + (size_t)(t + 2) * kstep; const char* b2 = last ? nB : cB + (size_t)(t + 2) * kstep;
            const char* a3 = a2 + kstep; const char* b3 = b2 + kstep;
            if constexpr (SP2) {
            PG8_LDB(B0, 0, 0); PG8_LDB(B1, 0, 1); PG8_SCHED; PG8_LDA(At, 0, 0); PG8_STAGE(PG8_SA(1, 1), a1 + hstep, voffA);
            PG8_WAIT_V(8); PG8_WAIT_L(0); PG8_BAR; PG8_MMA(0, 0, At, B0); PG8_MMA(0, 1, At, B1); PG8_BAR; PG8_SCHED;
            PG8_LDA(At, 0, 1); PG8_STAGE(PG8_SB(0, 0), b2, voffB); PG8_STAGE(PG8_SB(0, 1), b2 + hstep, voffB); PG8_STAGE(PG8_SA(0, 0), a2, voffA);
            PG8_WAIT_V(8); PG8_WAIT_L(0); PG8_BAR; PG8_MMA(1, 0, At, B0); PG8_MMA(1, 1, At, B1); PG8_BAR; PG8_SCHED;
            PG8_LDB(B0, 1, 0); PG8_LDB(B1, 1, 1); PG8_SCHED; PG8_LDA(At, 1, 0); PG8_STAGE(PG8_SA(0, 1), a2 + hstep, voffA);
            PG8_WAIT_V(8); PG8_WAIT_L(0); PG8_BAR; PG8_MMA(0, 0, At, B0); PG8_MMA(0, 1, At, B1); PG8_BAR; PG8_SCHED;
            PG8_LDA(At, 1, 1); PG8_STAGE(PG8_SB(1, 0), b3, voffB); PG8_STAGE(PG8_SB(1, 1), b3 + hstep, voffB); PG8_STAGE(PG8_SA(1, 0), a3, voffA);
            PG8_WAIT_V(8); PG8_WAIT_L(0); PG8_BAR; PG8_MMA(1, 0, At, B0); PG8_MMA(1, 1, At, B1); PG8_BAR; PG8_SCHED;
            } else {
            PG8_LDB(B0, 0, 0); PG8_SCHED; PG8_LDA(At, 0, 0); PG8_STAGE(PG8_SA(1, 1), a1 + hstep, voffA);
            PG8_WAIT_L(8); PG8_BAR; PG8_WAIT_L(0); PG8_MMA(0, 0, At, B0); PG8_BAR; PG8_SCHED;
            PG8_LDB(B1, 0, 1); PG8_STAGE(PG8_SB(0, 0), b2, voffB);
            PG8_BAR; PG8_WAIT_L(0); PG8_MMA(0, 1, At, B1); PG8_BAR;
            PG8_LDA(At, 0, 1); PG8_STAGE(PG8_SA(0, 0), a2, voffA);
            PG8_BAR; PG8_WAIT_L(0); PG8_MMA(1, 0, At, B0); PG8_BAR; PG8_SCHED;
            PG8_STAGE(PG8_SB(0, 1), b2 + hstep, voffB);
            PG8_WAIT_V(6); PG8_BAR; PG8_MMA(1, 1, At, B1); PG8_BAR;
            PG8_LDB(B0, 1, 0); PG8_SCHED; PG8_LDA(At, 1, 0); PG8_STAGE(PG8_SA(0, 1), a2 + hstep, voffA);
            PG8_WAIT_L(8); PG8_BAR; PG8_WAIT_L(0); PG8_MMA(0, 0, At, B0); PG8_BAR; PG8_SCHED;
            PG8_LDB(B1, 1, 1); PG8_STAGE(PG8_SB(1, 0), b3, voffB);
            PG8_BAR; PG8_WAIT_L(0); PG8_MMA(0, 1, At, B1); PG8_BAR;
            PG8_LDA(At, 1, 1); PG8_STAGE(PG8_SA(1, 0), a3, voffA);
            PG8_BAR; PG8_WAIT_L(0); PG8_MMA(1, 0, At, B0); PG8_BAR; PG8_SCHED;
            PG8_STAGE(PG8_SB(1, 1), b3 + hstep, voffB);
            PG8_WAIT_V(6); PG8_BAR; PG8_MMA(1, 1, At, B1); PG8_BAR;
            }
        }
        if constexpr (ALIGN_EPI) { if (wr == 0) PG8_BAR; }
        E(acc, cur, wr, wc, fr, fq);
        if (!has_next) break;
#pragma unroll
        for (int a = 0; a < 2; ++a)
#pragma unroll
            for (int b = 0; b < 2; ++b)
#pragma unroll
                for (int m = 0; m < 4; ++m)
#pragma unroll
                    for (int n = 0; n < 2; ++n) acc[a][b][m][n] = (f32x4){0.f, 0.f, 0.f, 0.f};
        cur = nxt; cA = nA; cB = nB; ++ui;
        if constexpr (ALIGN_EPI) { if (wr == 1) PG8_BAR; }
    }
    PG8_WAIT_V(0);
    if constexpr (!ALIGN_EPI) { if (wr == 0) PG8_BAR; }
    PG8_BAR;
#undef PG8_SA
#undef PG8_SB
#undef PG8_STAGE
#undef PG8_LDA
#undef PG8_LDB
#undef PG8_MMA
#undef PG8_WAIT_V
#undef PG8_WAIT_L
#undef PG8_BAR
#undef PG8_SCHED
}
}
constexpr int T_TOK = 16384, DM = 2048, SEQ = 2048, NBATCH = 8, MEML = 256, MT = NBATCH * MEML, IN_COLS = 5376;
constexpr float EPS = 1e-6f, GN_EPS = 1e-5f, LOG2E = 1.4426950408889634f;
constexpr float C2Q = 0.125f * LOG2E;
constexpr float C3Q = 0.08838834764831845f * LOG2E;
constexpr size_t MiB = 1u << 20;
constexpr size_t WS_CTL = 0, CTL_ZERO_BYTES = 64 * 1024;
constexpr size_t WS_WIN = 2 * MiB, WS_WOUT = 23 * MiB, WS_WXQ = 31 * MiB, WS_WXKV = 33 * MiB, WS_WXO = 37 * MiB, WS_WPQ = 39 * MiB;
constexpr size_t WS_XB = 48 * MiB, WS_MEMB = 112 * MiB;
constexpr size_t WS_COSA = 120 * MiB, WS_SINA = 122 * MiB, WS_COSR = 124 * MiB, WS_SINR = 132 * MiB;
constexpr size_t WS_SS0 = 140 * MiB, WS_SS1 = WS_SS0 + 65536, WS_SS2 = WS_SS1 + 65536, WS_SSM = WS_SS2 + 65536;
constexpr size_t WS_KX = 141 * MiB, WS_VX = 143 * MiB, WS_QX = 145 * MiB, WS_OX = 161 * MiB, WS_EXP = 177 * MiB, WS_GATE = 185 * MiB;
constexpr size_t WS_Y = 193 * MiB;
constexpr size_t WS_QA = 257 * MiB, WS_KA = 289 * MiB, WS_VA = 293 * MiB, WS_QR = 297 * MiB, WS_KR = 329 * MiB, WS_VR = 361 * MiB, WS_GR = 393 * MiB;
constexpr size_t WS_UB = 425 * MiB, WS_VB = 457 * MiB, WS_SU = 489 * MiB, WS_SV = WS_SU + 65536;
constexpr size_t WS_END = 490 * MiB;

#define GAS __attribute__((address_space(1)))
#define LAS __attribute__((address_space(3)))
typedef unsigned short bf16_t;
typedef short bf16x8 __attribute__((ext_vector_type(8)));
typedef short v4i16 __attribute__((ext_vector_type(4)));
typedef float f32x4 __attribute__((ext_vector_type(4)));
typedef float f32x2 __attribute__((ext_vector_type(2)));
typedef unsigned u32x4 __attribute__((ext_vector_type(4)));
typedef unsigned u32x2 __attribute__((ext_vector_type(2)));
typedef __bf16 bf16x2_t __attribute__((ext_vector_type(2)));

__device__ __forceinline__ unsigned pk2(float lo, float hi) { f32x2 v = {lo, hi}; bf16x2_t b = __builtin_convertvector(v, bf16x2_t); return __builtin_bit_cast(unsigned, b); }
__device__ __forceinline__ float bf_lo(unsigned w) { return __uint_as_float(w << 16); }
__device__ __forceinline__ float bf_hi(unsigned w) { return __uint_as_float(w & 0xffff0000u); }
__device__ __forceinline__ float wave_sum(float v) {
#pragma unroll
    for (int o = 1; o < 64; o <<= 1) v += __shfl_xor(v, o);
    return v;
}

struct EpiP1 {
    static constexpr bool PERM = true;
    unsigned char* ws;
    __device__ __forceinline__ void operator()(const pg8::f32x4 (&acc)[2][2][4][2], const pg8::Unit& u, int wr, int wc, int fr, int fq) const {
        if (u.kind == 1) {
            const float* ssm = (const float*)(ws + WS_SSM);
            bf16_t* O = (bf16_t*)(ws + ((u.pn < 2) ? WS_KX : WS_VX)); const int cb = (u.pn & 1) * 256 + wc * 32 + 8 * fq;
#pragma unroll
            for (int ai = 0; ai < 2; ++ai)
#pragma unroll
                for (int m = 0; m < 4; ++m) { const int row = u.pm * 256 + ai * 128 + wr * 64 + m * 16 + fr; const float rs = rsqrtf(ssm[row] * (1.f / DM) + EPS);
#pragma unroll
                    for (int bj = 0; bj < 2; ++bj) { const f32x4 v0 = acc[ai][bj][m][0] * rs, v1 = acc[ai][bj][m][1] * rs;
                        u32x4 w; w.x = pk2(v0[0], v0[1]); w.y = pk2(v0[2], v0[3]); w.z = pk2(v1[0], v1[1]); w.w = pk2(v1[2], v1[3]);
                        *(u32x4*)(O + (size_t)row * 512 + cb + bj * 128) = w; } }
            return;
        }
        const float* ss0 = (const float*)(ws + WS_SS0);
        const int pn = u.pn;
        size_t ooff, ctoff, stoff; int pitch, colbase, i0, half, tw; float sc, zl = 0.f; bool rope;
        if (pn < 4)        { ooff = WS_QA; pitch = 1024; colbase = (4 * pn + wc) * 64; i0 = 8 * fq; half = 32; tw = 32; ctoff = WS_COSA; stoff = WS_SINA; sc = C2Q; rope = true; }
        else if (pn == 4)  { if (wc < 2) { ooff = WS_KA; colbase = wc * 64; rope = true; } else { ooff = WS_VA; colbase = (wc - 2) * 64; rope = false; }
                             pitch = 128; i0 = 8 * fq; half = 32; tw = 32; ctoff = WS_COSA; stoff = WS_SINA; sc = 1.f; }
        else { const int q = (pn - 5) >> 2, h = (pn - 5) & 3; ooff = WS_QR + (size_t)q * (32 * MiB); pitch = 1024; colbase = h * 256; i0 = 32 * wc + 8 * fq; half = 128; tw = 128; ctoff = WS_COSR; stoff = WS_SINR;
               sc = (q == 1) ? 0.0625f : 1.f; rope = (q < 2); if (q == 1) zl = log2f(1.f - exp2f(-5.f - (float)h)); }
        bf16_t* O = (bf16_t*)(ws + ooff); const float* ct = (const float*)(ws + ctoff); const float* st = (const float*)(ws + stoff);
#pragma unroll
        for (int ai = 0; ai < 2; ++ai)
#pragma unroll
            for (int m = 0; m < 4; ++m) { const int row = u.pm * 256 + ai * 128 + wr * 64 + m * 16 + fr; const float rs = rsqrtf(ss0[row] * (1.f / DM) + EPS) * sc * __builtin_amdgcn_exp2f((float)(127 - (row & 127)) * zl);
                f32x4 a0 = acc[ai][0][m][0] * rs, a1 = acc[ai][0][m][1] * rs, b0 = acc[ai][1][m][0] * rs, b1 = acc[ai][1][m][1] * rs;
                if (rope) { const f32x4 c0 = *(const f32x4*)(ct + (size_t)row * tw + i0), c1 = *(const f32x4*)(ct + (size_t)row * tw + i0 + 4);
                            const f32x4 s0 = *(const f32x4*)(st + (size_t)row * tw + i0), s1 = *(const f32x4*)(st + (size_t)row * tw + i0 + 4);
                            const f32x4 o0 = a0 * c0 - b0 * s0, o1 = a1 * c1 - b1 * s1, p0 = b0 * c0 + a0 * s0, p1 = b1 * c1 + a1 * s1; a0 = o0; a1 = o1; b0 = p0; b1 = p1; }
                bf16_t* rp = O + (size_t)row * pitch + colbase + i0;
                u32x4 w; w.x = pk2(a0[0], a0[1]); w.y = pk2(a0[2], a0[3]); w.z = pk2(a1[0], a1[1]); w.w = pk2(a1[2], a1[3]); *(u32x4*)rp = w;
                w.x = pk2(b0[0], b0[1]); w.y = pk2(b0[2], b0[3]); w.z = pk2(b1[0], b1[1]); w.w = pk2(b1[2], b1[3]); *(u32x4*)(rp + half) = w; }
    }
};
struct EpiRes1 {
    static constexpr bool PERM = true;
    bf16_t* XB; float* ss;
    __device__ __forceinline__ void operator()(const pg8::f32x4 (&acc)[2][2][4][2], const pg8::Unit& u, int wr, int wc, int fr, int fq) const {
        const int col0 = u.pn * 256 + wc * 32 + 8 * fq;
#pragma unroll
        for (int ai = 0; ai < 2; ++ai) {
            u32x4 r[4][2];
#pragma unroll
            for (int m = 0; m < 4; ++m) { const size_t off = (size_t)(u.pm * 256 + ai * 128 + wr * 64 + m * 16 + fr) * DM + col0;
#pragma unroll
                for (int bj = 0; bj < 2; ++bj) r[m][bj] = *(const u32x4*)(XB + off + bj * 128); }
#pragma unroll
            for (int m = 0; m < 4; ++m) { const int row = u.pm * 256 + ai * 128 + wr * 64 + m * 16 + fr; const size_t off = (size_t)row * DM + col0; float s = 0.f;
#pragma unroll
                for (int bj = 0; bj < 2; ++bj) { const size_t o = off + bj * 128;
                    const u32x4 q = r[m][bj];
                    const f32x4 v0 = (f32x4){bf_lo(q.x), bf_hi(q.x), bf_lo(q.y), bf_hi(q.y)} + acc[ai][bj][m][0], v1 = (f32x4){bf_lo(q.z), bf_hi(q.z), bf_lo(q.w), bf_hi(q.w)} + acc[ai][bj][m][1];
                    u32x4 w; w.x = pk2(v0[0], v0[1]); w.y = pk2(v0[2], v0[3]); w.z = pk2(v1[0], v1[1]); w.w = pk2(v1[2], v1[3]); *(u32x4*)(XB + o) = w;
                    s += ((v0[0] * v0[0] + v0[1] * v0[1]) + (v0[2] * v0[2] + v0[3] * v0[3])) + ((v1[0] * v1[0] + v1[1] * v1[1]) + (v1[2] * v1[2] + v1[3] * v1[3])); }
                s += __shfl_xor(s, 16); s += __shfl_xor(s, 32);
                if (fq == 0) atomicAdd(ss + row, s); }
            asm volatile("" ::: "memory");
        }
    }
};
struct EpiRes2 {
    static constexpr bool PERM = true;
    bf16_t* XB; float* ss;
    __device__ __forceinline__ void operator()(const pg8::f32x4 (&acc)[2][2][4][2], const pg8::Unit& u, int wr, int wc, int fr, int fq) const {
        const int col0 = u.pn * 256 + wc * 32 + 8 * fq;
        u32x4 r[2][4][2];
#pragma unroll
        for (int ai = 0; ai < 2; ++ai)
#pragma unroll
            for (int m = 0; m < 4; ++m) { const size_t off = (size_t)(u.pm * 256 + ai * 128 + wr * 64 + m * 16 + fr) * DM + col0;
#pragma unroll
                for (int bj = 0; bj < 2; ++bj) r[ai][m][bj] = *(const u32x4*)(XB + off + bj * 128); }
#pragma unroll
        for (int ai = 0; ai < 2; ++ai)
#pragma unroll
            for (int m = 0; m < 4; ++m) { const int row = u.pm * 256 + ai * 128 + wr * 64 + m * 16 + fr; const size_t off = (size_t)row * DM + col0; float s = 0.f;
#pragma unroll
                for (int bj = 0; bj < 2; ++bj) { const size_t o = off + bj * 128; const u32x4 q = r[ai][m][bj];
                    const f32x4 v0 = (f32x4){bf_lo(q.x), bf_hi(q.x), bf_lo(q.y), bf_hi(q.y)} + acc[ai][bj][m][0], v1 = (f32x4){bf_lo(q.z), bf_hi(q.z), bf_lo(q.w), bf_hi(q.w)} + acc[ai][bj][m][1];
                    u32x4 w; w.x = pk2(v0[0], v0[1]); w.y = pk2(v0[2], v0[3]); w.z = pk2(v1[0], v1[1]); w.w = pk2(v1[2], v1[3]); *(u32x4*)(XB + o) = w;
                    s += ((v0[0] * v0[0] + v0[1] * v0[1]) + (v0[2] * v0[2] + v0[3] * v0[3])) + ((v1[0] * v1[0] + v1[1] * v1[1]) + (v1[2] * v1[2] + v1[3] * v1[3])); }
                s += __shfl_xor(s, 16); s += __shfl_xor(s, 32);
                if (fq == 0) atomicAdd(ss + row, s); }
    }
};
struct EpiScale {
    static constexpr bool PERM = true;
    bf16_t* O; int ldc; const float* ss; float scale;
    __device__ __forceinline__ void operator()(const pg8::f32x4 (&acc)[2][2][4][2], const pg8::Unit& u, int wr, int wc, int fr, int fq) const {
        const int col0 = u.pn * 256 + wc * 32 + 8 * fq;
#pragma unroll
        for (int ai = 0; ai < 2; ++ai)
#pragma unroll
            for (int m = 0; m < 4; ++m) { const int row = u.pm * 256 + ai * 128 + wr * 64 + m * 16 + fr; const float rs = rsqrtf(ss[row] * (1.f / DM) + EPS) * scale;
#pragma unroll
                for (int bj = 0; bj < 2; ++bj) { const f32x4 v0 = acc[ai][bj][m][0] * rs, v1 = acc[ai][bj][m][1] * rs;
                    u32x4 w; w.x = pk2(v0[0], v0[1]); w.y = pk2(v0[2], v0[3]); w.z = pk2(v1[0], v1[1]); w.w = pk2(v1[2], v1[3]);
                    *(u32x4*)(O + (size_t)row * ldc + col0 + bj * 128) = w; } }
    }
};
#define XB_TMO      128
#define XB_XCNT(j)  (256  + 64 * (j))
#define XB_XSUB(j)  (1280 + 64 * (j))
#define XB_XGEN(j)  (2304 + 64 * (j))
#define XB_TOP      3328
#define XB_TOPGEN   3392
#define XCD_BAR_WORDS 3456
#define XB_SPIN_CAP (1u << 18)
__device__ __forceinline__ unsigned xb_ld(unsigned* p)              { return __hip_atomic_load(p, __ATOMIC_RELAXED, __HIP_MEMORY_SCOPE_AGENT); }
__device__ __forceinline__ unsigned xb_add(unsigned* p, unsigned v) { return __hip_atomic_fetch_add(p, v, __ATOMIC_RELAXED, __HIP_MEMORY_SCOPE_AGENT); }
__device__ __forceinline__ unsigned xb_xcc_id() { return (unsigned)__builtin_amdgcn_s_getreg((3 << 11) | 20) & 0xFu; }
#define XB_SPIN(cond, bar) do { unsigned _sp = 0; while (cond) { __builtin_amdgcn_s_sleep(1); \
    if ((++_sp & 255u) == 0u) { if (xb_ld(&(bar)[XB_TMO])) break; if (_sp > XB_SPIN_CAP) { atomicAdd(&(bar)[XB_TMO], 1u); break; } } } } while (0)
struct XcdBarrier { unsigned* bar; unsigned x; volatile LAS unsigned* st; };
__device__ __forceinline__ XcdBarrier xcd_barrier_post(unsigned* bar, volatile LAS unsigned* st) {
    XcdBarrier b; b.bar = bar; b.x = xb_xcc_id(); b.st = st;
    if (threadIdx.x == 0) (void)xb_add(&bar[XB_XCNT(b.x)], 1u);
    return b;
}
__device__ __forceinline__ void xcd_barrier_complete(unsigned* bar, unsigned x, unsigned& nloc, unsigned& nx) {
    const unsigned G = gridDim.x * gridDim.y * gridDim.z;
    unsigned sum, cnt, mine, sp = 0u;
    for (;;) {
        sum = 0u; cnt = 0u; mine = 0u;
#pragma unroll
        for (unsigned j = 0; j < 16; ++j) { const unsigned c = xb_ld(&bar[XB_XCNT(j)]); sum += c; cnt += (c > 0u) ? 1u : 0u; mine = (j == x) ? c : mine; }
        if (sum == G) break;
        __builtin_amdgcn_s_sleep(1);
        if ((++sp & 255u) == 0u) { if (xb_ld(&bar[XB_TMO])) break; if (sp > XB_SPIN_CAP) { atomicAdd(&bar[XB_TMO], 1u); break; } }
    }
    nloc = mine > 0u ? mine : 1u; nx = cnt > 0u ? cnt : 1u;
}
__device__ __forceinline__ void xcd_barrier(const XcdBarrier& b) {
    asm volatile("s_waitcnt vmcnt(0)" ::: "memory");
    __syncthreads();
    if (threadIdx.x == 0) {
        unsigned* bar = b.bar;
        __builtin_amdgcn_s_waitcnt(0);
        unsigned nloc = b.st[0], nx = b.st[1];
        if (nloc == 0u) { xcd_barrier_complete(bar, b.x, nloc, nx); b.st[0] = nloc; b.st[1] = nx; }
        const unsigned old = xb_add(&bar[XB_XSUB(b.x)], 1u);
        const unsigned gen = old / nloc;
        if (old + 1u == (gen + 1u) * nloc) {
            __builtin_amdgcn_fence(__ATOMIC_RELEASE, "agent");
            asm volatile("s_waitcnt vmcnt(0)" ::: "memory");
            const unsigned og = xb_add(&bar[XB_TOP], 1u);
            const unsigned tg = og / nx;
            if (og + 1u == (tg + 1u) * nx) xb_add(&bar[XB_TOPGEN], 1u);
            else XB_SPIN(xb_ld(&bar[XB_TOPGEN]) == tg, bar);
            __builtin_amdgcn_fence(__ATOMIC_ACQUIRE, "agent");
            xb_add(&bar[XB_XGEN(b.x)], 1u);
            asm volatile("s_waitcnt vmcnt(0)" ::: "memory");
        } else {
            XB_SPIN(xb_ld(&bar[XB_XGEN(b.x)]) == gen, bar);
            __builtin_amdgcn_fence(__ATOMIC_ACQUIRE, "agent");
            asm volatile("s_waitcnt vmcnt(0)" ::: "memory");
        }
    }
    __syncthreads();
}

__device__ __forceinline__ int win_phys(int n) {
    if (n < 1024) { const int head = n >> 6, d = n & 63; return (head >> 2) * 256 + (d >> 5) * 128 + (head & 3) * 32 + (d & 31); }
    if (n < 1280) { const int m = n - 1024, kind = m >> 7, hh = (m & 127) >> 6, d = m & 63; return 1024 + (d >> 5) * 128 + (kind * 2 + hh) * 32 + (d & 31); }
    return n;
}
template <bool PERMW>
__device__ __forceinline__ void p0_transpose_item(const float* W, const float* gk, int K, int N, bf16_t* WT, int row_off, LAS float* scr, int item, int lane) {
    const int nblk = N / 32, kb = item / nblk, nb = item % nblk, k0 = 64 * kb, n0 = 32 * nb;
    float wv[32];
#pragma unroll
    for (int i = 0; i < 32; ++i) { const int kk = 2 * i + (lane >> 5); wv[i] = W[(size_t)(k0 + kk) * N + n0 + (lane & 31)]; }
#pragma unroll
    for (int i = 0; i < 32; ++i) { const int kk = 2 * i + (lane >> 5); const float g = gk ? gk[k0 + kk] : 1.f; scr[kk * 33 + (lane & 31)] = wv[i] * g; }
    asm volatile("s_waitcnt lgkmcnt(0)" ::: "memory");
    const int c = lane & 7; const int pr0 = PERMW ? win_phys(n0) : n0;
#pragma unroll
    for (int j = 0; j < 4; ++j) { const int n = (lane >> 3) + 8 * j; const LAS float* s = scr + (8 * c) * 33 + n;
        u32x4 o; o.x = pk2(s[0 * 33], s[1 * 33]); o.y = pk2(s[2 * 33], s[3 * 33]); o.z = pk2(s[4 * 33], s[5 * 33]); o.w = pk2(s[6 * 33], s[7 * 33]);
        *(u32x4*)(WT + (size_t)(row_off + pr0 + n) * K + k0 + 8 * c) = o; }
    asm volatile("s_waitcnt lgkmcnt(0)" ::: "memory");
}
__device__ __forceinline__ void row_to_bf16(const float* xrow, bf16_t* orow, float* ssq, int lane) {
    const f32x4* xr = (const f32x4*)xrow + lane; f32x4 v[8]; float s = 0.f;
#pragma unroll
    for (int j = 0; j < 8; ++j) { v[j] = xr[64 * j]; s += (v[j][0] * v[j][0] + v[j][1] * v[j][1]) + (v[j][2] * v[j][2] + v[j][3] * v[j][3]); }
    s = wave_sum(s);
    u32x2* o8 = (u32x2*)orow + lane;
#pragma unroll
    for (int j = 0; j < 8; ++j) { u32x2 w; w.x = pk2(v[j][0], v[j][1]); w.y = pk2(v[j][2], v[j][3]); o8[64 * j] = w; }
    if (lane == 0) *ssq = s;
}
__device__ __forceinline__ void row2_to_bf16(const float* xrow, bf16_t* orow, float* ssq, size_t rstep, int lane) {
    const f32x4* xr0 = (const f32x4*)xrow + lane; const f32x4* xr1 = (const f32x4*)(xrow + rstep * DM) + lane; f32x4 v[8], q[8]; float s0 = 0.f, s1 = 0.f;
#pragma unroll
    for (int j = 0; j < 8; ++j) { v[j] = xr0[64 * j]; q[j] = xr1[64 * j]; }
#pragma unroll
    for (int j = 0; j < 8; ++j) { s0 += (v[j][0] * v[j][0] + v[j][1] * v[j][1]) + (v[j][2] * v[j][2] + v[j][3] * v[j][3]); s1 += (q[j][0] * q[j][0] + q[j][1] * q[j][1]) + (q[j][2] * q[j][2] + q[j][3] * q[j][3]); }
    s0 = wave_sum(s0); s1 = wave_sum(s1);
    u32x2* o0 = (u32x2*)orow + lane; u32x2* o1 = (u32x2*)(orow + rstep * DM) + lane;
#pragma unroll
    for (int j = 0; j < 8; ++j) { u32x2 w; w.x = pk2(v[j][0], v[j][1]); w.y = pk2(v[j][2], v[j][3]); o0[64 * j] = w; w.x = pk2(q[j][0], q[j][1]); w.y = pk2(q[j][2], q[j][3]); o1[64 * j] = w; }
    if (lane == 0) { ssq[0] = s0; ssq[rstep] = s1; }
}
__device__ __forceinline__ void sincos_red(float ang, float& c, float& s) {
    const float k = rintf(ang * 0.15915494309189535f);
    float r = fmaf(-k, 6.28125f, ang); r = fmaf(-k, 1.9353071795864769e-3f, r);
    const float rev = r * 0.15915494309189535f;
    s = __builtin_amdgcn_sinf(rev); c = __builtin_amdgcn_cosf(rev);
}

#define MFMA16(a, b, c) __builtin_amdgcn_mfma_f32_16x16x32_bf16((a), (b), (c), 0, 0, 0)
__device__ __forceinline__ bf16x8 pack_p(const f32x4& lo, const f32x4& hi) {
    u32x4 w; w.x = pk2(lo[0], lo[1]); w.y = pk2(lo[2], lo[3]); w.z = pk2(hi[0], hi[1]); w.w = pk2(hi[2], hi[3]); return __builtin_bit_cast(bf16x8, w);
}
__device__ __forceinline__ bf16x8 vt_frag(LAS const unsigned char* p, int stride16) {
    const v4i16 lo = __builtin_amdgcn_ds_read_tr16_b64_v4i16((LAS v4i16*)p);
    const v4i16 hi = __builtin_amdgcn_ds_read_tr16_b64_v4i16((LAS v4i16*)(p + stride16));
    return (bf16x8){lo[0], lo[1], lo[2], lo[3], hi[0], hi[1], hi[2], hi[3]};
}

__device__ __forceinline__ void swa_unit(LAS unsigned char* lds, int b, int n, int kvh, const bf16_t* QA, const bf16_t* KA, const bf16_t* VA,
                                         const float* sinks, const float* att_gain, bf16_t* Y) {
    constexpr int KS = 144;
    const int tid = threadIdx.x, lane = tid & 63, c = lane & 15, g = lane >> 4; const int w = __builtin_amdgcn_readfirstlane(tid >> 6);
    LAS unsigned char* Kl = lds; LAS unsigned char* Vl = lds + 256 * KS;
    for (int i = tid; i < 2048; i += 512) { const int key = i >> 3, ch = i & 7, pos = 128 * (n - 1) + key; u32x4 kv = {0u, 0u, 0u, 0u}, vv = {0u, 0u, 0u, 0u};
        if (pos >= 0) { const size_t off = (size_t)(b * SEQ + pos) * 128 + kvh * 64 + ch * 8; kv = *(const u32x4*)(KA + off); vv = *(const u32x4*)(VA + off); }
        *(LAS u32x4*)(Kl + key * KS + ch * 16) = kv; *(LAS u32x4*)(Vl + key * KS + ch * 16) = vv; }
    __syncthreads();
    const int hq = kvh * 8 + w; const float sink = sinks[hq] * LOG2E;
    bf16x8 qn[2];
#pragma unroll
    for (int ks = 0; ks < 2; ++ks) qn[ks] = *(const bf16x8*)(QA + (size_t)(b * SEQ + 128 * n + c) * 1024 + hq * 64 + ks * 32 + 8 * g);
    for (int a = 0; a < 8; ++a) {
        const int t = b * SEQ + 128 * n + 16 * a + c; const int kb0 = (a & ~1) * 16; const int qi = 128 + 16 * a + c;
        bf16x8 qf[2];
#pragma unroll
        for (int ks = 0; ks < 2; ++ks) { qf[ks] = qn[ks]; qn[ks] = *(const bf16x8*)(QA + (size_t)(t + (a < 7 ? 16 : 0)) * 1024 + hq * 64 + ks * 32 + 8 * g); }
        f32x4 s[10]; float m = sink;
#pragma unroll
        for (int blk = 0; blk < 10; ++blk) { const int key0 = kb0 + 16 * blk; f32x4 acc = {0.f, 0.f, 0.f, 0.f};
#pragma unroll
            for (int ks = 0; ks < 2; ++ks) { const bf16x8 kf = *(LAS const bf16x8*)(Kl + (key0 + c) * KS + (ks * 32 + 8 * g) * 2); acc = MFMA16(kf, qf[ks], acc); }
#pragma unroll
            for (int r = 0; r < 4; ++r) { const int j = key0 + 4 * g + r; const bool ok = (j <= qi) && (j > qi - 128) && (n > 0 || j >= 128);
                acc[r] = ok ? acc[r] : -INFINITY; m = fmaxf(m, acc[r]); }
            s[blk] = acc; }
        m = fmaxf(m, __shfl_xor(m, 16)); m = fmaxf(m, __shfl_xor(m, 32));
        float l = 0.f;
#pragma unroll
        for (int blk = 0; blk < 10; ++blk)
#pragma unroll
            for (int r = 0; r < 4; ++r) { const float p = __builtin_amdgcn_exp2f(s[blk][r] - m); s[blk][r] = p; l += p; }
        l += __shfl_xor(l, 16); l += __shfl_xor(l, 32); l += __builtin_amdgcn_exp2f(sink - m);
        f32x4 o[4];
#pragma unroll
        for (int db = 0; db < 4; ++db) o[db] = (f32x4){0.f, 0.f, 0.f, 0.f};
#pragma unroll
        for (int kp = 0; kp < 5; ++kp) { const bf16x8 pf = pack_p(s[2 * kp], s[2 * kp + 1]); const int key0 = kb0 + 32 * kp;
#pragma unroll
            for (int db = 0; db < 4; ++db) { const bf16x8 af = vt_frag(Vl + (key0 + 4 * g + (c >> 2)) * KS + (16 * db + 4 * (c & 3)) * 2, 16 * KS); o[db] = MFMA16(af, pf, o[db]); } }
        const float inv = 1.f / l; float q2 = 0.f;
#pragma unroll
        for (int db = 0; db < 4; ++db) { o[db] = o[db] * inv; q2 += (o[db][0] * o[db][0] + o[db][1] * o[db][1]) + (o[db][2] * o[db][2] + o[db][3] * o[db][3]); }
        q2 += __shfl_xor(q2, 16); q2 += __shfl_xor(q2, 32);
        const float rms = rsqrtf(q2 * (1.f / 64.f) + EPS);
#pragma unroll
        for (int db = 0; db < 4; ++db) { const int col = hq * 64 + 16 * db + 4 * g; const f32x4 gn = *(const f32x4*)(att_gain + col); const f32x4 v = o[db] * rms * gn;
            u32x2 wv; wv.x = pk2(v[0], v[1]); wv.y = pk2(v[2], v[3]); *(u32x2*)(Y + (size_t)t * DM + col) = wv; }
    }
    __syncthreads();
}

__device__ __forceinline__ bf16_t* ret_state_base(unsigned char* ws, int bh) {
    return (bf16_t*)(ws + ((bh < 25) ? WS_QX + (size_t)bh * 1966080 : WS_MEMB + (size_t)(bh - 25) * 1966080));
}
__device__ __forceinline__ void ret_state_unit(LAS unsigned char* lds, int bh, int dr, const bf16_t* KR, const bf16_t* VR, bf16_t* ST) {
    constexpr int RS = 544, TB = 64 * RS, KSS = 80, BUFB = 2 * TB + 128 * KSS;
    int tid_ = threadIdx.x; asm volatile("" : "+v"(tid_));
    const int tid = tid_, lane = tid & 63, c = lane & 15, g = lane >> 4; const int w = __builtin_amdgcn_readfirstlane(tid >> 6);
    const int b = bh >> 2, h = bh & 3; const size_t rowb = (size_t)b * SEQ; const int hoff = h * 256;
    const float g128 = exp2f(128.f * log2f(1.f - exp2f(-5.f - (float)h)));
    u32x4 vA[8], kA, vB[8], kB;
#define ST_LOAD(V, K, m) do { const int m_ = ((m) < 15) ? (m) : 14; _Pragma("unroll") for (int i = 0; i < 8; ++i) { const int id = tid + 512 * i, key = id >> 5, ch = id & 31; \
            V[i] = *(const u32x4*)(VR + (rowb + 128 * m_ + key) * 1024 + hoff + ch * 8); } \
        K = *(const u32x4*)(KR + (rowb + 128 * m_ + (tid >> 2)) * 1024 + hoff + 32 * dr + (tid & 3) * 8); } while (0)
#define ST_WRITE(V, K, buf) do { LAS unsigned char* B_ = lds + (buf) * BUFB; _Pragma("unroll") for (int i = 0; i < 8; ++i) { const int id = tid + 512 * i, key = id >> 5, ch = id & 31; \
            *(LAS u32x4*)(B_ + (key >> 6) * TB + (key & 63) * RS + ch * 16) = V[i]; } \
        *(LAS u32x4*)(B_ + 2 * TB + (tid >> 2) * KSS + (tid & 3) * 16) = K; } while (0)
    f32x4 acc[2][2];
#pragma unroll
    for (int i = 0; i < 2; ++i)
#pragma unroll
        for (int j = 0; j < 2; ++j) acc[i][j] = (f32x4){0.f, 0.f, 0.f, 0.f};
#define ST_COMPUTE(m, buf) do { LAS const unsigned char* B_ = lds + (buf) * BUFB; \
        _Pragma("unroll") for (int kp = 0; kp < 4; ++kp) { bf16x8 af[2], bfr[2]; \
            _Pragma("unroll") for (int rb = 0; rb < 2; ++rb) af[rb] = vt_frag(B_ + 2 * TB + (32 * kp + 4 * g + (c >> 2)) * KSS + (16 * rb + 4 * (c & 3)) * 2, 16 * KSS); \
            _Pragma("unroll") for (int j = 0; j < 2; ++j) bfr[j] = vt_frag(B_ + (kp >> 1) * TB + (32 * (kp & 1) + 4 * g + (c >> 2)) * RS + (16 * (2 * w + j) + 4 * (c & 3)) * 2, 16 * RS); \
            _Pragma("unroll") for (int rb = 0; rb < 2; ++rb) _Pragma("unroll") for (int j = 0; j < 2; ++j) acc[rb][j] = MFMA16(af[rb], bfr[j], acc[rb][j]); } \
        _Pragma("unroll") for (int rb = 0; rb < 2; ++rb) _Pragma("unroll") for (int j = 0; j < 2; ++j) { acc[rb][j] = acc[rb][j] * g128; \
            u32x2 o_; o_.x = pk2(acc[rb][j][0], acc[rb][j][1]); o_.y = pk2(acc[rb][j][2], acc[rb][j][3]); \
            *(u32x2*)(ST + (size_t)(m) * 65536 + (16 * (2 * w + j) + c) * 256 + 32 * dr + 16 * rb + 4 * g) = o_; } } while (0)
    ST_LOAD(vA, kA, 0); ST_LOAD(vB, kB, 1);
    ST_WRITE(vA, kA, 0); ST_LOAD(vA, kA, 2);
    __syncthreads();
#pragma unroll 1
    for (int m = 0; m < 15; m += 2) {
        ST_COMPUTE(m, 0);
        ST_WRITE(vB, kB, 1); ST_LOAD(vB, kB, m + 3);
        __syncthreads();
        if (m + 1 < 15) ST_COMPUTE(m + 1, 1);
        ST_WRITE(vA, kA, 0); ST_LOAD(vA, kA, m + 4);
        __syncthreads();
    }
#undef ST_LOAD
#undef ST_WRITE
#undef ST_COMPUTE
}
__device__ __forceinline__ void ret_chunk_unit(LAS unsigned char* lds, int b, int h, int n, const bf16_t* QR, const bf16_t* KR, const bf16_t* VR, const bf16_t* GR, const bf16_t* ST,
                                               const float* ret_gain, bf16_t* Y) {
    constexpr int RS = 544, TB = 64 * RS;
    int tid_ = threadIdx.x; asm volatile("" : "+v"(tid_));
    const int tid = tid_, lane = tid & 63, c = lane & 15, g = lane >> 4; const int w = __builtin_amdgcn_readfirstlane(tid >> 6);
    const size_t rowb = (size_t)b * SEQ; const int hoff = h * 256;
    const int ql = 16 * w + c; const size_t t = rowb + 128 * n + ql;
    const float lg = log2f(1.f - exp2f(-5.f - (float)h));
    bf16x8 qf[8];
#pragma unroll
    for (int ks = 0; ks < 8; ++ks) qf[ks] = *(const bf16x8*)(QR + t * 1024 + hoff + ks * 32 + 8 * g);
    f32x4 o[16];
#pragma unroll
    for (int db = 0; db < 16; ++db) o[db] = (f32x4){0.f, 0.f, 0.f, 0.f};
    u32x4 pk[4], pv[4];
    const bf16_t* Sn = ST + (size_t)(n > 0 ? n - 1 : 0) * 65536;
#define RC_LOAD(st) do { int tl = tid; asm volatile("" : "+v"(tl)); if ((st) < 4) { _Pragma("unroll") for (int i = 0; i < 4; ++i) { const int id = tl + 512 * i; pk[i] = *(const u32x4*)(Sn + (size_t)(st) * 16384 + id * 8); } } \
        else { _Pragma("unroll") for (int i = 0; i < 4; ++i) { const int id = tl + 512 * i, key = id >> 5, ch = id & 31; const size_t off = (rowb + 128 * n + 64 * ((st) - 4) + key) * 1024 + hoff + ch * 8; \
            pk[i] = *(const u32x4*)(KR + off); pv[i] = *(const u32x4*)(VR + off); } } } while (0)
#define RC_WRITE(buf, st) do { int tl = tid; asm volatile("" : "+v"(tl)); _Pragma("unroll") for (int i = 0; i < 4; ++i) { const int id = tl + 512 * i, key = id >> 5, ch = id & 31; \
        *(LAS u32x4*)(lds + (buf) * 2 * TB + key * RS + ch * 16) = pk[i]; if ((st) >= 4) *(LAS u32x4*)(lds + (buf) * 2 * TB + TB + key * RS + ch * 16) = pv[i]; } } while (0)
    const int st0 = (n > 0) ? 0 : 4;
    if (n > 0) { RC_LOAD(0); RC_WRITE(0, 0); } else { RC_LOAD(4); RC_WRITE(0, 4); }
    __syncthreads();
#pragma unroll
    for (int st = 0; st < 6; ++st) {
        if (st >= st0) {
            const int buf = st & 1;
            LAS const unsigned char* Kl = lds + buf * 2 * TB; LAS const unsigned char* Vl = Kl + TB;
            if (st + 1 < 6) RC_LOAD(st + 1);
            if (st < 4) {
#pragma unroll
                for (int blk = 0; blk < 4; ++blk) { f32x4 acc = {0.f, 0.f, 0.f, 0.f};
#pragma unroll
                    for (int ks = 0; ks < 8; ++ks) { const bf16x8 kf = *(LAS const bf16x8*)(Kl + (16 * blk + c) * RS + (ks * 32 + 8 * g) * 2); acc = MFMA16(kf, qf[ks], acc); }
                    o[(st < 4 ? 4 * st : 0) + blk] = acc; }
                __builtin_amdgcn_sched_barrier(0);
            } else if (64 * (st - 4) <= 16 * w + 15) {
                f32x4 s[4];
#pragma unroll
                for (int blk = 0; blk < 4; ++blk) { f32x4 acc = {0.f, 0.f, 0.f, 0.f};
#pragma unroll
                    for (int ks = 0; ks < 8; ++ks) { const bf16x8 kf = *(LAS const bf16x8*)(Kl + (16 * blk + c) * RS + (ks * 32 + 8 * g) * 2); acc = MFMA16(kf, qf[ks], acc); }
#pragma unroll
                    for (int r = 0; r < 4; ++r) { const int d = ql - (64 * (st - 4) + 16 * blk + 4 * g + r); acc[r] = (d >= 0) ? acc[r] : 0.f; }
                    s[blk] = acc; }
#pragma unroll
                for (int kp = 0; kp < 2; ++kp) { const bf16x8 pf = pack_p(s[2 * kp], s[2 * kp + 1]);
#pragma unroll
                    for (int db = 0; db < 16; ++db) { const bf16x8 af = vt_frag(Vl + (32 * kp + 4 * g + (c >> 2)) * RS + (16 * db + 4 * (c & 3)) * 2, 16 * RS); o[db] = MFMA16(af, pf, o[db]); }
                    __builtin_amdgcn_sched_barrier(0); }
            }
            if (st + 1 < 6) RC_WRITE(buf ^ 1, st + 1);
            __syncthreads();
            __builtin_amdgcn_sched_barrier(0);
        }
    }
#undef RC_LOAD
#undef RC_WRITE
    { const float qs = __builtin_amdgcn_exp2f((float)(ql - 127) * lg);
#pragma unroll
      for (int db = 0; db < 16; ++db) o[db] = o[db] * qs; }
    float s1 = 0.f;
#pragma unroll
    for (int db = 0; db < 16; ++db) s1 += (o[db][0] + o[db][1]) + (o[db][2] + o[db][3]);
    s1 += __shfl_xor(s1, 16); s1 += __shfl_xor(s1, 32);
    const float mu = s1 * (1.f / 256.f); float s2 = 0.f;
#pragma unroll
    for (int db = 0; db < 16; ++db) { o[db] = o[db] - mu; s2 += (o[db][0] * o[db][0] + o[db][1] * o[db][1]) + (o[db][2] * o[db][2] + o[db][3] * o[db][3]); }
    s2 += __shfl_xor(s2, 16); s2 += __shfl_xor(s2, 32);
    const float rstd = rsqrtf(s2 * (1.f / 256.f) + GN_EPS);
#pragma unroll
    for (int db = 0; db < 16; ++db) { const int col = hoff + 16 * db + 4 * g; const f32x4 gn = *(const f32x4*)(ret_gain + col); const u32x2 gw = *(const u32x2*)(GR + t * 1024 + col);
        const float z0 = bf_lo(gw.x), z1 = bf_hi(gw.x), z2 = bf_lo(gw.y), z3 = bf_hi(gw.y);
        f32x4 v = o[db] * rstd * gn;
        v[0] *= z0 / (1.f + __expf(-z0)); v[1] *= z1 / (1.f + __expf(-z1)); v[2] *= z2 / (1.f + __expf(-z2)); v[3] *= z3 / (1.f + __expf(-z3));
        u32x2 wv; wv.x = pk2(v[0], v[1]); wv.y = pk2(v[2], v[3]); *(u32x2*)(Y + t * DM + 1024 + col) = wv; }
}

__device__ __forceinline__ void xattn_unit(LAS unsigned char* lds, int b, int hx, int qblk, const bf16_t* QX, const bf16_t* KX, const bf16_t* VX, bf16_t* OX) {
    constexpr int KS = 288;
    const int tid = threadIdx.x, lane = tid & 63, c = lane & 15, g = lane >> 4; const int w = __builtin_amdgcn_readfirstlane(tid >> 6);
    LAS unsigned char* Kl = lds; LAS unsigned char* Vl = lds + 256 * KS;
    for (int i = tid; i < 4096; i += 512) { const int key = i >> 4, ch = i & 15; const size_t off = (size_t)(b * MEML + key) * 512 + hx * 128 + ch * 8;
        *(LAS u32x4*)(Kl + key * KS + ch * 16) = *(const u32x4*)(KX + off); *(LAS u32x4*)(Vl + key * KS + ch * 16) = *(const u32x4*)(VX + off); }
    __syncthreads();
    bf16x8 qn[4];
#pragma unroll
    for (int ks = 0; ks < 4; ++ks) qn[ks] = *(const bf16x8*)(QX + ((size_t)b * SEQ + 256 * qblk + 16 * w + c) * 512 + hx * 128 + ks * 32 + 8 * g);
#pragma unroll 1
    for (int pass = 0; pass < 2; ++pass) {
        const size_t t = (size_t)b * SEQ + 256 * qblk + 128 * pass + 16 * w + c;
        bf16x8 qf[4];
#pragma unroll
        for (int ks = 0; ks < 4; ++ks) { qf[ks] = qn[ks]; qn[ks] = *(const bf16x8*)(QX + (t + (pass == 0 ? 128 : 0)) * 512 + hx * 128 + ks * 32 + 8 * g); }
        f32x4 s[16]; float m = -INFINITY;
#pragma unroll
        for (int blk = 0; blk < 16; ++blk) { f32x4 acc = {0.f, 0.f, 0.f, 0.f};
#pragma unroll
            for (int ks = 0; ks < 4; ++ks) { const bf16x8 kf = *(LAS const bf16x8*)(Kl + (16 * blk + c) * KS + (ks * 32 + 8 * g) * 2); acc = MFMA16(kf, qf[ks], acc); }
            m = fmaxf(fmaxf(fmaxf(acc[0], acc[1]), fmaxf(acc[2], acc[3])), m); s[blk] = acc; __builtin_amdgcn_sched_barrier(0); }
        m = fmaxf(m, __shfl_xor(m, 16)); m = fmaxf(m, __shfl_xor(m, 32));
        float l = 0.f;
#pragma unroll
        for (int blk = 0; blk < 16; ++blk)
#pragma unroll
            for (int r = 0; r < 4; ++r) { const float p = __builtin_amdgcn_exp2f(s[blk][r] - m); s[blk][r] = p; l += p; }
        l += __shfl_xor(l, 16); l += __shfl_xor(l, 32);
        f32x4 o[8];
#pragma unroll
        for (int db = 0; db < 8; ++db) o[db] = (f32x4){0.f, 0.f, 0.f, 0.f};
#pragma unroll
        for (int kp = 0; kp < 8; ++kp) { const bf16x8 pf = pack_p(s[2 * kp], s[2 * kp + 1]);
#pragma unroll
            for (int db = 0; db < 8; ++db) { const bf16x8 af = vt_frag(Vl + (32 * kp + 4 * g + (c >> 2)) * KS + (16 * db + 4 * (c & 3)) * 2, 16 * KS); o[db] = MFMA16(af, pf, o[db]); }
            __builtin_amdgcn_sched_barrier(0); }
        const float inv = 1.f / l;
#pragma unroll
        for (int db = 0; db < 8; ++db) { const f32x4 v = o[db] * inv; u32x2 wv; wv.x = pk2(v[0], v[1]); wv.y = pk2(v[2], v[3]); *(u32x2*)(OX + t * 512 + hx * 128 + 16 * db + 4 * g) = wv; }
    }
    __syncthreads();
}

__device__ __forceinline__ int mono_i(float x) { int i = __float_as_int(x); return i ^ ((i >> 31) & 0x7fffffff); }
__device__ __forceinline__ float mono_f(int i) { return __int_as_float(i ^ ((i >> 31) & 0x7fffffff)); }
#define INS16(L, v) do { int _v = (v); _Pragma("unroll") for (int _k = 0; _k < 16; ++_k) { const int _t = max(L[_k], _v); _v = min(L[_k], _v); L[_k] = _t; } } while (0)
#define CE_DESC(x, y) do { const int _h = max((x), (y)), _l = min((x), (y)); (x) = _h; (y) = _l; } while (0)
#define SORT16_DESC(L) do { \
    CE_DESC(L[0], L[1]); \
    CE_DESC(L[2], L[3]); \
    CE_DESC(L[0], L[2]); \
    CE_DESC(L[1], L[3]); \
    CE_DESC(L[1], L[2]); \
    CE_DESC(L[4], L[5]); \
    CE_DESC(L[6], L[7]); \
    CE_DESC(L[4], L[6]); \
    CE_DESC(L[5], L[7]); \
    CE_DESC(L[5], L[6]); \
    CE_DESC(L[0], L[4]); \
    CE_DESC(L[2], L[6]); \
    CE_DESC(L[2], L[4]); \
    CE_DESC(L[1], L[5]); \
    CE_DESC(L[3], L[7]); \
    CE_DESC(L[3], L[5]); \
    CE_DESC(L[1], L[2]); \
    CE_DESC(L[3], L[4]); \
    CE_DESC(L[5], L[6]); \
    CE_DESC(L[8], L[9]); \
    CE_DESC(L[10], L[11]); \
    CE_DESC(L[8], L[10]); \
    CE_DESC(L[9], L[11]); \
    CE_DESC(L[9], L[10]); \
    CE_DESC(L[12], L[13]); \
    CE_DESC(L[14], L[15]); \
    CE_DESC(L[12], L[14]); \
    CE_DESC(L[13], L[15]); \
    CE_DESC(L[13], L[14]); \
    CE_DESC(L[8], L[12]); \
    CE_DESC(L[10], L[14]); \
    CE_DESC(L[10], L[12]); \
    CE_DESC(L[9], L[13]); \
    CE_DESC(L[11], L[15]); \
    CE_DESC(L[11], L[13]); \
    CE_DESC(L[9], L[10]); \
    CE_DESC(L[11], L[12]); \
    CE_DESC(L[13], L[14]); \
    CE_DESC(L[0], L[8]); \
    CE_DESC(L[4], L[12]); \
    CE_DESC(L[4], L[8]); \
    CE_DESC(L[2], L[10]); \
    CE_DESC(L[6], L[14]); \
    CE_DESC(L[6], L[10]); \
    CE_DESC(L[2], L[4]); \
    CE_DESC(L[6], L[8]); \
    CE_DESC(L[10], L[12]); \
    CE_DESC(L[1], L[9]); \
    CE_DESC(L[5], L[13]); \
    CE_DESC(L[5], L[9]); \
    CE_DESC(L[3], L[11]); \
    CE_DESC(L[7], L[15]); \
    CE_DESC(L[7], L[11]); \
    CE_DESC(L[3], L[5]); \
    CE_DESC(L[7], L[9]); \
    CE_DESC(L[11], L[13]); \
    CE_DESC(L[1], L[2]); \
    CE_DESC(L[3], L[4]); \
    CE_DESC(L[5], L[6]); \
    CE_DESC(L[7], L[8]); \
    CE_DESC(L[9], L[10]); \
    CE_DESC(L[11], L[12]); \
    CE_DESC(L[13], L[14]); \
} while (0)

__device__ __forceinline__ void bitonic_fix16(int (&L)[16]) {
    CE_DESC(L[0], L[8]); CE_DESC(L[1], L[9]); CE_DESC(L[2], L[10]); CE_DESC(L[3], L[11]); CE_DESC(L[4], L[12]); CE_DESC(L[5], L[13]); CE_DESC(L[6], L[14]); CE_DESC(L[7], L[15]);
    CE_DESC(L[0], L[4]); CE_DESC(L[1], L[5]); CE_DESC(L[2], L[6]); CE_DESC(L[3], L[7]); CE_DESC(L[8], L[12]); CE_DESC(L[9], L[13]); CE_DESC(L[10], L[14]); CE_DESC(L[11], L[15]);
    CE_DESC(L[0], L[2]); CE_DESC(L[1], L[3]); CE_DESC(L[4], L[6]); CE_DESC(L[5], L[7]); CE_DESC(L[8], L[10]); CE_DESC(L[9], L[11]); CE_DESC(L[12], L[14]); CE_DESC(L[13], L[15]);
    CE_DESC(L[0], L[1]); CE_DESC(L[2], L[3]); CE_DESC(L[4], L[5]); CE_DESC(L[6], L[7]); CE_DESC(L[8], L[9]); CE_DESC(L[10], L[11]); CE_DESC(L[12], L[13]); CE_DESC(L[14], L[15]);
}
__device__ __forceinline__ void merge16(int (&L)[16], int xm) {
    int P[16];
#pragma unroll
    for (int i = 0; i < 16; ++i) P[i] = __shfl_xor(L[i], xm);
#pragma unroll
    for (int i = 0; i < 16; ++i) L[i] = max(L[i], P[15 - i]);
    bitonic_fix16(L);
}
__device__ __forceinline__ void peer_topk_unit(LAS unsigned char* lds, int pm, int h, const bf16_t* PQ, const float* subk, int* EXP, float* GATE) {
    constexpr int KS = 272;
    const int tid = threadIdx.x, lane = tid & 63, c = lane & 15, g = lane >> 4; const int w = __builtin_amdgcn_readfirstlane(tid >> 6);
    const float* sk = subk + (size_t)h * 2 * 128 * 128;
    for (int i = tid; i < 8192; i += 512) { const int row = i >> 5, ch = i & 31; const f32x4 v = *(const f32x4*)(sk + (size_t)row * 128 + ch * 4);
        u32x2 wv; wv.x = pk2(v[0], v[1]); wv.y = pk2(v[2], v[3]); *(LAS u32x2*)(lds + row * KS + ch * 8) = wv; }
    __syncthreads();
#pragma unroll 1
    for (int grp = 0; grp < 2; ++grp) {
        const size_t t = (size_t)pm * 256 + 32 * w + 16 * grp + c;
        int S1[16], S2[16];
        bf16x8 qall[2][4];
#pragma unroll
        for (int p = 0; p < 2; ++p)
#pragma unroll
            for (int ks = 0; ks < 4; ++ks) qall[p][ks] = *(const bf16x8*)(PQ + t * DM + h * 256 + p * 128 + ks * 32 + 8 * g);
#pragma unroll
        for (int p = 0; p < 2; ++p) {
            bf16x8 qf[4];
#pragma unroll
            for (int ks = 0; ks < 4; ++ks) qf[ks] = qall[p][ks];
            int A[16], B[16];
#pragma unroll
            for (int blk = 0; blk < 8; ++blk) { f32x4 acc = {0.f, 0.f, 0.f, 0.f};
#pragma unroll
                for (int ks = 0; ks < 4; ++ks) { const bf16x8 kf = *(LAS const bf16x8*)(lds + (p * 128 + 16 * blk + c) * KS + (ks * 32 + 8 * g) * 2); acc = MFMA16(kf, qf[ks], acc); }
#pragma unroll
                for (int r = 0; r < 4; ++r) { const int idx = 16 * blk + 4 * g + r; const int key = (mono_i(acc[r]) & ~127) | (127 - idx); if (blk < 4) A[4 * blk + r] = key; else B[4 * (blk - 4) + r] = key; }
                __builtin_amdgcn_sched_barrier(0); }
            SORT16_DESC(A); SORT16_DESC(B);
#pragma unroll
            for (int i = 0; i < 16; ++i) A[i] = max(A[i], B[15 - i]);
            bitonic_fix16(A);
            merge16(A, 16); merge16(A, 32);
#pragma unroll
            for (int k = 0; k < 16; ++k) { if (p == 0) S1[k] = A[k]; else S2[k] = A[k]; }
        }
        float s1v[16], s2v[16];
#pragma unroll
        for (int k = 0; k < 16; ++k) { s1v[k] = mono_f(S1[k] & ~127); s2v[k] = mono_f(S2[k] & ~127); }
        int Mx[16];
#pragma unroll
        for (int k = 0; k < 16; ++k) Mx[k] = (int)0x80000000;
#define STAIR4(a0, b0, a1, b1, a2, b2, a3, b3) do { const float _c0 = s1v[a0] + s2v[b0], _c1 = s1v[a1] + s2v[b1], _c2 = s1v[a2] + s2v[b2], _c3 = s1v[a3] + s2v[b3]; \
        const float _m = (g == 0) ? _c0 : (g == 1) ? _c1 : (g == 2) ? _c2 : _c3; const int _cd = (g == 0) ? (255 - (16 * a0 + b0)) : (g == 1) ? (255 - (16 * a1 + b1)) : (g == 2) ? (255 - (16 * a2 + b2)) : (255 - (16 * a3 + b3)); \
        INS16(Mx, (mono_i(_m) & ~255) | _cd); } while (0)
#define STAIR2(a0, b0, a1, b1) do { const float _c0 = s1v[a0] + s2v[b0], _c1 = s1v[a1] + s2v[b1]; const float _m = (g == 0) ? _c0 : _c1; const int _cd = (g == 0) ? (255 - (16 * a0 + b0)) : (255 - (16 * a1 + b1)); \
        const int _key = (mono_i(_m) & ~255) | _cd; INS16(Mx, (g < 2) ? _key : (int)0x80000000); } while (0)
        STAIR4(0, 0, 0, 1, 0, 2, 0, 3);
        STAIR4(0, 4, 0, 5, 0, 6, 0, 7);
        STAIR4(0, 8, 0, 9, 0, 10, 0, 11);
        STAIR4(0, 12, 0, 13, 0, 14, 0, 15);
        STAIR4(1, 0, 1, 1, 1, 2, 1, 3);
        STAIR4(1, 4, 1, 5, 1, 6, 1, 7);
        STAIR4(2, 0, 2, 1, 2, 2, 2, 3);
        STAIR4(2, 4, 3, 0, 3, 1, 3, 2);
        STAIR4(3, 3, 4, 0, 4, 1, 4, 2);
        STAIR4(5, 0, 5, 1, 6, 0, 6, 1);
        STAIR4(7, 0, 7, 1, 8, 0, 9, 0);
        STAIR4(10, 0, 11, 0, 12, 0, 13, 0);
        STAIR2(14, 0, 15, 0);
#undef STAIR4
#undef STAIR2
        merge16(Mx, 16); merge16(Mx, 32);
        const float top = mono_f(Mx[0] & ~255); float wg[4]; int ex[4]; float wsum = 0.f;
#pragma unroll
        for (int i = 0; i < 4; ++i) { const int key = (g == 0) ? Mx[i] : (g == 1) ? Mx[4 + i] : (g == 2) ? Mx[8 + i] : Mx[12 + i];
            wg[i] = __expf(mono_f(key & ~255) - top); wsum += wg[i];
            const int ab = 255 - (key & 255), a = ab >> 4, bb = ab & 15; int e1 = 0, e2 = 0;
#pragma unroll
            for (int k = 0; k < 16; ++k) { e1 = (a == k) ? (127 - (S1[k] & 127)) : e1; e2 = (bb == k) ? (127 - (S2[k] & 127)) : e2; }
            ex[i] = e1 * 128 + e2; }
        wsum += __shfl_xor(wsum, 16); wsum += __shfl_xor(wsum, 32);
        const float inv = 1.f / wsum;
        *(int4*)(EXP + t * 128 + h * 16 + 4 * g) = make_int4(ex[0], ex[1], ex[2], ex[3]);
        *(f32x4*)(GATE + t * 128 + h * 16 + 4 * g) = (f32x4){wg[0] * inv, wg[1] * inv, wg[2] * inv, wg[3] * inv};
    }
    __syncthreads();
}
typedef __bf16 v32bf16 __attribute__((ext_vector_type(32)));
typedef unsigned v6u32 __attribute__((ext_vector_type(6)));
constexpr int ROWB = 1536;
__device__ __forceinline__ float fdot2bf(bf16x2_t a, bf16x2_t b, float c) { return __builtin_amdgcn_fdot2_f32_bf16(a, b, c, false); }
__device__ __forceinline__ void row_to_fp6(const float* src, const float* colgain, unsigned char* dst, float* inv, int lane) {
    f32x4 v[8]; float am = 0.f;
#pragma unroll
    for (int j = 0; j < 8; ++j) { v[j] = *(const f32x4*)(src + 32 * lane + 4 * j); if (colgain) v[j] = v[j] * *(const f32x4*)(colgain + 32 * lane + 4 * j);
        am = fmaxf(am, fmaxf(fmaxf(fabsf(v[j][0]), fabsf(v[j][1])), fmaxf(fabsf(v[j][2]), fabsf(v[j][3])))); }
#pragma unroll
    for (int o = 1; o < 64; o <<= 1) am = fmaxf(am, __shfl_xor(am, o));
    float S = 1.f;
    if (am > 1e-30f) S = __uint_as_float(__float_as_uint(7.5f / am) & 0x7f800000u);
    unsigned pk[6] = {0u, 0u, 0u, 0u, 0u, 0u};
#pragma unroll
    for (int j = 0; j < 8; ++j)
#pragma unroll
        for (int i = 0; i < 4; ++i) { const float t = v[j][i] * S, a = fabsf(t);
            const float cf = (a < 2.f) ? rintf(a * 8.f) : (a < 4.f) ? 16.f + rintf((a - 2.f) * 4.f) : 24.f + rintf((a - 4.f) * 2.f);
            unsigned cd = (unsigned)fminf(cf, 31.f); if (t < 0.f) cd |= 32u;
            const int e = 4 * j + i, bit = 6 * e, dw = bit >> 5, sh = bit & 31;
            pk[dw] |= cd << sh; if (sh > 26) pk[dw + 1] |= cd >> (32 - sh); }
    *(u32x4*)(dst + 16 * lane) = (u32x4){pk[0], pk[1], pk[2], pk[3]}; *(u32x2*)(dst + 1024 + 8 * lane) = (u32x2){pk[4], pk[5]};
    if (lane == 0) *inv = 1.f / S;
}
__device__ __forceinline__ v32bf16 sw_unpack6(v6u32 s) {
    v32bf16 r;
#pragma unroll
    for (int e = 0; e < 32; ++e) { const int bit = 6 * e, dw = bit >> 5, sh = bit & 31; unsigned cd = s[dw] >> sh; if (sh > 26) cd |= s[dw + 1] << (32 - sh); cd &= 63u;
        const unsigned m = cd & 31u; float a = (m < 16u) ? (float)m * 0.125f : (m < 24u) ? 2.f + (float)(m - 16u) * 0.25f : 4.f + (float)(m - 24u) * 0.5f; if (cd & 32u) a = -a; r[e] = (__bf16)a; }
    return r;
}
constexpr int RING = 4;
typedef unsigned v16u32 __attribute__((ext_vector_type(16)));
__device__ __forceinline__ bf16x2_t as_pair(unsigned w) { return __builtin_bit_cast(bf16x2_t, w); }
#define PAIR(r, p) as_pair((r)[(p)])
#define PG_EW(p)  ((LAS int*)(wb + 512 + (p) * 512))
#define PG_SU(p)  ((LAS float*)(wb + 1536 + (p) * 512))
#define PG_GV(p)  ((LAS float*)(wb + 2560 + (p) * 512))
#define PG_ST(p)  ((LAS f32x4*)(wb + 4096 + (p) * 4096))
__device__ __forceinline__ void peer_gather_wave(LAS unsigned char* wb, LAS const float* gl, int tfirst, int tstep, const bf16_t* X,
                                                 const unsigned char* UBp, const unsigned char* VBp, const float* SUp, const float* SVp, const int* EXP, const float* GATEp, float* OUT, int lane) {
    LAS float* cw = (LAS float*)wb;
    u32x4 xq[4]; int kA, kB, s0k, s1k; float su0, su1, sv0, sv1, gt0, gt1; bf16x2_t xb[16];
    u32x4 ra[RING]; u32x2 rc[RING];
    const int eloc = ((lane >> 5) & 1) * 8 + ((lane >> 4) & 1) * 4 + ((lane >> 3) & 1) * 2 + ((lane >> 2) & 1);
#define ROWLOAD(BASE, slot, EW, k) do { const int _e = __builtin_amdgcn_readfirstlane((EW)[(k)]) >> 7; const unsigned char* _rp = (BASE) + (size_t)_e * ROWB; \
        ra[slot] = *(const u32x4*)(_rp + 16 * lane); rc[slot] = *(const u32x2*)(_rp + 1024 + 8 * lane); } while (0)
#define ROWCVT(slot) __builtin_amdgcn_cvt_scalef32_pk32_bf16_fp6((v6u32){ra[slot].x, ra[slot].y, ra[slot].z, ra[slot].w, rc[slot].x, rc[slot].y}, 1.0f)
#define TOK_FETCH(t) do { const bf16_t* _xr = X + (size_t)(t) * DM + 32 * lane; _Pragma("unroll") for (int j = 0; j < 4; ++j) xq[j] = *(const u32x4*)(_xr + 8 * j); \
        kA = EXP[(size_t)(t) * 128 + lane]; kB = EXP[(size_t)(t) * 128 + 64 + lane]; } while (0)
#define TOK_SORT(t) do { int k0 = (kA << 7) | lane, k1 = (kB << 7) | (64 + lane); \
        _Pragma("unroll") for (int k = 2; k <= 128; k <<= 1) _Pragma("unroll") for (int j = k >> 1; j > 0; j >>= 1) { \
            if (j == 64) { const int a_ = min(k0, k1), c_ = max(k0, k1); k0 = a_; k1 = c_; } \
            else { const int p0 = __shfl_xor(k0, j), p1 = __shfl_xor(k1, j); const bool lower = (lane & j) == 0; \
                   const bool asc0 = (k >= 64) ? true : ((lane & k) == 0), asc1 = (k == 128) ? true : ((k == 64) ? false : ((lane & k) == 0)); \
                   k0 = (lower == asc0) ? min(k0, p0) : max(k0, p0); k1 = (lower == asc1) ? min(k1, p1) : max(k1, p1); } } \
        s0k = k0; s1k = k1; su0 = SUp[k0 >> 7]; sv0 = SVp[k0 >> 7]; gt0 = GATEp[(size_t)(t) * 128 + (k0 & 127)]; su1 = SUp[k1 >> 7]; sv1 = SVp[k1 >> 7]; gt1 = GATEp[(size_t)(t) * 128 + (k1 & 127)]; } while (0)
#define TOK_COMMIT(p) do { PG_EW(p)[lane] = s0k; PG_EW(p)[lane + 64] = s1k; PG_SU(p)[lane] = su0; PG_SU(p)[lane + 64] = su1; PG_GV(p)[lane] = gt0 * sv0; PG_GV(p)[lane + 64] = gt1 * sv1; } while (0)
#define TOK_XB(p) do { f32x4 xv[8]; float ss = 0.f; \
        _Pragma("unroll") for (int j = 0; j < 4; ++j) { xv[2 * j] = (f32x4){bf_lo(xq[j].x), bf_hi(xq[j].x), bf_lo(xq[j].y), bf_hi(xq[j].y)}; xv[2 * j + 1] = (f32x4){bf_lo(xq[j].z), bf_hi(xq[j].z), bf_lo(xq[j].w), bf_hi(xq[j].w)}; } \
        _Pragma("unroll") for (int j = 0; j < 8; ++j) ss += (xv[j][0] * xv[j][0] + xv[j][1] * xv[j][1]) + (xv[j][2] * xv[j][2] + xv[j][3] * xv[j][3]); \
        ss = wave_sum(ss); const float rs = rsqrtf(ss * (1.f / DM) + EPS); \
        _Pragma("unroll") for (int j = 0; j < 8; ++j) { const f32x4 a = xv[j] * rs * *(LAS const f32x4*)(gl + 32 * lane + 4 * j); xb[2 * j] = __builtin_bit_cast(bf16x2_t, pk2(a[0], a[1])); xb[2 * j + 1] = __builtin_bit_cast(bf16x2_t, pk2(a[2], a[3])); } \
        _Pragma("unroll") for (int j = 0; j < 4; ++j) PG_ST(p)[j * 64 + lane] = __builtin_bit_cast(f32x4, xq[j]); } while (0)
#define V_ROWS(K0, K1, cur) for (int k0 = (K0); k0 < (K1); k0 += RING) { _Pragma("unroll") for (int j = 0; j < RING; ++j) { \
            const float cv = cw[k0 + j]; const unsigned clo_u = pk2(cv, 0.f); const bf16x2_t clo = __builtin_bit_cast(bf16x2_t, clo_u), chi = __builtin_bit_cast(bf16x2_t, clo_u << 16); \
            const v16u32 r = __builtin_bit_cast(v16u32, ROWCVT(j)); \
            _Pragma("unroll") for (int q = 0; q < 16; ++q) { acc[2 * q] = fdot2bf(PAIR(r, q), clo, acc[2 * q]); acc[2 * q + 1] = fdot2bf(PAIR(r, q), chi, acc[2 * q + 1]); } \
            ROWLOAD(VBp, j, PG_EW(cur), k0 + j + RING); } }

    TOK_FETCH(tfirst); TOK_SORT(tfirst); TOK_COMMIT(0); TOK_XB(0);
    asm volatile("s_waitcnt lgkmcnt(0)" ::: "memory");
#pragma unroll
    for (int j = 0; j < RING; ++j) ROWLOAD(UBp, j, PG_EW(0), j);
    int cur = 0;
#pragma unroll 1
    for (int t = tfirst; t < T_TOK; t += tstep, cur ^= 1) {
        const int nxt = cur ^ 1; const int tn = (t + tstep < T_TOK) ? t + tstep : t;
#pragma unroll 1
        for (int b = 0; b < 8; ++b) {
            float part[16];
#pragma unroll
            for (int j = 0; j < 16; ++j) { const int slot = j & (RING - 1); const v16u32 r = __builtin_bit_cast(v16u32, ROWCVT(slot)); float a0 = 0.f, a1 = 0.f;
#pragma unroll
                for (int q = 0; q < 8; ++q) { a0 = fdot2bf(PAIR(r, 2 * q), xb[2 * q], a0); a1 = fdot2bf(PAIR(r, 2 * q + 1), xb[2 * q + 1], a1); }
                part[j] = a0 + a1;
                { const int sn = 16 * b + j + RING; const unsigned char* nb = (sn < 128) ? UBp : VBp; ROWLOAD(nb, slot, PG_EW(cur), sn & 127); } }
            float q8[8], q4[4], q2[2], q1;
#pragma unroll
            for (int i = 0; i < 8; ++i) { const bool up = (lane & 32) != 0; const float snd = up ? part[i] : part[i + 8], kp = up ? part[i + 8] : part[i]; q8[i] = kp + __shfl_xor(snd, 32); }
#pragma unroll
            for (int i = 0; i < 4; ++i) { const bool up = (lane & 16) != 0; const float snd = up ? q8[i] : q8[i + 4], kp = up ? q8[i + 4] : q8[i]; q4[i] = kp + __shfl_xor(snd, 16); }
#pragma unroll
            for (int i = 0; i < 2; ++i) { const bool up = (lane & 8) != 0; const float snd = up ? q4[i] : q4[i + 2], kp = up ? q4[i + 2] : q4[i]; q2[i] = kp + __shfl_xor(snd, 8); }
            { const bool up = (lane & 4) != 0; const float snd = up ? q2[0] : q2[1], kp = up ? q2[1] : q2[0]; q1 = kp + __shfl_xor(snd, 4); }
            q1 += __shfl_xor(q1, 1); q1 += __shfl_xor(q1, 2);
            if ((lane & 3) == 0) { const int k = 16 * b + eloc; const float av = q1 * PG_SU(cur)[k]; const float gel = 0.5f * av * (1.f + erff(av * 0.70710678118654752f)); cw[k] = gel * PG_GV(cur)[k]; }
        }
        asm volatile("s_waitcnt lgkmcnt(0)" ::: "memory");
        float acc[32];
#pragma unroll
        for (int i = 0; i < 32; ++i) acc[i] = 0.f;
        TOK_FETCH(tn);
        V_ROWS(0, 32, cur)
        TOK_SORT(tn);
        V_ROWS(32, 64, cur)
        TOK_COMMIT(nxt);
        V_ROWS(64, 96, cur)
        TOK_XB(nxt);
        V_ROWS(96, 128 - RING, cur)
        asm volatile("s_waitcnt lgkmcnt(0)" ::: "memory");
#pragma unroll
        for (int j = 0; j < RING; ++j) { const int k = 128 - RING + j;
            const float cv = cw[k]; const unsigned clo_u = pk2(cv, 0.f); const bf16x2_t clo = __builtin_bit_cast(bf16x2_t, clo_u), chi = __builtin_bit_cast(bf16x2_t, clo_u << 16);
            const v16u32 r = __builtin_bit_cast(v16u32, ROWCVT(j));
#pragma unroll
            for (int q = 0; q < 16; ++q) { acc[2 * q] = fdot2bf(PAIR(r, q), clo, acc[2 * q]); acc[2 * q + 1] = fdot2bf(PAIR(r, q), chi, acc[2 * q + 1]); }
            ROWLOAD(UBp, j, PG_EW(nxt), j); }
        f32x4 xo[8]; float s3 = 0.f;
#pragma unroll
        for (int j = 0; j < 4; ++j) { const u32x4 q = __builtin_bit_cast(u32x4, PG_ST(cur)[j * 64 + lane]); xo[2 * j] = (f32x4){bf_lo(q.x), bf_hi(q.x), bf_lo(q.y), bf_hi(q.y)}; xo[2 * j + 1] = (f32x4){bf_lo(q.z), bf_hi(q.z), bf_lo(q.w), bf_hi(q.w)}; }
#pragma unroll
        for (int j = 0; j < 8; ++j)
#pragma unroll
            for (int i = 0; i < 4; ++i) { xo[j][i] += acc[4 * j + i]; s3 += xo[j][i] * xo[j][i]; }
        s3 = wave_sum(s3);
        const float r3 = rsqrtf(s3 * (1.f / DM) + EPS);
        float* orow = OUT + (size_t)t * DM + 32 * lane;
#pragma unroll
        for (int j = 0; j < 8; ++j) { const f32x4 g0 = *(LAS const f32x4*)(gl + DM + 32 * lane + 4 * j); *(f32x4*)(orow + 4 * j) = xo[j] * r3 * g0; }
    }
#undef ROWLOAD
#undef ROWCVT
#undef TOK_FETCH
#undef TOK_SORT
#undef TOK_COMMIT
#undef TOK_XB
#undef V_ROWS
}

constexpr unsigned NF1 = 896;
__device__ __forceinline__ void fp8_chunk(int chunk, int wave, int lane, const float* peer_u, const float* peer_v, const float* g_ffn, unsigned char* UB, unsigned char* VB, float* SU, float* SV) {
#pragma unroll 1
    for (int r = 0; r < 2; ++r) { const int row = chunk * 16 + wave * 2 + r;
        if (row < 16384) row_to_fp6(peer_u + (size_t)row * DM, nullptr, UB + (size_t)row * ROWB, SU + row, lane);
        else row_to_fp6(peer_v + (size_t)(row - 16384) * DM, nullptr, VB + (size_t)(row - 16384) * ROWB, SV + (row - 16384), lane); }
}
constexpr int NWAVES = 8, LDS_BYTES = 163840, MISC_OFF = 159744;
constexpr int N_PHASES = 10;
struct Args { const void* in[21]; float* out; unsigned char* ws; int ph_lo, ph_hi; float inv_freq[128]; };

#define IN_x ((const float*)((const float*)args.in[0]))
#define IN_mem ((const float*)((const float*)args.in[1]))
#define IN_positions ((const int*)((const int*)args.in[2]))
#define IN_g_mix ((const float*)((const float*)args.in[3]))
#define IN_w_in ((const float*)((const float*)args.in[4]))
#define IN_sinks ((const float*)((const float*)args.in[5]))
#define IN_att_gain ((const float*)((const float*)args.in[6]))
#define IN_ret_gain ((const float*)((const float*)args.in[7]))
#define IN_w_out ((const float*)((const float*)args.in[8]))
#define IN_g_cross ((const float*)((const float*)args.in[9]))
#define IN_g_mem ((const float*)((const float*)args.in[10]))
#define IN_w_xq ((const float*)((const float*)args.in[11]))
#define IN_w_xk ((const float*)((const float*)args.in[12]))
#define IN_w_xv ((const float*)((const float*)args.in[13]))
#define IN_w_xo ((const float*)((const float*)args.in[14]))
#define IN_g_ffn ((const float*)((const float*)args.in[15]))
#define IN_w_pq ((const float*)((const float*)args.in[16]))
#define IN_subk ((const float*)((const float*)args.in[17]))
#define IN_peer_u ((const float*)((const float*)args.in[18]))
#define IN_peer_v ((const float*)((const float*)args.in[19]))
#define IN_g_fin ((const float*)((const float*)args.in[20]))
#define IN_out ((float*)(args.out))
#define WIN ((bf16_t*)((bf16_t*)(ws + WS_WIN)))
#define WOUT ((bf16_t*)((bf16_t*)(ws + WS_WOUT)))
#define WXQ ((bf16_t*)((bf16_t*)(ws + WS_WXQ)))
#define WXKV ((bf16_t*)((bf16_t*)(ws + WS_WXKV)))
#define WXO ((bf16_t*)((bf16_t*)(ws + WS_WXO)))
#define WPQ ((bf16_t*)((bf16_t*)(ws + WS_WPQ)))
#define XB ((bf16_t*)((bf16_t*)(ws + WS_XB)))
#define MEMB ((bf16_t*)((bf16_t*)(ws + WS_MEMB)))
#define COSA ((float*)((float*)(ws + WS_COSA)))
#define SINA ((float*)((float*)(ws + WS_SINA)))
#define COSR ((float*)((float*)(ws + WS_COSR)))
#define SINR ((float*)((float*)(ws + WS_SINR)))
#define SS0 ((float*)((float*)(ws + WS_SS0)))
#define SS1 ((float*)((float*)(ws + WS_SS1)))
#define SS2 ((float*)((float*)(ws + WS_SS2)))
#define SSM ((float*)((float*)(ws + WS_SSM)))
#define KX ((bf16_t*)((bf16_t*)(ws + WS_KX)))
#define VX ((bf16_t*)((bf16_t*)(ws + WS_VX)))
#define QX ((bf16_t*)((bf16_t*)(ws + WS_QX)))
#define OX ((bf16_t*)((bf16_t*)(ws + WS_OX)))
#define EXPI ((int*)((int*)(ws + WS_EXP)))
#define GATE ((float*)((float*)(ws + WS_GATE)))
#define Y ((bf16_t*)((bf16_t*)(ws + WS_Y)))
#define PQ ((bf16_t*)((bf16_t*)(ws + WS_Y)))
#define QA ((bf16_t*)((bf16_t*)(ws + WS_QA)))
#define KA ((bf16_t*)((bf16_t*)(ws + WS_KA)))
#define VA ((bf16_t*)((bf16_t*)(ws + WS_VA)))
#define QR ((bf16_t*)((bf16_t*)(ws + WS_QR)))
#define KR ((bf16_t*)((bf16_t*)(ws + WS_KR)))
#define VR ((bf16_t*)((bf16_t*)(ws + WS_VR)))
#define GR ((bf16_t*)((bf16_t*)(ws + WS_GR)))
#define UB ((unsigned char*)(ws + WS_UB))
#define VB ((unsigned char*)(ws + WS_VB))
#define SU ((float*)((float*)(ws + WS_SU)))
#define SV ((float*)((float*)(ws + WS_SV)))
__global__ void __launch_bounds__(NWAVES * 64, 2) fwd_kernel(Args args) {
    extern __shared__ __attribute__((aligned(16))) unsigned char lds_raw[];
    LAS unsigned char* lds = (LAS unsigned char*)lds_raw;
    const int tid = threadIdx.x, lane = tid & 63; const int wave = __builtin_amdgcn_readfirstlane(tid >> 6);
    const int G = gridDim.x; const int bx = blockIdx.x; const int vcu = (G % 8 == 0) ? (bx % 8) * (G / 8) + bx / 8 : bx;
    unsigned char* ws = args.ws;
    float* const out_base = args.out;
    for (int u = tid; u < (LDS_BYTES - MISC_OFF) / 4; u += NWAVES * 64) ((LAS unsigned*)(lds + MISC_OFF))[u] = 0u;
    __syncthreads();
    const int lo = args.ph_lo, hi = args.ph_hi;
    const bool use_bar = (hi - lo) > 1;
    XcdBarrier bar; bar.bar = (unsigned*)(ws + WS_CTL) + 1024; bar.x = 0; bar.st = nullptr;
    if (use_bar) bar = xcd_barrier_post((unsigned*)(ws + WS_CTL) + 1024, (volatile LAS unsigned*)(lds + MISC_OFF) + 8);
#ifdef ONLY_PHASE
#define PHASE_ON(k) ((k) == ONLY_PHASE)
#else
#define PHASE_ON(k) true
#endif
#define IN(k) (lo <= (k) && (k) < hi)
#ifdef REPEAT_PHASE
#define REP(k) for (int _rep = 0; _rep < (((k) == REPEAT_PHASE) ? 2 : 1); ++_rep)
#else
#define REP(k)
#endif
#define SEAM(k) do { if (IN(k) && IN((k) + 1)) xcd_barrier(bar); } while (0)
    const int gw = vcu * NWAVES + wave, NGW = G * NWAVES;

    REP(0) if (PHASE_ON(0) && IN(0)) {
        LAS float* scr = (LAS float*)(lds + wave * 8448);
        constexpr int I_IN = 32 * (IN_COLS / 32), I_XQ = 32 * 16;
        constexpr int NITEMS = I_IN + 2 * I_XQ;
        for (int it = gw; it < NITEMS; it += NGW) {
            int r = it;
            if (r < I_IN) { p0_transpose_item<true>(IN_w_in, IN_g_mix, DM, IN_COLS, WIN, 0, scr, r, lane); continue; } r -= I_IN;
            if (r < I_XQ) { p0_transpose_item<false>(IN_w_xk, IN_g_mem, DM, 512, WXKV, 0, scr, r, lane); continue; } r -= I_XQ;
            p0_transpose_item<false>(IN_w_xv, IN_g_mem, DM, 512, WXKV, 512, scr, r, lane);
        }
        for (int m = gw; m < T_TOK; m += 2 * NGW) row2_to_bf16(IN_x + (size_t)m * DM, XB + (size_t)m * DM, SS0 + m, (size_t)NGW, lane);
        for (int m = gw; m < MT; m += NGW) row_to_bf16(IN_mem + (size_t)m * DM, MEMB + (size_t)m * DM, SSM + m, lane);
        const int gt = vcu * (NWAVES * 64) + tid, NGT = G * NWAVES * 64;
        for (int i = gt; i < T_TOK * 128; i += NGT) { const int tok = i >> 7, f = i & 127; const float ang = (float)IN_positions[tok] * args.inv_freq[f]; float cc, sn; sincos_red(ang, cc, sn);
            COSR[i] = cc; SINR[i] = sn; }
        for (int i = gt; i < T_TOK * 32; i += NGT) { const int tok = i >> 5, f = i & 31; const float ang = (float)IN_positions[tok] * args.inv_freq[4 * f]; float cc, sn; sincos_red(ang, cc, sn);
            COSA[i] = cc; SINA[i] = sn; }
        for (int i = gt; i < T_TOK; i += NGT) { SS1[i] = 0.f; SS2[i] = 0.f; }
        __syncthreads();
    }
    SEAM(0);
    REP(1) if (PHASE_ON(1) && IN(1)) {
        pg8::Sched S; S.A = (const char*)XB; S.B = (const char*)WIN; S.nM = T_TOK / 256; S.nN = IN_COLS / 256; S.nwg = S.nM * S.nN;
        S.A2 = (const char*)MEMB; S.B2 = (const char*)WXKV; S.nM2 = MT / 256; S.nwg2 = (MT / 256) * 4; S.G = G; S.c = bx; S.WGM = WGM_P1; S.tstep = (size_t)256 * DM * 2;
        EpiP1 E{ws};
        pg8::gemm_phase<EpiP1>(lds, DM, S, E);
        unsigned* qctr = (unsigned*)(ws + WS_CTL) + 8192 + 64; volatile LAS unsigned* qw = (volatile LAS unsigned*)(lds + MISC_OFF) + 16;
        LAS float* scr = (LAS float*)(lds + wave * 8448);
        for (;;) {
            if (tid == 0) qw[0] = atomicAdd(qctr, 1u);
            __syncthreads(); const unsigned chunk = qw[0]; __syncthreads();
            if (chunk >= 640u + NF1) break;
            if (chunk < 640u) { int r = (int)chunk * 8 + wave;
                if (r < 2048) p0_transpose_item<false>(IN_w_out, nullptr, DM, DM, WOUT, 0, scr, r, lane);
                else if ((r -= 2048) < 512) p0_transpose_item<false>(IN_w_xq, IN_g_cross, DM, 512, WXQ, 0, scr, r, lane);
                else if ((r -= 512) < 512) p0_transpose_item<false>(IN_w_xo, nullptr, 512, DM, WXO, 0, scr, r, lane);
                else p0_transpose_item<false>(IN_w_pq, IN_g_ffn, DM, DM, WPQ, 0, scr, r - 512, lane);
            } else fp8_chunk((int)chunk - 640, wave, lane, IN_peer_u, IN_peer_v, IN_g_ffn, UB, VB, SU, SV);
        }
    }
    SEAM(1);
    REP(2) if (PHASE_ON(2) && IN(2)) {
        for (int u = vcu; u < 256; u += G) ret_state_unit(lds, u >> 3, u & 7, KR, VR, ret_state_base(ws, u >> 3));
        for (int u = vcu; u < 256; u += G) swa_unit(lds, u >> 5, (u >> 1) & 15, u & 1, QA, KA, VA, IN_sinks, IN_att_gain, Y);
    }
    SEAM(2);
    REP(3) if (PHASE_ON(3) && IN(3)) {
        for (int u = vcu; u < 512; u += G) { const int bh = u >> 4, n = u & 15; ret_chunk_unit(lds, bh >> 2, bh & 3, n, QR, KR, VR, GR, ret_state_base(ws, bh), IN_ret_gain, Y); }
    }
    SEAM(3);
    if (PHASE_ON(4) && IN(4)) {
        pg8::Sched S; S.A = (const char*)Y; S.B = (const char*)WOUT; S.WGM = WGM_P3; S.nM = T_TOK / 256; S.nN = DM / 256; S.nwg = S.nM * S.nN; S.A2 = nullptr; S.B2 = nullptr; S.nM2 = 1; S.nwg2 = 0; S.G = G; S.c = bx; S.tstep = (size_t)256 * DM * 2;
        EpiRes1 E{XB, SS1};
        pg8::gemm_phase<EpiRes1, false>(lds, DM, S, E);
    }
    SEAM(4);
    REP(5) if (PHASE_ON(5) && IN(5)) {
        pg8::Sched S; S.A = (const char*)XB; S.B = (const char*)WXQ; S.WGM = WGM_P4; S.nM = T_TOK / 256; S.nN = 2; S.nwg = S.nM * S.nN; S.A2 = nullptr; S.B2 = nullptr; S.nM2 = 1; S.nwg2 = 0; S.G = G; S.c = bx; S.tstep = (size_t)256 * DM * 2;
        EpiScale E{QX, 512, SS1, C3Q};
        pg8::gemm_phase<EpiScale>(lds, DM, S, E);
        unsigned* qctr = (unsigned*)(ws + WS_CTL) + 8192; volatile LAS unsigned* qw = (volatile LAS unsigned*)(lds + MISC_OFF) + 16;
        for (;;) {
            if (tid == 0) qw[0] = atomicAdd(qctr, 1u);
            __syncthreads(); const unsigned chunk = qw[0] + NF1; __syncthreads();
            if (chunk >= 2048u) break;
            fp8_chunk((int)chunk, wave, lane, IN_peer_u, IN_peer_v, IN_g_ffn, UB, VB, SU, SV);
        }
    }
    SEAM(5);
    REP(6) if (PHASE_ON(6) && IN(6)) { for (int u = vcu; u < 256; u += G) xattn_unit(lds, u >> 5, (u >> 3) & 3, u & 7, QX, KX, VX, OX); }
    SEAM(6);
    if (PHASE_ON(7) && IN(7)) {
        pg8::Sched S; S.A = (const char*)OX; S.B = (const char*)WXO; S.WGM = WGM_P6; S.nM = T_TOK / 256; S.nN = DM / 256; S.nwg = S.nM * S.nN; S.A2 = nullptr; S.B2 = nullptr; S.nM2 = 1; S.nwg2 = 0; S.G = G; S.c = bx; S.tstep = (size_t)256 * 512 * 2;
        EpiRes2 E{XB, SS2};
        pg8::gemm_phase<EpiRes2, false>(lds, 512, S, E);
    }
    SEAM(7);
    REP(8) if (PHASE_ON(8) && IN(8)) {
        pg8::Sched S; S.A = (const char*)XB; S.B = (const char*)WPQ; S.WGM = WGM_P7; S.nM = T_TOK / 256; S.nN = DM / 256; S.nwg = S.nM * S.nN; S.A2 = nullptr; S.B2 = nullptr; S.nM2 = 1; S.nwg2 = 0; S.G = G; S.c = bx; S.tstep = (size_t)256 * DM * 2;
        EpiScale E{PQ, DM, SS2, 1.f};
        pg8::gemm_phase<EpiScale>(lds, DM, S, E);
        asm volatile("s_waitcnt vmcnt(0)" ::: "memory"); __syncthreads();
        { pg8::Unit u; for (int i = 0; S.next(i, u); ++i) peer_topk_unit(lds, u.pm, u.pn, PQ, IN_subk, EXPI, GATE); }
    }
    SEAM(8);
    if (PHASE_ON(9) && IN(9)) {
        LAS float* gl = (LAS float*)(lds + 98304);
        for (int i = tid; i < DM; i += NWAVES * 64) { gl[i] = IN_g_ffn[i]; gl[DM + i] = IN_g_fin[i]; }
        __syncthreads();
        if (gw < T_TOK) peer_gather_wave(lds + wave * 12288, gl, gw, NGW, XB, UB, VB, SU, SV, EXPI, GATE, IN_out, lane);
    }
#undef IN
#undef SEAM
}

extern "C" void kernel_launch(void* const* d_in, const int* in_sizes, int n_in, void* d_out, int out_size, void* d_ws, size_t ws_size, hipStream_t stream) {
    static int grid = 0;
    if (grid == 0) {
        if (n_in != 21 || out_size != T_TOK * DM || ws_size < WS_END) { fprintf(stderr, "kernel_launch: unexpected problem (n_in %d out %d ws %zu)\n", n_in, out_size, ws_size); grid = -1; return; }
        int dev = 0, cus = 0;
        if (hipGetDevice(&dev) != hipSuccess || hipDeviceGetAttribute(&cus, hipDeviceAttributeMultiprocessorCount, dev) != hipSuccess) { grid = -1; return; }
        if (hipFuncSetAttribute((const void*)fwd_kernel, hipFuncAttributeMaxDynamicSharedMemorySize, LDS_BYTES) != hipSuccess) { fprintf(stderr, "kernel_launch: hipFuncSetAttribute failed\n"); grid = -1; return; }
        (void)hipGetLastError();
        grid = cus;
    }
    if (grid < 0) return;
    (void)hipMemsetAsync((char*)d_ws + WS_CTL, 0, CTL_ZERO_BYTES, stream);
    Args a{};
    for (int i = 0; i < 21; ++i) a.in[i] = d_in[i];
    a.out = (float*)d_out; a.ws = (unsigned char*)d_ws;
    for (int i = 0; i < 128; ++i) a.inv_freq[i] = (float)pow(10000.0, -(double)(2 * i) / 256.0);
#ifdef MK_PER_PHASE
    for (int p = 0; p < N_PHASES; ++p) { a.ph_lo = p; a.ph_hi = p + 1;
#ifdef REPEAT_LAUNCH
        if (p == REPEAT_LAUNCH) for (int r = 0; r < 4; ++r) hipLaunchKernelGGL(fwd_kernel, dim3(grid), dim3(NWAVES * 64), LDS_BYTES, stream, a);
#endif
        hipLaunchKernelGGL(fwd_kernel, dim3(grid), dim3(NWAVES * 64), LDS_BYTES, stream, a); }
#else
    a.ph_lo = 0; a.ph_hi = N_PHASES; hipLaunchKernelGGL(fwd_kernel, dim3(grid), dim3(NWAVES * 64), LDS_BYTES, stream, a);
#endif
}
```

```cpp
#include <hip/hip_runtime.h>
#include <cstdio>
#include <cstdint>
#include <cmath>
#ifndef WGM_P1
#define WGM_P1 4
#endif
#ifndef WGM_P3
#define WGM_P3 4
#endif
#ifndef WGM_P4
#define WGM_P4 4
#endif
#ifndef WGM_P6
#define WGM_P6 4
#endif
#ifndef WGM_P7
#define WGM_P7 4
#endif
namespace pg8 {
#define PG8_LAS __attribute__((address_space(3)))
typedef unsigned short bf16_t;
typedef short bf16x8 __attribute__((ext_vector_type(8)));
typedef float f32x4 __attribute__((ext_vector_type(4)));
typedef unsigned u32x4 __attribute__((ext_vector_type(4)));
typedef unsigned u32x2 __attribute__((ext_vector_type(2)));
constexpr int BM = 256, BK = 64, HALF = 128, HTB = HALF * BK * 2  , STAGE_BYTES = 8 * HTB, NXCD = 8;

__host__ __device__ __forceinline__ int lds_byte(int r, int c) { const int st = (r >> 4) * 2 + (c >> 5), rr = r & 15, cc = c & 31, ob = rr * 64 + cc * 2; return st * 1024 + (ob ^ (((ob >> 9) & 1) << 5)); }
__host__ __device__ __forceinline__ void stage_rc(int b, int& R, int& C) { const int st = b / 1024, sb = b % 1024, swz = sb ^ (((sb >> 9) & 1) << 5); R = (st >> 1) * 16 + swz / 64; C = (st & 1) * 32 + (swz % 64) / 2; }
__host__ __device__ __forceinline__ int perm32(int rho) { const int n = rho >> 4, i = rho & 15; return 8 * (i >> 2) + 4 * n + (i & 3); }

struct Unit { int pm, pn, kind; const char* a; const char* b; };

struct Sched {
    const char *A, *B, *A2, *B2; int nM, nN, nwg, nM2, nwg2, G, c, WGM; size_t tstep;
    __device__ __forceinline__ bool next(int i, Unit& u) const {
        const long L = (long)i * G + c;
        if (L < nwg) {
            int wgid = (int)L; { const int q = nwg / NXCD, r = nwg % NXCD, xcd = wgid % NXCD, off = wgid / NXCD; wgid = (xcd < r ? xcd * (q + 1) : r * (q + 1) + (xcd - r) * q) + off; }
            const int nig = WGM * nN, gid = wgid / nig, fm = gid * WGM, gsz = (nM - fm) < WGM ? (nM - fm) : WGM;
            u.pm = fm + ((wgid % nig) % gsz); u.pn = (wgid % nig) / gsz; u.kind = 0; u.a = A + (size_t)u.pm * tstep; u.b = B + (size_t)u.pn * tstep; return true;
        }
        const long L2 = L - nwg; if (L2 >= nwg2) return false;
        u.pm = (int)(L2 % nM2); u.pn = (int)(L2 / nM2); u.kind = 1; u.a = A2 + (size_t)u.pm * tstep; u.b = B2 + (size_t)u.pn * tstep; return true;
    }
};

__device__ __forceinline__ unsigned cvt_pk_bf16(float lo, float hi) { unsigned r; asm volatile("v_cvt_pk_bf16_f32 %0, %1, %2" : "=v"(r) : "v"(lo), "v"(hi)); return r; }

template <class Epi, bool ALIGN_EPI = true, bool SP2 = true>
__device__ __forceinline__ void gemm_phase(PG8_LAS unsigned char* lds, const int K, const Sched& S, const Epi& E) {
    const int tid = threadIdx.x, wid = __builtin_amdgcn_readfirstlane(tid >> 6), lane = tid & 63, wr = wid >> 2, wc = wid & 3, fr = lane & 15, fq = lane >> 4;
    const int nt = K / BK;
    unsigned voffA[2], voffB[2];
#pragma unroll
    for (int i = 0; i < 2; ++i) { int R, C; stage_rc(tid * 16 + i * 8192, R, C); const int Rb = Epi::PERM ? ((R & ~31) + perm32(R & 31)) : R;
        voffA[i] = (unsigned)(R * K + C) * 2u; voffB[i] = (unsigned)(Rb * K + C) * 2u; }
    const size_t kstep = (size_t)(BK * 2);
    const size_t hstep = (size_t)HALF * K * 2;
    const unsigned ldsw = (unsigned)wid * 1024u;
    const int aoff = lds_byte(wr * 64 + fr, fq * 8), boff = lds_byte(wc * 32 + fr, fq * 8);
#define PG8_SA(b, h) (((b) * 2 + (h)) * HTB)
#define PG8_SB(b, h) ((4 + (b) * 2 + (h)) * HTB)
#define PG8_STAGE(bufoff, gbase, voff) do { _Pragma("unroll") for (int _i = 0; _i < 2; ++_i) \
        __builtin_amdgcn_global_load_lds((const unsigned*)((const char*)(gbase) + (voff)[_i]), (PG8_LAS unsigned*)(lds + (bufoff) + ldsw + _i * 8192), 16, 0, 0); } while (0)
#define PG8_LDA(dst, b, h) do { _Pragma("unroll") for (int m = 0; m < 4; ++m) _Pragma("unroll") for (int k = 0; k < 2; ++k) dst[m][k] = *(const PG8_LAS bf16x8*)(lds + PG8_SA(b, h) + aoff + m * 2048 + k * 1024); } while (0)
#define PG8_LDB(dst, b, h) do { _Pragma("unroll") for (int n = 0; n < 2; ++n) _Pragma("unroll") for (int k = 0; k < 2; ++k) dst[n][k] = *(const PG8_LAS bf16x8*)(lds + PG8_SB(b, h) + boff + n * 2048 + k * 1024); } while (0)
#define PG8_MMA(ai, bj, At, Bt) do { __builtin_amdgcn_s_setprio(1); _Pragma("unroll") for (int m = 0; m < 4; ++m) _Pragma("unroll") for (int n = 0; n < 2; ++n) _Pragma("unroll") for (int k = 0; k < 2; ++k) \
        acc[ai][bj][m][n] = __builtin_amdgcn_mfma_f32_16x16x32_bf16(Bt[n][k], At[m][k], acc[ai][bj][m][n], 0, 0, 0); __builtin_amdgcn_s_setprio(0); } while (0)
#define PG8_WAIT_V(n) asm volatile("s_waitcnt vmcnt(" #n ")" ::: "memory")
#define PG8_WAIT_L(n) asm volatile("s_waitcnt lgkmcnt(" #n ")" ::: "memory")
#define PG8_BAR __builtin_amdgcn_s_barrier()
#define PG8_SCHED __builtin_amdgcn_sched_barrier(0)
    Unit cur, nxt; int ui = 0;
    if (!S.next(0, cur)) return;
    f32x4 acc[2][2][4][2];
#pragma unroll
    for (int a = 0; a < 2; ++a)
#pragma unroll
        for (int b = 0; b < 2; ++b)
#pragma unroll
            for (int m = 0; m < 4; ++m)
#pragma unroll
                for (int n = 0; n < 2; ++n) acc[a][b][m][n] = (f32x4){0.f, 0.f, 0.f, 0.f};
    bf16x8 At[4][2], B0[2][2], B1[2][2];
    const char* cA = cur.a; const char* cB = cur.b;
    if constexpr (SP2) {
        PG8_STAGE(PG8_SB(0, 0), cB, voffB); PG8_STAGE(PG8_SB(0, 1), cB + hstep, voffB); PG8_STAGE(PG8_SA(0, 0), cA, voffA); PG8_STAGE(PG8_SA(0, 1), cA + hstep, voffA);
        if (wr == 1) PG8_BAR;
        PG8_WAIT_V(2); PG8_BAR;
        PG8_STAGE(PG8_SB(1, 0), cB + kstep, voffB); PG8_STAGE(PG8_SA(1, 0), cA + kstep, voffA); PG8_STAGE(PG8_SB(1, 1), cB + hstep + kstep, voffB);
        PG8_WAIT_V(6); PG8_BAR;
    } else {
        PG8_STAGE(PG8_SB(0, 0), cB, voffB); PG8_STAGE(PG8_SA(0, 0), cA, voffA); PG8_STAGE(PG8_SB(0, 1), cB + hstep, voffB); PG8_STAGE(PG8_SA(0, 1), cA + hstep, voffA);
        if (wr == 1) PG8_BAR;
        PG8_WAIT_V(4); PG8_BAR;
        PG8_STAGE(PG8_SB(1, 0), cB + kstep, voffB); PG8_STAGE(PG8_SA(1, 0), cA + kstep, voffA); PG8_STAGE(PG8_SB(1, 1), cB + hstep + kstep, voffB);
        PG8_WAIT_V(6); PG8_BAR;
    }
    for (;;) {
        const bool has_next = S.next(ui + 1, nxt);
        const char* nA = has_next ? nxt.a : cA; const char* nB = has_next ? nxt.b : cB;
        for (int t = 0; t < nt; t += 2) {
            const bool last = (t == nt - 2);
            const char* a1 = cA + (size_t)(t + 1) * kstep;
            const char* a2 = last ? nA : cA + (size_t)(t + 2) * kstep; const char* b2 = last ? nB : cB + (size_t)(t + 2) * kstep;
            const char* a3 = a2 + kstep; const char* b3 = b2 + kstep;
            if constexpr (SP2) {
            PG8_LDB(B0, 0, 0); PG8_LDB(B1, 0, 1); PG8_SCHED; PG8_LDA(At, 0, 0); PG8_STAGE(PG8_SA(1, 1), a1 + hstep, voffA);
            PG8_WAIT_V(8); PG8_WAIT_L(0); PG8_BAR; PG8_MMA(0, 0, At, B0); PG8_MMA(0, 1, At, B1); PG8_BAR; PG8_SCHED;
            PG8_LDA(At, 0, 1); PG8_STAGE(PG8_SB(0, 0), b2, voffB); PG8_STAGE(PG8_SB(0, 1), b2 + hstep, voffB); PG8_STAGE(PG8_SA(0, 0), a2, voffA);
            PG8_WAIT_V(8); PG8_WAIT_L(0); PG8_BAR; PG8_MMA(1, 0, At, B0); PG8_MMA(1, 1, At, B1); PG8_BAR; PG8_SCHED;
            PG8_LDB(B0, 1, 0); PG8_LDB(B1, 1, 1); PG8_SCHED; PG8_LDA(At, 1, 0); PG8_STAGE(PG8_SA(0, 1), a2 + hstep, voffA);
            PG8_WAIT_V(8); PG8_WAIT_L(0); PG8_BAR; PG8_MMA(0, 0, At, B0); PG8_MMA(0, 1, At, B1); PG8_BAR; PG8_SCHED;
            PG8_LDA(At, 1, 1); PG8_STAGE(PG8_SB(1, 0), b3, voffB); PG8_STAGE(PG8_SB(1, 1), b3 + hstep, voffB); PG8_STAGE(PG8_SA(1, 0), a3, voffA);
            PG8_WAIT_V(8); PG8_WAIT_L(0); PG8_BAR; PG8_MMA(1, 0, At, B0); PG8_MMA(1, 1, At, B1); PG8_BAR; PG8_SCHED;
            } else {
            PG8_LDB(B0, 0, 0); PG8_SCHED; PG8_LDA(At, 0, 0); PG8_STAGE(PG8_SA(1, 1), a1 + hstep, voffA);
            PG8_WAIT_L(8); PG8_BAR; PG8_WAIT_L(0); PG8_MMA(0, 0, At, B0); PG8_BAR; PG8_SCHED;
            PG8_LDB(B1, 0, 1); PG8_STAGE(PG8_SB(0, 0), b2, voffB);
            PG8_BAR; PG8_WAIT_L(0); PG8_MMA(0, 1, At, B1); PG8_BAR;
            PG8_LDA(At, 0, 1); PG8_STAGE(PG8_SA(0, 0), a2, voffA);
            PG8_BAR; PG8_WAIT_L(0); PG8_MMA(1, 0, At, B0); PG8_BAR; PG8_SCHED;
            PG8_STAGE(PG8_SB(0, 1), b2 + hstep, voffB);
            PG8_WAIT_V(6); PG8_BAR; PG8_MMA(1, 1, At, B1); PG8_BAR;
            PG8_LDB(B0, 1, 0); PG8_SCHED; PG8_LDA(At, 1, 0); PG8_STAGE(PG8_SA(0, 1), a2 + hstep, voffA);
            PG8_WAIT_L(8); PG8_BAR; PG8_WAIT_L(0); PG8_MMA(0, 0, At, B0); PG8_BAR; PG8_SCHED;
            PG8_LDB(B1, 1, 1); PG8_STAGE(PG8_SB(1, 0), b3, voffB);
            PG8_BAR; PG8_WAIT_L(0); PG8_MMA(0, 1, At, B1); PG8_BAR;
            PG8_LDA(At, 1, 1); PG8_STAGE(PG8_SA(1, 0), a3, voffA);
            PG8_BAR; PG8_WAIT_L(0); PG8_MMA(1, 0, At, B0); PG8_BAR; PG8_SCHED;
            PG8_STAGE(PG8_SB(1, 1), b3 + hstep, voffB);
            PG8_WAIT_V(6); PG8_BAR; PG8_MMA(1, 1, At, B1); PG8_BAR;
            }
        }
        if constexpr (ALIGN_EPI) { if (wr == 0) PG8_BAR; }
        E(acc, cur, wr, wc, fr, fq);
        if (!has_next) break;
#pragma unroll
        for (int a = 0; a < 2; ++a)
#pragma unroll
            for (int b = 0; b < 2; ++b)
#pragma unroll
                for (int m = 0; m < 4; ++m)
#pragma unroll
                    for (int n = 0; n < 2; ++n) acc[a][b][m][n] = (f32x4){0.f, 0.f, 0.f, 0.f};
        cur = nxt; cA = nA; cB = nB; ++ui;
        if constexpr (ALIGN_EPI) { if (wr == 1) PG8_BAR; }
    }
    PG8_WAIT_V(0);
    if constexpr (!ALIGN_EPI) { if (wr == 0) PG8_BAR; }
    PG8_BAR;
#undef PG8_SA
#undef PG8_SB
#undef PG8_STAGE
#undef PG8_LDA
#undef PG8_LDB
#undef PG8_MMA
#undef PG8_WAIT_V
#undef PG8_WAIT_L
#undef PG8_BAR
#undef PG8_SCHED
}
}
constexpr int T_TOK = 16384, DM = 2048, SEQ = 2048, NBATCH = 8, MEML = 256, MT = NBATCH * MEML, IN_COLS = 5376;
constexpr float EPS = 1e-6f, GN_EPS = 1e-5f, LOG2E = 1.4426950408889634f;
constexpr float C2Q = 0.125f * LOG2E;
constexpr float C3Q = 0.08838834764831845f * LOG2E;
constexpr size_t MiB = 1u << 20;
constexpr size_t WS_CTL = 0, CTL_ZERO_BYTES = 64 * 1024;
constexpr size_t WS_WIN = 2 * MiB, WS_WOUT = 23 * MiB, WS_WXQ = 31 * MiB, WS_WXKV = 33 * MiB, WS_WXO = 37 * MiB, WS_WPQ = 39 * MiB;
constexpr size_t WS_XB = 48 * MiB, WS_MEMB = 112 * MiB;
constexpr size_t WS_COSA = 120 * MiB, WS_SINA = 122 * MiB, WS_COSR = 124 * MiB, WS_SINR = 132 * MiB;
constexpr size_t WS_SS0 = 140 * MiB, WS_SS1 = WS_SS0 + 65536, WS_SS2 = WS_SS1 + 65536, WS_SSM = WS_SS2 + 65536;
constexpr size_t WS_KX = 141 * MiB, WS_VX = 143 * MiB, WS_QX = 145 * MiB, WS_OX = 161 * MiB, WS_EXP = 177 * MiB, WS_GATE = 185 * MiB;
constexpr size_t WS_Y = 193 * MiB;
constexpr size_t WS_QA = 257 * MiB, WS_KA = 289 * MiB, WS_VA = 293 * MiB, WS_QR = 297 * MiB, WS_KR = 329 * MiB, WS_VR = 361 * MiB, WS_GR = 393 * MiB;
constexpr size_t WS_UB = 425 * MiB, WS_VB = 457 * MiB, WS_SU = 489 * MiB, WS_SV = WS_SU + 65536;
constexpr size_t WS_END = 490 * MiB;

#define GAS __attribute__((address_space(1)))
#define LAS __attribute__((address_space(3)))
typedef unsigned short bf16_t;
typedef short bf16x8 __attribute__((ext_vector_type(8)));
typedef short v4i16 __attribute__((ext_vector_type(4)));
typedef float f32x4 __attribute__((ext_vector_type(4)));
typedef float f32x2 __attribute__((ext_vector_type(2)));
typedef unsigned u32x4 __attribute__((ext_vector_type(4)));
typedef unsigned u32x2 __attribute__((ext_vector_type(2)));
typedef __bf16 bf16x2_t __attribute__((ext_vector_type(2)));

__device__ __forceinline__ unsigned pk2(float lo, float hi) { f32x2 v = {lo, hi}; bf16x2_t b = __builtin_convertvector(v, bf16x2_t); return __builtin_bit_cast(unsigned, b); }
__device__ __forceinline__ float bf_lo(unsigned w) { return __uint_as_float(w << 16); }
__device__ __forceinline__ float bf_hi(unsigned w) { return __uint_as_float(w & 0xffff0000u); }
__device__ __forceinline__ float wave_sum(float v) {
#pragma unroll
    for (int o = 1; o < 64; o <<= 1) v += __shfl_xor(v, o);
    return v;
}

struct EpiP1 {
    static constexpr bool PERM = true;
    unsigned char* ws;
    __device__ __forceinline__ void operator()(const pg8::f32x4 (&acc)[2][2][4][2], const pg8::Unit& u, int wr, int wc, int fr, int fq) const {
        if (u.kind == 1) {
            const float* ssm = (const float*)(ws + WS_SSM);
            bf16_t* O = (bf16_t*)(ws + ((u.pn < 2) ? WS_KX : WS_VX)); const int cb = (u.pn & 1) * 256 + wc * 32 + 8 * fq;
#pragma unroll
            for (int ai = 0; ai < 2; ++ai)
#pragma unroll
                for (int m = 0; m < 4; ++m) { const int row = u.pm * 256 + ai * 128 + wr * 64 + m * 16 + fr; const float rs = rsqrtf(ssm[row] * (1.f / DM) + EPS);
#pragma unroll
                    for (int bj = 0; bj < 2; ++bj) { const f32x4 v0 = acc[ai][bj][m][0] * rs, v1 = acc[ai][bj][m][1] * rs;
                        u32x4 w; w.x = pk2(v0[0], v0[1]); w.y = pk2(v0[2], v0[3]); w.z = pk2(v1[0], v1[1]); w.w = pk2(v1[2], v1[3]);
                        *(u32x4*)(O + (size_t)row * 512 + cb + bj * 128) = w; } }
            return;
        }
        const float* ss0 = (const float*)(ws + WS_SS0);
        const int pn = u.pn;
        size_t ooff, ctoff, stoff; int pitch, colbase, i0, half, tw; float sc, zl = 0.f; bool rope;
        if (pn < 4)        { ooff = WS_QA; pitch = 1024; colbase = (4 * pn + wc) * 64; i0 = 8 * fq; half = 32; tw = 32; ctoff = WS_COSA; stoff = WS_SINA; sc = C2Q; rope = true; }
        else if (pn == 4)  { if (wc < 2) { ooff = WS_KA; colbase = wc * 64; rope = true; } else { ooff = WS_VA; colbase = (wc - 2) * 64; rope = false; }
                             pitch = 128; i0 = 8 * fq; half = 32; tw = 32; ctoff = WS_COSA; stoff = WS_SINA; sc = 1.f; }
        else { const int q = (pn - 5) >> 2, h = (pn - 5) & 3; ooff = WS_QR + (size_t)q * (32 * MiB); pitch = 1024; colbase = h * 256; i0 = 32 * wc + 8 * fq; half = 128; tw = 128; ctoff = WS_COSR; stoff = WS_SINR;
               sc = (q == 1) ? 0.0625f : 1.f; rope = (q < 2); if (q == 1) zl = log2f(1.f - exp2f(-5.f - (float)h)); }
        bf16_t* O = (bf16_t*)(ws + ooff); const float* ct = (const float*)(ws + ctoff); const float* st = (const float*)(ws + stoff);
#pragma unroll
        for (int ai = 0; ai < 2; ++ai)
#pragma unroll
            for (int m = 0; m < 4; ++m) { const int row = u.pm * 256 + ai * 128 + wr * 64 + m * 16 + fr; const float rs = rsqrtf(ss0[row] * (1.f / DM) + EPS) * sc * __builtin_amdgcn_exp2f((float)(127 - (row & 127)) * zl);
                f32x4 a0 = acc[ai][0][m][0] * rs, a1 = acc[ai][0][m][1] * rs, b0 = acc[ai][1][m][0] * rs, b1 = acc[ai][1][m][1] * rs;
                if (rope) { const f32x4 c0 = *(const f32x4*)(ct + (size_t)row * tw + i0), c1 = *(const f32x4*)(ct + (size_t)row * tw + i0 + 4);
                            const f32x4 s0 = *(const f32x4*)(st + (size_t)row * tw + i0), s1 = *(const f32x4*)(st + (size_t)row * tw + i0 + 4);
                            const f32x4 o0 = a0 * c0 - b0 * s0, o1 = a1 * c1 - b1 * s1, p0 = b0 * c0 + a0 * s0, p1 = b1 * c1 + a1 * s1; a0 = o0; a1 = o1; b0 = p0; b1 = p1; }
                bf16_t* rp = O + (size_t)row * pitch + colbase + i0;
                u32x4 w; w.x = pk2(a0[0], a0[1]); w.y = pk2(a0[2], a0[3]); w.z = pk2(a1[0], a1[1]); w.w = pk2(a1[2], a1[3]); *(u32x4*)rp = w;
                w.x = pk2(b0[0], b0[1]); w.y = pk2(b0[2], b0[3]); w.z = pk2(b1[0], b1[1]); w.w = pk2(b1[2], b1[3]); *(u32x4*)(rp + half) = w; }
    }
};
struct EpiRes1 {
    static constexpr bool PERM = true;
    bf16_t* XB; float* ss;
    __device__ __forceinline__ void operator()(const pg8::f32x4 (&acc)[2][2][4][2], const pg8::Unit& u, int wr, int wc, int fr, int fq) const {
        const int col0 = u.pn * 256 + wc * 32 + 8 * fq;
#pragma unroll
        for (int ai = 0; ai < 2; ++ai) {
            u32x4 r[4][2];
#pragma unroll
            for (int m = 0; m < 4; ++m) { const size_t off = (size_t)(u.pm * 256 + ai * 128 + wr * 64 + m * 16 + fr) * DM + col0;
#pragma unroll
                for (int bj = 0; bj < 2; ++bj) r[m][bj] = *(const u32x4*)(XB + off + bj * 128); }
#pragma unroll
            for (int m = 0; m < 4; ++m) { const int row = u.pm * 256 + ai * 128 + wr * 64 + m * 16 + fr; const size_t off = (size_t)row * DM + col0; float s = 0.f;
#pragma unroll
                for (int bj = 0; bj < 2; ++bj) { const size_t o = off + bj * 128;
                    const u32x4 q = r[m][bj];
                    const f32x4 v0 = (f32x4){bf_lo(q.x), bf_hi(q.x), bf_lo(q.y), bf_hi(q.y)} + acc[ai][bj][m][0], v1 = (f32x4){bf_lo(q.z), bf_hi(q.z), bf_lo(q.w), bf_hi(q.w)} + acc[ai][bj][m][1];
                    u32x4 w; w.x = pk2(v0[0], v0[1]); w.y = pk2(v0[2], v0[3]); w.z = pk2(v1[0], v1[1]); w.w = pk2(v1[2], v1[3]); *(u32x4*)(XB + o) = w;
                    s += ((v0[0] * v0[0] + v0[1] * v0[1]) + (v0[2] * v0[2] + v0[3] * v0[3])) + ((v1[0] * v1[0] + v1[1] * v1[1]) + (v1[2] * v1[2] + v1[3] * v1[3])); }
                s += __shfl_xor(s, 16); s += __shfl_xor(s, 32);
                if (fq == 0) atomicAdd(ss + row, s); }
            asm volatile("" ::: "memory");
        }
    }
};
struct EpiRes2 {
    static constexpr bool PERM = true;
    bf16_t* XB; float* ss;
    __device__ __forceinline__ void operator()(const pg8::f32x4 (&acc)[2][2][4][2], const pg8::Unit& u, int wr, int wc, int fr, int fq) const {
        const int col0 = u.pn * 256 + wc * 32 + 8 * fq;
        u32x4 r[2][4][2];
#pragma unroll
        for (int ai = 0; ai < 2; ++ai)
#pragma unroll
            for (int m = 0; m < 4; ++m) { const size_t off = (size_t)(u.pm * 256 + ai * 128 + wr * 64 + m * 16 + fr) * DM + col0;
#pragma unroll
                for (int bj = 0; bj < 2; ++bj) r[ai][m][bj] = *(const u32x4*)(XB + off + bj * 128); }
#pragma unroll
        for (int ai = 0; ai < 2; ++ai)
#pragma unroll
            for (int m = 0; m < 4; ++m) { const int row = u.pm * 256 + ai * 128 + wr * 64 + m * 16 + fr; const size_t off = (size_t)row * DM + col0; float s = 0.f;
#pragma unroll
                for (int bj = 0; bj < 2; ++bj) { const size_t o = off + bj * 128; const u32x4 q = r[ai][m][bj];
                    const f32x4 v0 = (f32x4){bf_lo(q.x), bf_hi(q.x), bf_lo(q.y), bf_hi(q.y)} + acc[ai][bj][m][0], v1 = (f32x4){bf_lo(q.z), bf_hi(q.z), bf_lo(q.w), bf_hi(q.w)} + acc[ai][bj][m][1];
                    u32x4 w; w.x = pk2(v0[0], v0[1]); w.y = pk2(v0[2], v0[3]); w.z = pk2(v1[0], v1[1]); w.w = pk2(v1[2], v1[3]); *(u32x4*)(XB + o) = w;
                    s += ((v0[0] * v0[0] + v0[1] * v0[1]) + (v0[2] * v0[2] + v0[3] * v0[3])) + ((v1[0] * v1[0] + v1[1] * v1[1]) + (v1[2] * v1[2] + v1[3] * v1[3])); }
                s += __shfl_xor(s, 16); s += __shfl_xor(s, 32);
                if (fq == 0) atomicAdd(ss + row, s); }
    }
};
struct EpiScale {
    static constexpr bool PERM = true;
    bf16_t* O; int ldc; const float* ss; float scale;
    __device__ __forceinline__ void operator()(const pg8::f32x4 (&acc)[2][2][4][2], const pg8::Unit& u, int wr, int wc, int fr, int fq) const {
        const int col0 = u.pn * 256 + wc * 32 + 8 * fq;
#pragma unroll
        for (int ai = 0; ai < 2; ++ai)
#pragma unroll
            for (int m = 0; m < 4; ++m) { const int row = u.pm * 256 + ai * 128 + wr * 64 + m * 16 + fr; const float rs = rsqrtf(ss[row] * (1.f / DM) + EPS) * scale;
#pragma unroll
                for (int bj = 0; bj < 2; ++bj) { const f32x4 v0 = acc[ai][bj][m][0] * rs, v1 = acc[ai][bj][m][1] * rs;
                    u32x4 w; w.x = pk2(v0[0], v0[1]); w.y = pk2(v0[2], v0[3]); w.z = pk2(v1[0], v1[1]); w.w = pk2(v1[2], v1[3]);
                    *(u32x4*)(O + (size_t)row * ldc + col0 + bj * 128) = w; } }
    }
};
#define XB_TMO      128
#define XB_XCNT(j)  (256  + 64 * (j))
#define XB_XSUB(j)  (1280 + 64 * (j))
#define XB_XGEN(j)  (2304 + 64 * (j))
#define XB_TOP      3328
#define XB_TOPGEN   3392
#define XCD_BAR_WORDS 3456
#define XB_SPIN_CAP (1u << 18)
__device__ __forceinline__ unsigned xb_ld(unsigned* p)              { return __hip_atomic_load(p, __ATOMIC_RELAXED, __HIP_MEMORY_SCOPE_AGENT); }
__device__ __forceinline__ unsigned xb_add(unsigned* p, unsigned v) { return __hip_atomic_fetch_add(p, v, __ATOMIC_RELAXED, __HIP_MEMORY_SCOPE_AGENT); }
__device__ __forceinline__ unsigned xb_xcc_id() { return (unsigned)__builtin_amdgcn_s_getreg((3 << 11) | 20) & 0xFu; }
#define XB_SPIN(cond, bar) do { unsigned _sp = 0; while (cond) { __builtin_amdgcn_s_sleep(1); \
    if ((++_sp & 255u) == 0u) { if (xb_ld(&(bar)[XB_TMO])) break; if (_sp > XB_SPIN_CAP) { atomicAdd(&(bar)[XB_TMO], 1u); break; } } } } while (0)
struct XcdBarrier { unsigned* bar; unsigned x; volatile LAS unsigned* st; };
__device__ __forceinline__ XcdBarrier xcd_barrier_post(unsigned* bar, volatile LAS unsigned* st) {
    XcdBarrier b; b.bar = bar; b.x = xb_xcc_id(); b.st = st;
    if (threadIdx.x == 0) (void)xb_add(&bar[XB_XCNT(b.x)], 1u);
    return b;
}
__device__ __forceinline__ void xcd_barrier_complete(unsigned* bar, unsigned x, unsigned& nloc, unsigned& nx) {
    const unsigned G = gridDim.x * gridDim.y * gridDim.z;
    unsigned sum, cnt, mine, sp = 0u;
    for (;;) {
        sum = 0u; cnt = 0u; mine = 0u;
#pragma unroll
        for (unsigned j = 0; j < 16; ++j) { const unsigned c = xb_ld(&bar[XB_XCNT(j)]); sum += c; cnt += (c > 0u) ? 1u : 0u; mine = (j == x) ? c : mine; }
        if (sum == G) break;
        __builtin_amdgcn_s_sleep(1);
        if ((++sp & 255u) == 0u) { if (xb_ld(&bar[XB_TMO])) break; if (sp > XB_SPIN_CAP) { atomicAdd(&bar[XB_TMO], 1u); break; } }
    }
    nloc = mine > 0u ? mine : 1u; nx = cnt > 0u ? cnt : 1u;
}
__device__ __forceinline__ void xcd_barrier(const XcdBarrier& b) {
    asm volatile("s_waitcnt vmcnt(0)" ::: "memory");
    __syncthreads();
    if (threadIdx.x == 0) {
        unsigned* bar = b.bar;
        __builtin_amdgcn_s_waitcnt(0);
        unsigned nloc = b.st[0], nx = b.st[1];
        if (nloc == 0u) { xcd_barrier_complete(bar, b.x, nloc, nx); b.st[0] = nloc; b.st[1] = nx; }
        const unsigned old = xb_add(&bar[XB_XSUB(b.x)], 1u);
        const unsigned gen = old / nloc;
        if (old + 1u == (gen + 1u) * nloc) {
            __builtin_amdgcn_fence(__ATOMIC_RELEASE, "agent");
            asm volatile("s_waitcnt vmcnt(0)" ::: "memory");
            const unsigned og = xb_add(&bar[XB_TOP], 1u);
            const unsigned tg = og / nx;
            if (og + 1u == (tg + 1u) * nx) xb_add(&bar[XB_TOPGEN], 1u);
            else XB_SPIN(xb_ld(&bar[XB_TOPGEN]) == tg, bar);
            __builtin_amdgcn_fence(__ATOMIC_ACQUIRE, "agent");
            xb_add(&bar[XB_XGEN(b.x)], 1u);
            asm volatile("s_waitcnt vmcnt(0)" ::: "memory");
        } else {
            XB_SPIN(xb_ld(&bar[XB_XGEN(b.x)]) == gen, bar);
            __builtin_amdgcn_fence(__ATOMIC_ACQUIRE, "agent");
            asm volatile("s_waitcnt vmcnt(0)" ::: "memory");
        }
    }
    __syncthreads();
}

__device__ __forceinline__ int win_phys(int n) {
    if (n < 1024) { const int head = n >> 6, d = n & 63; return (head >> 2) * 256 + (d >> 5) * 128 + (head & 3) * 32 + (d & 31); }
    if (n < 1280) { const int m = n - 1024, kind = m >> 7, hh = (m & 127) >> 6, d = m & 63; return 1024 + (d >> 5) * 128 + (kind * 2 + hh) * 32 + (d & 31); }
    return n;
}
template <bool PERMW>
__device__ __forceinline__ void p0_transpose_item(const float* W, const float* gk, int K, int N, bf16_t* WT, int row_off, LAS float* scr, int item, int lane) {
    const int nblk = N / 32, kb = item / nblk, nb = item % nblk, k0 = 64 * kb, n0 = 32 * nb;
    float wv[32];
#pragma unroll
    for (int i = 0; i < 32; ++i) { const int kk = 2 * i + (lane >> 5); wv[i] = W[(size_t)(k0 + kk) * N + n0 + (lane & 31)]; }
#pragma unroll
    for (int i = 0; i < 32; ++i) { const int kk = 2 * i + (lane >> 5); const float g = gk ? gk[k0 + kk] : 1.f; scr[kk * 33 + (lane & 31)] = wv[i] * g; }
    asm volatile("s_waitcnt lgkmcnt(0)" ::: "memory");
    const int c = lane & 7; const int pr0 = PERMW ? win_phys(n0) : n0;
#pragma unroll
    for (int j = 0; j < 4; ++j) { const int n = (lane >> 3) + 8 * j; const LAS float* s = scr + (8 * c) * 33 + n;
        u32x4 o; o.x = pk2(s[0 * 33], s[1 * 33]); o.y = pk2(s[2 * 33], s[3 * 33]); o.z = pk2(s[4 * 33], s[5 * 33]); o.w = pk2(s[6 * 33], s[7 * 33]);
        *(u32x4*)(WT + (size_t)(row_off + pr0 + n) * K + k0 + 8 * c) = o; }
    asm volatile("s_waitcnt lgkmcnt(0)" ::: "memory");
}
__device__ __forceinline__ void row_to_bf16(const float* xrow, bf16_t* orow, float* ssq, int lane) {
    const f32x4* xr = (const f32x4*)xrow + lane; f32x4 v[8]; float s = 0.f;
#pragma unroll
    for (int j = 0; j < 8; ++j) { v[j] = xr[64 * j]; s += (v[j][0] * v[j][0] + v[j][1] * v[j][1]) + (v[j][2] * v[j][2] + v[j][3] * v[j][3]); }
    s = wave_sum(s);
    u32x2* o8 = (u32x2*)orow + lane;
#pragma unroll
    for (int j = 0; j < 8; ++j) { u32x2 w; w.x = pk2(v[j][0], v[j][1]); w.y = pk2(v[j][2], v[j][3]); o8[64 * j] = w; }
    if (lane == 0) *ssq = s;
}
__device__ __forceinline__ void row2_to_bf16(const float* xrow, bf16_t* orow, float* ssq, size_t rstep, int lane) {
    const f32x4* xr0 = (const f32x4*)xrow + lane; const f32x4* xr1 = (const f32x4*)(xrow + rstep * DM) + lane; f32x4 v[8], q[8]; float s0 = 0.f, s1 = 0.f;
#pragma unroll
    for (int j = 0; j < 8; ++j) { v[j] = xr0[64 * j]; q[j] = xr1[64 * j]; }
#pragma unroll
    for (int j = 0; j < 8; ++j) { s0 += (v[j][0] * v[j][0] + v[j][1] * v[j][1]) + (v[j][2] * v[j][2] + v[j][3] * v[j][3]); s1 += (q[j][0] * q[j][0] + q[j][1] * q[j][1]) + (q[j][2] * q[j][2] + q[j][3] * q[j][3]); }
    s0 = wave_sum(s0); s1 = wave_sum(s1);
    u32x2* o0 = (u32x2*)orow + lane; u32x2* o1 = (u32x2*)(orow + rstep * DM) + lane;
#pragma unroll
    for (int j = 0; j < 8; ++j) { u32x2 w; w.x = pk2(v[j][0], v[j][1]); w.y = pk2(v[j][2], v[j][3]); o0[64 * j] = w; w.x = pk2(q[j][0], q[j][1]); w.y = pk2(q[j][2], q[j][3]); o1[64 * j] = w; }
    if (lane == 0) { ssq[0] = s0; ssq[rstep] = s1; }
}
__device__ __forceinline__ void sincos_red(float ang, float& c, float& s) {
    const float k = rintf(ang * 0.15915494309189535f);
    float r = fmaf(-k, 6.28125f, ang); r = fmaf(-k, 1.9353071795864769e-3f, r);
    const float rev = r * 0.15915494309189535f;
    s = __builtin_amdgcn_sinf(rev); c = __builtin_amdgcn_cosf(rev);
}

#define MFMA16(a, b, c) __builtin_amdgcn_mfma_f32_16x16x32_bf16((a), (b), (c), 0, 0, 0)
__device__ __forceinline__ bf16x8 pack_p(const f32x4& lo, const f32x4& hi) {
    u32x4 w; w.x = pk2(lo[0], lo[1]); w.y = pk2(lo[2], lo[3]); w.z = pk2(hi[0], hi[1]); w.w = pk2(hi[2], hi[3]); return __builtin_bit_cast(bf16x8, w);
}
__device__ __forceinline__ bf16x8 vt_frag(LAS const unsigned char* p, int stride16) {
    const v4i16 lo = __builtin_amdgcn_ds_read_tr16_b64_v4i16((LAS v4i16*)p);
    const v4i16 hi = __builtin_amdgcn_ds_read_tr16_b64_v4i16((LAS v4i16*)(p + stride16));
    return (bf16x8){lo[0], lo[1], lo[2], lo[3], hi[0], hi[1], hi[2], hi[3]};
}

__device__ __forceinline__ void swa_unit(LAS unsigned char* lds, int b, int n, int kvh, const bf16_t* QA, const bf16_t* KA, const bf16_t* VA,
                                         const float* sinks, const float* att_gain, bf16_t* Y) {
    constexpr int KS = 144;
    const int tid = threadIdx.x, lane = tid & 63, c = lane & 15, g = lane >> 4; const int w = __builtin_amdgcn_readfirstlane(tid >> 6);
    LAS unsigned char* Kl = lds; LAS unsigned char* Vl = lds + 256 * KS;
    for (int i = tid; i < 2048; i += 512) { const int key = i >> 3, ch = i & 7, pos = 128 * (n - 1) + key; u32x4 kv = {0u, 0u, 0u, 0u}, vv = {0u, 0u, 0u, 0u};
        if (pos >= 0) { const size_t off = (size_t)(b * SEQ + pos) * 128 + kvh * 64 + ch * 8; kv = *(const u32x4*)(KA + off); vv = *(const u32x4*)(VA + off); }
        *(LAS u32x4*)(Kl + key * KS + ch * 16) = kv; *(LAS u32x4*)(Vl + key * KS + ch * 16) = vv; }
    __syncthreads();
    const int hq = kvh * 8 + w; const float sink = sinks[hq] * LOG2E;
    bf16x8 qn[2];
#pragma unroll
    for (int ks = 0; ks < 2; ++ks) qn[ks] = *(const bf16x8*)(QA + (size_t)(b * SEQ + 128 * n + c) * 1024 + hq * 64 + ks * 32 + 8 * g);
    float blo[4], bhi[4];
#pragma unroll
    for (int r = 0; r < 4; ++r) { blo[r] = (4 * g + r > c) ? 0.f : -INFINITY; bhi[r] = (4 * g + r <= c) ? 0.f : -INFINITY; }
#pragma unroll 1
    for (int a2 = 0; a2 < 4; ++a2) {
        const int kb0 = 32 * a2;
#pragma unroll
      for (int par = 0; par < 2; ++par) {
        const int a = 2 * a2 + par; const int t = b * SEQ + 128 * n + 16 * a + c;
        bf16x8 qf[2];
#pragma unroll
        for (int ks = 0; ks < 2; ++ks) { qf[ks] = qn[ks]; qn[ks] = *(const bf16x8*)(QA + (size_t)(t + (a < 7 ? 16 : 0)) * 1024 + hq * 64 + ks * 32 + 8 * g); }
        f32x4 s[10]; float sbk[10]; float m = sink;
#pragma unroll
        for (int blk = 0; blk < 10; ++blk) { const int key0 = kb0 + 16 * blk;
            const bool skip = (par == 0) ? (blk == 9) : (blk == 0), lowb = (par == 0) ? (blk == 0) : (blk == 1), highb = (par == 0) ? (blk == 8) : (blk == 9);
            sbk[blk] = (n > 0 || key0 >= 128) ? 0.f : -INFINITY;
            if (skip) { s[blk] = (f32x4){0.f, 0.f, 0.f, 0.f}; continue; }
            f32x4 acc = {0.f, 0.f, 0.f, 0.f};
#pragma unroll
            for (int ks = 0; ks < 2; ++ks) { const bf16x8 kf = *(LAS const bf16x8*)(Kl + (key0 + c) * KS + (ks * 32 + 8 * g) * 2); acc = MFMA16(kf, qf[ks], acc); }
            if (lowb) {
#pragma unroll
                for (int r = 0; r < 4; ++r) acc[r] += blo[r]; }
            if (highb) {
#pragma unroll
                for (int r = 0; r < 4; ++r) acc[r] += bhi[r]; }
            m = fmaxf(m, fmaxf(fmaxf(acc[0], acc[1]), fmaxf(acc[2], acc[3])) + sbk[blk]);
            s[blk] = acc; }
        m = fmaxf(m, __shfl_xor(m, 16)); m = fmaxf(m, __shfl_xor(m, 32));
        float l = 0.f;
#pragma unroll
        for (int blk = 0; blk < 10; ++blk) { const bool skip = (par == 0) ? (blk == 9) : (blk == 0);
            if (skip) continue;
            const float mb = m - sbk[blk];
#pragma unroll
            for (int r = 0; r < 4; ++r) { const float p = __builtin_amdgcn_exp2f(s[blk][r] - mb); s[blk][r] = p; l += p; } }
        l += __shfl_xor(l, 16); l += __shfl_xor(l, 32); l += __builtin_amdgcn_exp2f(sink - m);
        f32x4 o[4];
#pragma unroll
        for (int db = 0; db < 4; ++db) o[db] = (f32x4){0.f, 0.f, 0.f, 0.f};
#pragma unroll
        for (int kp = 0; kp < 5; ++kp) { const bf16x8 pf = pack_p(s[2 * kp], s[2 * kp + 1]); const int key0 = kb0 + 32 * kp;
#pragma unroll
            for (int db = 0; db < 4; ++db) { const bf16x8 af = vt_frag(Vl + (key0 + 4 * g + (c >> 2)) * KS + (16 * db + 4 * (c & 3)) * 2, 16 * KS); o[db] = MFMA16(af, pf, o[db]); } }
        const float inv = 1.f / l; float q2 = 0.f;
#pragma unroll
        for (int db = 0; db < 4; ++db) { o[db] = o[db] * inv; q2 += (o[db][0] * o[db][0] + o[db][1] * o[db][1]) + (o[db][2] * o[db][2] + o[db][3] * o[db][3]); }
        q2 += __shfl_xor(q2, 16); q2 += __shfl_xor(q2, 32);
        const float rms = rsqrtf(q2 * (1.f / 64.f) + EPS);
#pragma unroll
        for (int db = 0; db < 4; ++db) { const int col = hq * 64 + 16 * db + 4 * g; const f32x4 gn = *(const f32x4*)(att_gain + col); const f32x4 v = o[db] * rms * gn;
            u32x2 wv; wv.x = pk2(v[0], v[1]); wv.y = pk2(v[2], v[3]); *(u32x2*)(Y + (size_t)t * DM + col) = wv; }
      }
    }
    __syncthreads();
}

__device__ __forceinline__ bf16_t* ret_state_base(unsigned char* ws, int bh) {
    return (bf16_t*)(ws + ((bh < 25) ? WS_QX + (size_t)bh * 1966080 : WS_MEMB + (size_t)(bh - 25) * 1966080));
}
__device__ __forceinline__ void ret_state_unit(LAS unsigned char* lds, int bh, int dr, const bf16_t* KR, const bf16_t* VR, bf16_t* ST) {
    constexpr int RS = 544, TB = 64 * RS, KSS = 80, BUFB = 2 * TB + 128 * KSS;
    int tid_ = threadIdx.x; asm volatile("" : "+v"(tid_));
    const int tid = tid_, lane = tid & 63, c = lane & 15, g = lane >> 4; const int w = __builtin_amdgcn_readfirstlane(tid >> 6);
    const int b = bh >> 2, h = bh & 3; const size_t rowb = (size_t)b * SEQ; const int hoff = h * 256;
    const float g128 = exp2f(128.f * log2f(1.f - exp2f(-5.f - (float)h)));
    u32x4 vA[8], kA, vB[8], kB;
#define ST_LOAD(V, K, m) do { const int m_ = ((m) < 15) ? (m) : 14; _Pragma("unroll") for (int i = 0; i < 8; ++i) { const int id = tid + 512 * i, key = id >> 5, ch = id & 31; \
            V[i] = *(const u32x4*)(VR + (rowb + 128 * m_ + key) * 1024 + hoff + ch * 8); } \
        K = *(const u32x4*)(KR + (rowb + 128 * m_ + (tid >> 2)) * 1024 + hoff + 32 * dr + (tid & 3) * 8); } while (0)
#define ST_WRITE(V, K, buf) do { LAS unsigned char* B_ = lds + (buf) * BUFB; _Pragma("unroll") for (int i = 0; i < 8; ++i) { const int id = tid + 512 * i, key = id >> 5, ch = id & 31; \
            *(LAS u32x4*)(B_ + (key >> 6) * TB + (key & 63) * RS + ch * 16) = V[i]; } \
        *(LAS u32x4*)(B_ + 2 * TB + (tid >> 2) * KSS + (tid & 3) * 16) = K; } while (0)
    f32x4 acc[2][2];
#pragma unroll
    for (int i = 0; i < 2; ++i)
#pragma unroll
        for (int j = 0; j < 2; ++j) acc[i][j] = (f32x4){0.f, 0.f, 0.f, 0.f};
#define ST_COMPUTE(m, buf) do { LAS const unsigned char* B_ = lds + (buf) * BUFB; \
        _Pragma("unroll") for (int kp = 0; kp < 4; ++kp) { bf16x8 af[2], bfr[2]; \
            _Pragma("unroll") for (int rb = 0; rb < 2; ++rb) af[rb] = vt_frag(B_ + 2 * TB + (32 * kp + 4 * g + (c >> 2)) * KSS + (16 * rb + 4 * (c & 3)) * 2, 16 * KSS); \
            _Pragma("unroll") for (int j = 0; j < 2; ++j) bfr[j] = vt_frag(B_ + (kp >> 1) * TB + (32 * (kp & 1) + 4 * g + (c >> 2)) * RS + (16 * (2 * w + j) + 4 * (c & 3)) * 2, 16 * RS); \
            _Pragma("unroll") for (int rb = 0; rb < 2; ++rb) _Pragma("unroll") for (int j = 0; j < 2; ++j) acc[rb][j] = MFMA16(af[rb], bfr[j], acc[rb][j]); } \
        _Pragma("unroll") for (int rb = 0; rb < 2; ++rb) _Pragma("unroll") for (int j = 0; j < 2; ++j) { acc[rb][j] = acc[rb][j] * g128; \
            u32x2 o_; o_.x = pk2(acc[rb][j][0], acc[rb][j][1]); o_.y = pk2(acc[rb][j][2], acc[rb][j][3]); \
            *(u32x2*)(ST + (size_t)(m) * 65536 + (16 * (2 * w + j) + c) * 256 + 32 * dr + 16 * rb + 4 * g) = o_; } } while (0)
    ST_LOAD(vA, kA, 0); ST_LOAD(vB, kB, 1);
    ST_WRITE(vA, kA, 0); ST_LOAD(vA, kA, 2);
    __syncthreads();
#pragma unroll 1
    for (int m = 0; m < 15; m += 2) {
        ST_COMPUTE(m, 0);
        ST_WRITE(vB, kB, 1); ST_LOAD(vB, kB, m + 3);
        __syncthreads();
        if (m + 1 < 15) ST_COMPUTE(m + 1, 1);
        ST_WRITE(vA, kA, 0); ST_LOAD(vA, kA, m + 4);
        __syncthreads();
    }
#undef ST_LOAD
#undef ST_WRITE
#undef ST_COMPUTE
}
__device__ __forceinline__ void ret_chunk_unit(LAS unsigned char* lds, int b, int h, int n, const bf16_t* QR, const bf16_t* KR, const bf16_t* VR, const bf16_t* GR, const bf16_t* ST,
                                               const float* ret_gain, bf16_t* Y) {
    constexpr int RS = 544, TB = 64 * RS;
    int tid_ = threadIdx.x; asm volatile("" : "+v"(tid_));
    const int tid = tid_, lane = tid & 63, c = lane & 15, g = lane >> 4; const int w = __builtin_amdgcn_readfirstlane(tid >> 6);
    const size_t rowb = (size_t)b * SEQ; const int hoff = h * 256;
    const int ql = 16 * w + c; const size_t t = rowb + 128 * n + ql;
    const float lg = log2f(1.f - exp2f(-5.f - (float)h));
    bf16x8 qf[8];
#pragma unroll
    for (int ks = 0; ks < 8; ++ks) qf[ks] = *(const bf16x8*)(QR + t * 1024 + hoff + ks * 32 + 8 * g);
    f32x4 o[16];
#pragma unroll
    for (int db = 0; db < 16; ++db) o[db] = (f32x4){0.f, 0.f, 0.f, 0.f};
    u32x4 pk[4], pv[4];
    const bf16_t* Sn = ST + (size_t)(n > 0 ? n - 1 : 0) * 65536;
#define RC_LOAD(st) do { int tl = tid; asm volatile("" : "+v"(tl)); if ((st) < 4) { _Pragma("unroll") for (int i = 0; i < 4; ++i) { const int id = tl + 512 * i; pk[i] = *(const u32x4*)(Sn + (size_t)(st) * 16384 + id * 8); } } \
        else { _Pragma("unroll") for (int i = 0; i < 4; ++i) { const int id = tl + 512 * i, key = id >> 5, ch = id & 31; const size_t off = (rowb + 128 * n + 64 * ((st) - 4) + key) * 1024 + hoff + ch * 8; \
            pk[i] = *(const u32x4*)(KR + off); pv[i] = *(const u32x4*)(VR + off); } } } while (0)
#define RC_WRITE(buf, st) do { int tl = tid; asm volatile("" : "+v"(tl)); _Pragma("unroll") for (int i = 0; i < 4; ++i) { const int id = tl + 512 * i, key = id >> 5, ch = id & 31; \
        *(LAS u32x4*)(lds + (buf) * 2 * TB + key * RS + ch * 16) = pk[i]; if ((st) >= 4) *(LAS u32x4*)(lds + (buf) * 2 * TB + TB + key * RS + ch * 16) = pv[i]; } } while (0)
    const int st0 = (n > 0) ? 0 : 4;
    if (n > 0) { RC_LOAD(0); RC_WRITE(0, 0); } else { RC_LOAD(4); RC_WRITE(0, 4); }
    __syncthreads();
#pragma unroll
    for (int st = 0; st < 6; ++st) {
        if (st >= st0) {
            const int buf = st & 1;
            LAS const unsigned char* Kl = lds + buf * 2 * TB; LAS const unsigned char* Vl = Kl + TB;
            if (st + 1 < 6) RC_LOAD(st + 1);
            if (st < 4) {
#pragma unroll
                for (int blk = 0; blk < 4; ++blk) { f32x4 acc = {0.f, 0.f, 0.f, 0.f};
#pragma unroll
                    for (int ks = 0; ks < 8; ++ks) { const bf16x8 kf = *(LAS const bf16x8*)(Kl + (16 * blk + c) * RS + (ks * 32 + 8 * g) * 2); acc = MFMA16(kf, qf[ks], acc); }
                    o[(st < 4 ? 4 * st : 0) + blk] = acc; }
                __builtin_amdgcn_sched_barrier(0);
            } else if (64 * (st - 4) <= 16 * w + 15) {
                f32x4 s[4];
#pragma unroll
                for (int blk = 0; blk < 4; ++blk) { f32x4 acc = {0.f, 0.f, 0.f, 0.f};
#pragma unroll
                    for (int ks = 0; ks < 8; ++ks) { const bf16x8 kf = *(LAS const bf16x8*)(Kl + (16 * blk + c) * RS + (ks * 32 + 8 * g) * 2); acc = MFMA16(kf, qf[ks], acc); }
#pragma unroll
                    for (int r = 0; r < 4; ++r) { const int d = ql - (64 * (st - 4) + 16 * blk + 4 * g + r); acc[r] = (d >= 0) ? acc[r] : 0.f; }
                    s[blk] = acc; }
#pragma unroll
                for (int kp = 0; kp < 2; ++kp) { const bf16x8 pf = pack_p(s[2 * kp], s[2 * kp + 1]);
#pragma unroll
                    for (int db = 0; db < 16; ++db) { const bf16x8 af = vt_frag(Vl + (32 * kp + 4 * g + (c >> 2)) * RS + (16 * db + 4 * (c & 3)) * 2, 16 * RS); o[db] = MFMA16(af, pf, o[db]); }
                    __builtin_amdgcn_sched_barrier(0); }
            }
            if (st + 1 < 6) RC_WRITE(buf ^ 1, st + 1);
            __syncthreads();
            __builtin_amdgcn_sched_barrier(0);
        }
    }
#undef RC_LOAD
#undef RC_WRITE
    { const float qs = __builtin_amdgcn_exp2f((float)(ql - 127) * lg);
#pragma unroll
      for (int db = 0; db < 16; ++db) o[db] = o[db] * qs; }
    float s1 = 0.f;
#pragma unroll
    for (int db = 0; db < 16; ++db) s1 += (o[db][0] + o[db][1]) + (o[db][2] + o[db][3]);
    s1 += __shfl_xor(s1, 16); s1 += __shfl_xor(s1, 32);
    const float mu = s1 * (1.f / 256.f); float s2 = 0.f;
#pragma unroll
    for (int db = 0; db < 16; ++db) { o[db] = o[db] - mu; s2 += (o[db][0] * o[db][0] + o[db][1] * o[db][1]) + (o[db][2] * o[db][2] + o[db][3] * o[db][3]); }
    s2 += __shfl_xor(s2, 16); s2 += __shfl_xor(s2, 32);
    const float rstd = rsqrtf(s2 * (1.f / 256.f) + GN_EPS);
#pragma unroll
    for (int db = 0; db < 16; ++db) { const int col = hoff + 16 * db + 4 * g; const f32x4 gn = *(const f32x4*)(ret_gain + col); const u32x2 gw = *(const u32x2*)(GR + t * 1024 + col);
        const float z0 = bf_lo(gw.x), z1 = bf_hi(gw.x), z2 = bf_lo(gw.y), z3 = bf_hi(gw.y);
        f32x4 v = o[db] * rstd * gn;
        v[0] *= z0 / (1.f + __expf(-z0)); v[1] *= z1 / (1.f + __expf(-z1)); v[2] *= z2 / (1.f + __expf(-z2)); v[3] *= z3 / (1.f + __expf(-z3));
        u32x2 wv; wv.x = pk2(v[0], v[1]); wv.y = pk2(v[2], v[3]); *(u32x2*)(Y + t * DM + 1024 + col) = wv; }
}

__device__ __forceinline__ void xattn_unit(LAS unsigned char* lds, int b, int hx, int qblk, const bf16_t* QX, const bf16_t* KX, const bf16_t* VX, bf16_t* OX) {
    constexpr int KS = 288;
    const int tid = threadIdx.x, lane = tid & 63, c = lane & 15, g = lane >> 4; const int w = __builtin_amdgcn_readfirstlane(tid >> 6);
    LAS unsigned char* Kl = lds; LAS unsigned char* Vl = lds + 256 * KS;
    for (int i = tid; i < 4096; i += 512) { const int key = i >> 4, ch = i & 15; const size_t off = (size_t)(b * MEML + key) * 512 + hx * 128 + ch * 8;
        *(LAS u32x4*)(Kl + key * KS + ch * 16) = *(const u32x4*)(KX + off); *(LAS u32x4*)(Vl + key * KS + ch * 16) = *(const u32x4*)(VX + off); }
    __syncthreads();
    bf16x8 qn[4];
#pragma unroll
    for (int ks = 0; ks < 4; ++ks) qn[ks] = *(const bf16x8*)(QX + ((size_t)b * SEQ + 256 * qblk + 16 * w + c) * 512 + hx * 128 + ks * 32 + 8 * g);
#pragma unroll 1
    for (int pass = 0; pass < 2; ++pass) {
        const size_t t = (size_t)b * SEQ + 256 * qblk + 128 * pass + 16 * w + c;
        bf16x8 qf[4];
#pragma unroll
        for (int ks = 0; ks < 4; ++ks) { qf[ks] = qn[ks]; qn[ks] = *(const bf16x8*)(QX + (t + (pass == 0 ? 128 : 0)) * 512 + hx * 128 + ks * 32 + 8 * g); }
        f32x4 s[16]; float m = -INFINITY;
#pragma unroll
        for (int blk = 0; blk < 16; ++blk) { f32x4 acc = {0.f, 0.f, 0.f, 0.f};
#pragma unroll
            for (int ks = 0; ks < 4; ++ks) { const bf16x8 kf = *(LAS const bf16x8*)(Kl + (16 * blk + c) * KS + (ks * 32 + 8 * g) * 2); acc = MFMA16(kf, qf[ks], acc); }
            m = fmaxf(fmaxf(fmaxf(acc[0], acc[1]), fmaxf(acc[2], acc[3])), m); s[blk] = acc; __builtin_amdgcn_sched_barrier(0); }
        m = fmaxf(m, __shfl_xor(m, 16)); m = fmaxf(m, __shfl_xor(m, 32));
        float l = 0.f;
#pragma unroll
        for (int blk = 0; blk < 16; ++blk)
#pragma unroll
            for (int r = 0; r < 4; ++r) { const float p = __builtin_amdgcn_exp2f(s[blk][r] - m); s[blk][r] = p; l += p; }
        l += __shfl_xor(l, 16); l += __shfl_xor(l, 32);
        f32x4 o[8];
#pragma unroll
        for (int db = 0; db < 8; ++db) o[db] = (f32x4){0.f, 0.f, 0.f, 0.f};
#pragma unroll
        for (int kp = 0; kp < 8; ++kp) { const bf16x8 pf = pack_p(s[2 * kp], s[2 * kp + 1]);
#pragma unroll
            for (int db = 0; db < 8; ++db) { const bf16x8 af = vt_frag(Vl + (32 * kp + 4 * g + (c >> 2)) * KS + (16 * db + 4 * (c & 3)) * 2, 16 * KS); o[db] = MFMA16(af, pf, o[db]); }
            __builtin_amdgcn_sched_barrier(0); }
        const float inv = 1.f / l;
#pragma unroll
        for (int db = 0; db < 8; ++db) { const f32x4 v = o[db] * inv; u32x2 wv; wv.x = pk2(v[0], v[1]); wv.y = pk2(v[2], v[3]); *(u32x2*)(OX + t * 512 + hx * 128 + 16 * db + 4 * g) = wv; }
    }
    __syncthreads();
}

__device__ __forceinline__ int mono_i(float x) { int i = __float_as_int(x); return i ^ ((i >> 31) & 0x7fffffff); }
__device__ __forceinline__ float mono_f(int i) { return __int_as_float(i ^ ((i >> 31) & 0x7fffffff)); }
#define INS16(L, v) do { int _v = (v); _Pragma("unroll") for (int _k = 0; _k < 16; ++_k) { const int _t = max(L[_k], _v); _v = min(L[_k], _v); L[_k] = _t; } } while (0)
#define CE_DESC(x, y) do { const int _h = max((x), (y)), _l = min((x), (y)); (x) = _h; (y) = _l; } while (0)
#define SORT16_DESC(L) do { \
    CE_DESC(L[0], L[1]); \
    CE_DESC(L[2], L[3]); \
    CE_DESC(L[0], L[2]); \
    CE_DESC(L[1], L[3]); \
    CE_DESC(L[1], L[2]); \
    CE_DESC(L[4], L[5]); \
    CE_DESC(L[6], L[7]); \
    CE_DESC(L[4], L[6]); \
    CE_DESC(L[5], L[7]); \
    CE_DESC(L[5], L[6]); \
    CE_DESC(L[0], L[4]); \
    CE_DESC(L[2], L[6]); \
    CE_DESC(L[2], L[4]); \
    CE_DESC(L[1], L[5]); \
    CE_DESC(L[3], L[7]); \
    CE_DESC(L[3], L[5]); \
    CE_DESC(L[1], L[2]); \
    CE_DESC(L[3], L[4]); \
    CE_DESC(L[5], L[6]); \
    CE_DESC(L[8], L[9]); \
    CE_DESC(L[10], L[11]); \
    CE_DESC(L[8], L[10]); \
    CE_DESC(L[9], L[11]); \
    CE_DESC(L[9], L[10]); \
    CE_DESC(L[12], L[13]); \
    CE_DESC(L[14], L[15]); \
    CE_DESC(L[12], L[14]); \
    CE_DESC(L[13], L[15]); \
    CE_DESC(L[13], L[14]); \
    CE_DESC(L[8], L[12]); \
    CE_DESC(L[10], L[14]); \
    CE_DESC(L[10], L[12]); \
    CE_DESC(L[9], L[13]); \
    CE_DESC(L[11], L[15]); \
    CE_DESC(L[11], L[13]); \
    CE_DESC(L[9], L[10]); \
    CE_DESC(L[11], L[12]); \
    CE_DESC(L[13], L[14]); \
    CE_DESC(L[0], L[8]); \
    CE_DESC(L[4], L[12]); \
    CE_DESC(L[4], L[8]); \
    CE_DESC(L[2], L[10]); \
    CE_DESC(L[6], L[14]); \
    CE_DESC(L[6], L[10]); \
    CE_DESC(L[2], L[4]); \
    CE_DESC(L[6], L[8]); \
    CE_DESC(L[10], L[12]); \
    CE_DESC(L[1], L[9]); \
    CE_DESC(L[5], L[13]); \
    CE_DESC(L[5], L[9]); \
    CE_DESC(L[3], L[11]); \
    CE_DESC(L[7], L[15]); \
    CE_DESC(L[7], L[11]); \
    CE_DESC(L[3], L[5]); \
    CE_DESC(L[7], L[9]); \
    CE_DESC(L[11], L[13]); \
    CE_DESC(L[1], L[2]); \
    CE_DESC(L[3], L[4]); \
    CE_DESC(L[5], L[6]); \
    CE_DESC(L[7], L[8]); \
    CE_DESC(L[9], L[10]); \
    CE_DESC(L[11], L[12]); \
    CE_DESC(L[13], L[14]); \
} while (0)

__device__ __forceinline__ void bitonic_fix16(int (&L)[16]) {
    CE_DESC(L[0], L[8]); CE_DESC(L[1], L[9]); CE_DESC(L[2], L[10]); CE_DESC(L[3], L[11]); CE_DESC(L[4], L[12]); CE_DESC(L[5], L[13]); CE_DESC(L[6], L[14]); CE_DESC(L[7], L[15]);
    CE_DESC(L[0], L[4]); CE_DESC(L[1], L[5]); CE_DESC(L[2], L[6]); CE_DESC(L[3], L[7]); CE_DESC(L[8], L[12]); CE_DESC(L[9], L[13]); CE_DESC(L[10], L[14]); CE_DESC(L[11], L[15]);
    CE_DESC(L[0], L[2]); CE_DESC(L[1], L[3]); CE_DESC(L[4], L[6]); CE_DESC(L[5], L[7]); CE_DESC(L[8], L[10]); CE_DESC(L[9], L[11]); CE_DESC(L[12], L[14]); CE_DESC(L[13], L[15]);
    CE_DESC(L[0], L[1]); CE_DESC(L[2], L[3]); CE_DESC(L[4], L[5]); CE_DESC(L[6], L[7]); CE_DESC(L[8], L[9]); CE_DESC(L[10], L[11]); CE_DESC(L[12], L[13]); CE_DESC(L[14], L[15]);
}
__device__ __forceinline__ void merge16(int (&L)[16], int xm) {
    int P[16];
#pragma unroll
    for (int i = 0; i < 16; ++i) P[i] = __shfl_xor(L[i], xm);
#pragma unroll
    for (int i = 0; i < 16; ++i) L[i] = max(L[i], P[15 - i]);
    bitonic_fix16(L);
}
__device__ __forceinline__ void peer_topk_unit(LAS unsigned char* lds, int pm, int h, const bf16_t* PQ, const float* subk, int* EXP, float* GATE) {
    constexpr int KS = 272;
    const int tid = threadIdx.x, lane = tid & 63, c = lane & 15, g = lane >> 4; const int w = __builtin_amdgcn_readfirstlane(tid >> 6);
    const float* sk = subk + (size_t)h * 2 * 128 * 128;
    for (int i = tid; i < 8192; i += 512) { const int row = i >> 5, ch = i & 31; const f32x4 v = *(const f32x4*)(sk + (size_t)row * 128 + ch * 4);
        u32x2 wv; wv.x = pk2(v[0], v[1]); wv.y = pk2(v[2], v[3]); *(LAS u32x2*)(lds + row * KS + ch * 8) = wv; }
    __syncthreads();
#pragma unroll 1
    for (int grp = 0; grp < 2; ++grp) {
        const size_t t = (size_t)pm * 256 + 32 * w + 16 * grp + c;
        int S1[16], S2[16];
        bf16x8 qall[2][4];
#pragma unroll
        for (int p = 0; p < 2; ++p)
#pragma unroll
            for (int ks = 0; ks < 4; ++ks) qall[p][ks] = *(const bf16x8*)(PQ + t * DM + h * 256 + p * 128 + ks * 32 + 8 * g);
#pragma unroll
        for (int p = 0; p < 2; ++p) {
            bf16x8 qf[4];
#pragma unroll
            for (int ks = 0; ks < 4; ++ks) qf[ks] = qall[p][ks];
            int A[16], B[16];
#pragma unroll
            for (int blk = 0; blk < 8; ++blk) { f32x4 acc = {0.f, 0.f, 0.f, 0.f};
#pragma unroll
                for (int ks = 0; ks < 4; ++ks) { const bf16x8 kf = *(LAS const bf16x8*)(lds + (p * 128 + 16 * blk + c) * KS + (ks * 32 + 8 * g) * 2); acc = MFMA16(kf, qf[ks], acc); }
#pragma unroll
                for (int r = 0; r < 4; ++r) { const int idx = 16 * blk + 4 * g + r; const int key = (mono_i(acc[r]) & ~127) | (127 - idx); if (blk < 4) A[4 * blk + r] = key; else B[4 * (blk - 4) + r] = key; }
                __builtin_amdgcn_sched_barrier(0); }
            SORT16_DESC(A); SORT16_DESC(B);
#pragma unroll
            for (int i = 0; i < 16; ++i) A[i] = max(A[i], B[15 - i]);
            bitonic_fix16(A);
            merge16(A, 16); merge16(A, 32);
#pragma unroll
            for (int k = 0; k < 16; ++k) { if (p == 0) S1[k] = A[k]; else S2[k] = A[k]; }
        }
        float s1v[16], s2v[16];
#pragma unroll
        for (int k = 0; k < 16; ++k) { s1v[k] = mono_f(S1[k] & ~127); s2v[k] = mono_f(S2[k] & ~127); }
        int Mx[16];
#pragma unroll
        for (int k = 0; k < 16; ++k) Mx[k] = (int)0x80000000;
#define STAIR4(a0, b0, a1, b1, a2, b2, a3, b3) do { const float _c0 = s1v[a0] + s2v[b0], _c1 = s1v[a1] + s2v[b1], _c2 = s1v[a2] + s2v[b2], _c3 = s1v[a3] + s2v[b3]; \
        const float _m = (g == 0) ? _c0 : (g == 1) ? _c1 : (g == 2) ? _c2 : _c3; const int _cd = (g == 0) ? (255 - (16 * a0 + b0)) : (g == 1) ? (255 - (16 * a1 + b1)) : (g == 2) ? (255 - (16 * a2 + b2)) : (255 - (16 * a3 + b3)); \
        INS16(Mx, (mono_i(_m) & ~255) | _cd); } while (0)
#define STAIR2(a0, b0, a1, b1) do { const float _c0 = s1v[a0] + s2v[b0], _c1 = s1v[a1] + s2v[b1]; const float _m = (g == 0) ? _c0 : _c1; const int _cd = (g == 0) ? (255 - (16 * a0 + b0)) : (255 - (16 * a1 + b1)); \
        const int _key = (mono_i(_m) & ~255) | _cd; INS16(Mx, (g < 2) ? _key : (int)0x80000000); } while (0)
        STAIR4(0, 0, 0, 1, 0, 2, 0, 3);
        STAIR4(0, 4, 0, 5, 0, 6, 0, 7);
        STAIR4(0, 8, 0, 9, 0, 10, 0, 11);
        STAIR4(0, 12, 0, 13, 0, 14, 0, 15);
        STAIR4(1, 0, 1, 1, 1, 2, 1, 3);
        STAIR4(1, 4, 1, 5, 1, 6, 1, 7);
        STAIR4(2, 0, 2, 1, 2, 2, 2, 3);
        STAIR4(2, 4, 3, 0, 3, 1, 3, 2);
        STAIR4(3, 3, 4, 0, 4, 1, 4, 2);
        STAIR4(5, 0, 5, 1, 6, 0, 6, 1);
        STAIR4(7, 0, 7, 1, 8, 0, 9, 0);
        STAIR4(10, 0, 11, 0, 12, 0, 13, 0);
        STAIR2(14, 0, 15, 0);
#undef STAIR4
#undef STAIR2
        merge16(Mx, 16); merge16(Mx, 32);
        const float top = mono_f(Mx[0] & ~255); float wg[4]; int ex[4]; float wsum = 0.f;
#pragma unroll
        for (int i = 0; i < 4; ++i) { const int key = (g == 0) ? Mx[i] : (g == 1) ? Mx[4 + i] : (g == 2) ? Mx[8 + i] : Mx[12 + i];
            wg[i] = __expf(mono_f(key & ~255) - top); wsum += wg[i];
            const int ab = 255 - (key & 255), a = ab >> 4, bb = ab & 15; int e1 = 0, e2 = 0;
#pragma unroll
            for (int k = 0; k < 16; ++k) { e1 = (a == k) ? (127 - (S1[k] & 127)) : e1; e2 = (bb == k) ? (127 - (S2[k] & 127)) : e2; }
            ex[i] = e1 * 128 + e2; }
        wsum += __shfl_xor(wsum, 16); wsum += __shfl_xor(wsum, 32);
        const float inv = 1.f / wsum;
        *(int4*)(EXP + t * 128 + h * 16 + 4 * g) = make_int4(ex[0], ex[1], ex[2], ex[3]);
        *(f32x4*)(GATE + t * 128 + h * 16 + 4 * g) = (f32x4){wg[0] * inv, wg[1] * inv, wg[2] * inv, wg[3] * inv};
    }
    __syncthreads();
}
typedef __bf16 v32bf16 __attribute__((ext_vector_type(32)));
typedef unsigned v6u32 __attribute__((ext_vector_type(6)));
constexpr int ROWB = 1024;
__device__ __forceinline__ float fdot2bf(bf16x2_t a, bf16x2_t b, float c) { return __builtin_amdgcn_fdot2_f32_bf16(a, b, c, false); }
__device__ __forceinline__ void row_to_fp6(const float* src, const float* colgain, unsigned char* dst, float* inv, int lane) {
    f32x4 v[8]; float am = 0.f;
#pragma unroll
    for (int j = 0; j < 8; ++j) { v[j] = *(const f32x4*)(src + 32 * lane + 4 * j); if (colgain) v[j] = v[j] * *(const f32x4*)(colgain + 32 * lane + 4 * j);
        am = fmaxf(am, fmaxf(fmaxf(fabsf(v[j][0]), fabsf(v[j][1])), fmaxf(fabsf(v[j][2]), fabsf(v[j][3])))); }
#pragma unroll
    for (int o = 1; o < 64; o <<= 1) am = fmaxf(am, __shfl_xor(am, o));
    float S = 1.f;
    if (am > 1e-30f) S = __uint_as_float(__float_as_uint(6.f / am) & 0x7f800000u);
    unsigned pk[4] = {0u, 0u, 0u, 0u};
#pragma unroll
    for (int j = 0; j < 8; ++j)
#pragma unroll
        for (int i = 0; i < 4; ++i) { const float t = v[j][i] * S, a = fabsf(t);
            unsigned cd = (a < 0.25f) ? 0u : (a < 0.75f) ? 1u : (a < 1.25f) ? 2u : (a < 1.75f) ? 3u : (a < 2.5f) ? 4u : (a < 3.5f) ? 5u : (a < 5.f) ? 6u : 7u;
            if (t < 0.f) cd |= 8u;
            const int e = 4 * j + i; pk[e >> 3] |= cd << ((e & 7) * 4); }
    *(u32x4*)(dst + 16 * lane) = (u32x4){pk[0], pk[1], pk[2], pk[3]};
    if (lane == 0) *inv = 1.f / S;
}
__device__ __forceinline__ v32bf16 sw_unpack6(v6u32 s) {
    v32bf16 r;
#pragma unroll
    for (int e = 0; e < 32; ++e) { const int bit = 6 * e, dw = bit >> 5, sh = bit & 31; unsigned cd = s[dw] >> sh; if (sh > 26) cd |= s[dw + 1] << (32 - sh); cd &= 63u;
        const unsigned m = cd & 31u; float a = (m < 16u) ? (float)m * 0.125f : (m < 24u) ? 2.f + (float)(m - 16u) * 0.25f : 4.f + (float)(m - 24u) * 0.5f; if (cd & 32u) a = -a; r[e] = (__bf16)a; }
    return r;
}
constexpr int RING = 8;
typedef unsigned v16u32 __attribute__((ext_vector_type(16)));
typedef float v32f32 __attribute__((ext_vector_type(32)));
__device__ __forceinline__ bf16x2_t fp4_pair_bf(unsigned w, int b) {
    switch (b & 3) { case 0: return __builtin_amdgcn_cvt_scalef32_pk_bf16_fp4(w, 1.0f, 0); case 1: return __builtin_amdgcn_cvt_scalef32_pk_bf16_fp4(w, 1.0f, 1);
                     case 2: return __builtin_amdgcn_cvt_scalef32_pk_bf16_fp4(w, 1.0f, 2); default: return __builtin_amdgcn_cvt_scalef32_pk_bf16_fp4(w, 1.0f, 3); }
}
__device__ __forceinline__ f32x2 fp4_pair(unsigned w, int b) {
    switch (b & 3) { case 0: return __builtin_amdgcn_cvt_scalef32_pk_f32_fp4(w, 1.0f, 0); case 1: return __builtin_amdgcn_cvt_scalef32_pk_f32_fp4(w, 1.0f, 1);
                     case 2: return __builtin_amdgcn_cvt_scalef32_pk_f32_fp4(w, 1.0f, 2); default: return __builtin_amdgcn_cvt_scalef32_pk_f32_fp4(w, 1.0f, 3); }
}
__device__ __forceinline__ bf16x2_t as_pair(unsigned w) { return __builtin_bit_cast(bf16x2_t, w); }
#define PAIR(r, p) as_pair((r)[(p)])
#define PG_EW(p)  ((LAS int*)(wb + 512 + (p) * 512))
#define PG_SU(p)  ((LAS float*)(wb + 1536 + (p) * 512))
#define PG_GV(p)  ((LAS float*)(wb + 2560 + (p) * 512))
#define PG_ST(p)  ((LAS f32x4*)(wb + 4096 + (p) * 4096))
__device__ __forceinline__ void peer_gather_wave(LAS unsigned char* wb, LAS const float* gl, int tfirst, int tstep, const bf16_t* X,
                                                 const unsigned char* UBp, const unsigned char* VBp, const float* SUp, const float* SVp, const int* EXP, const float* GATEp, float* OUT, int lane, bool lockstep) {
    LAS float* cw = (LAS float*)wb;
    const __amdgpu_buffer_rsrc_t rsu = __builtin_amdgcn_make_buffer_rsrc((void*)UBp, 0, 16384 * ROWB, 0x00020000), rsv = __builtin_amdgcn_make_buffer_rsrc((void*)VBp, 0, 16384 * ROWB, 0x00020000);
    const int lo16 = 16 * lane;
    u32x4 xq[4]; int kA, kB, s0k, s1k; float su0, su1, sv0, sv1, gt0, gt1; bf16x2_t xb[16];
    u32x4 ra[RING];
    const int eloc = ((lane >> 5) & 1) * 8 + ((lane >> 4) & 1) * 4 + ((lane >> 3) & 1) * 2 + ((lane >> 2) & 1);
#define ROWLOAD(BASE, slot, EW, k) do { const int _so = (__builtin_amdgcn_readfirstlane((EW)[(k)]) >> 7) * ROWB; \
        ra[slot] = __builtin_bit_cast(u32x4, __builtin_amdgcn_raw_buffer_load_b128(((BASE) == UBp) ? rsu : rsv, lo16, _so, 0)); } while (0)
#define ROWLOADK(BASE, slot, key) do { const int _so = ((key) >> 7) * ROWB; ra[slot] = __builtin_bit_cast(u32x4, __builtin_amdgcn_raw_buffer_load_b128(((BASE) == UBp) ? rsu : rsv, lo16, _so, 0)); } while (0)
#define ROWPAIR(slot, p) fp4_pair(ra[slot][(p) >> 2], (p) & 3)
#define TOK_FETCH(t) do { const bf16_t* _xr = X + (size_t)(t) * DM + 32 * lane; _Pragma("unroll") for (int j = 0; j < 4; ++j) xq[j] = *(const u32x4*)(_xr + 8 * j); \
        kA = EXP[(size_t)(t) * 128 + lane]; kB = EXP[(size_t)(t) * 128 + 64 + lane]; } while (0)
#define TOK_SORT(t) do { int k0 = (kA << 7) | lane, k1 = (kB << 7) | (64 + lane); \
        _Pragma("unroll") for (int k = 2; k <= 128; k <<= 1) _Pragma("unroll") for (int j = k >> 1; j > 0; j >>= 1) { \
            if (j == 64) { const int a_ = min(k0, k1), c_ = max(k0, k1); k0 = a_; k1 = c_; } \
            else { const int p0 = __shfl_xor(k0, j), p1 = __shfl_xor(k1, j); const bool lower = (lane & j) == 0; \
                   const bool asc0 = (k >= 64) ? true : ((lane & k) == 0), asc1 = (k == 128) ? true : ((k == 64) ? false : ((lane & k) == 0)); \
                   k0 = (lower == asc0) ? min(k0, p0) : max(k0, p0); k1 = (lower == asc1) ? min(k1, p1) : max(k1, p1); } } \
        s0k = k0; s1k = k1; su0 = SUp[k0 >> 7]; sv0 = SVp[k0 >> 7]; gt0 = GATEp[(size_t)(t) * 128 + (k0 & 127)]; su1 = SUp[k1 >> 7]; sv1 = SVp[k1 >> 7]; gt1 = GATEp[(size_t)(t) * 128 + (k1 & 127)]; } while (0)
#define TOK_COMMIT(p) do { PG_EW(p)[lane] = s0k; PG_EW(p)[lane + 64] = s1k; PG_SU(p)[lane] = su0; PG_SU(p)[lane + 64] = su1; PG_GV(p)[lane] = gt0 * sv0; PG_GV(p)[lane + 64] = gt1 * sv1; } while (0)
#define TOK_XB(p) do { f32x4 xv[8]; float ss = 0.f; \
        _Pragma("unroll") for (int j = 0; j < 4; ++j) { xv[2 * j] = (f32x4){bf_lo(xq[j].x), bf_hi(xq[j].x), bf_lo(xq[j].y), bf_hi(xq[j].y)}; xv[2 * j + 1] = (f32x4){bf_lo(xq[j].z), bf_hi(xq[j].z), bf_lo(xq[j].w), bf_hi(xq[j].w)}; } \
        _Pragma("unroll") for (int j = 0; j < 8; ++j) ss += (xv[j][0] * xv[j][0] + xv[j][1] * xv[j][1]) + (xv[j][2] * xv[j][2] + xv[j][3] * xv[j][3]); \
        ss = wave_sum(ss); const float rs = rsqrtf(ss * (1.f / DM) + EPS); \
        _Pragma("unroll") for (int j = 0; j < 8; ++j) { const f32x4 a = xv[j] * rs * *(LAS const f32x4*)(gl + 32 * lane + 4 * j); xb[2 * j] = __builtin_bit_cast(bf16x2_t, pk2(a[0], a[1])); xb[2 * j + 1] = __builtin_bit_cast(bf16x2_t, pk2(a[2], a[3])); } \
        _Pragma("unroll") for (int j = 0; j < 4; ++j) PG_ST(p)[j * 64 + lane] = __builtin_bit_cast(f32x4, xq[j]); } while (0)
#define V_ROWS(K0, K1, cur) { const int kvv = PG_EW(cur)[((K0) + RING + (lane & 31)) & 127]; _Pragma("unroll 1") for (int k0 = (K0); k0 < (K1); k0 += RING) { _Pragma("unroll") for (int j = 0; j < RING; ++j) { \
            const float cv = cw[k0 + j]; const f32x2 cc = {cv, cv}; \
            _Pragma("unroll") for (int q = 0; q < 16; ++q) acc[q] = __builtin_elementwise_fma(ROWPAIR(j, q), cc, acc[q]); \
            ROWLOADK(VBp, j, __builtin_amdgcn_readlane(kvv, k0 - (K0) + j)); } } }

    TOK_FETCH(tfirst); TOK_SORT(tfirst); TOK_COMMIT(0); TOK_XB(0);
    asm volatile("s_waitcnt lgkmcnt(0)" ::: "memory");
#pragma unroll
    for (int j = 0; j < RING; ++j) ROWLOAD(UBp, j, PG_EW(0), j);
    int cur = 0;
#pragma unroll 1
    for (int t = tfirst; t < T_TOK; t += tstep, cur ^= 1) {
        const int nxt = cur ^ 1; const int tn = (t + tstep < T_TOK) ? t + tstep : t;
#pragma unroll 1
        for (int b = 0; b < 8; ++b) {
            if (lockstep && (b & 3) == 0) __builtin_amdgcn_s_barrier();
            float part[16];
            const int kvec = PG_EW(cur)[(16 * b + RING + (lane & 15)) & 127];
#pragma unroll
            for (int j = 0; j < 16; ++j) { const int slot = j & (RING - 1); float a0 = 0.f, a1 = 0.f;
#pragma unroll
                for (int q = 0; q < 8; ++q) { a0 = fdot2bf(fp4_pair_bf(ra[slot][(2 * q) >> 2], (2 * q) & 3), xb[2 * q], a0); a1 = fdot2bf(fp4_pair_bf(ra[slot][(2 * q + 1) >> 2], (2 * q + 1) & 3), xb[2 * q + 1], a1); }
                part[j] = a0 + a1;
                { const int sn = 16 * b + j + RING; const unsigned char* nb = (sn < 128) ? UBp : VBp; ROWLOADK(nb, slot, __builtin_amdgcn_readlane(kvec, j)); } }
            float q8[8], q4[4], q2[2], q1;
#pragma unroll
            for (int i = 0; i < 8; ++i) { const u32x2 sw = __builtin_amdgcn_permlane32_swap(__float_as_uint(part[i]), __float_as_uint(part[i + 8]), false, false); q8[i] = __uint_as_float(sw[0]) + __uint_as_float(sw[1]); }
#pragma unroll
            for (int i = 0; i < 4; ++i) { const u32x2 sw = __builtin_amdgcn_permlane16_swap(__float_as_uint(q8[i]), __float_as_uint(q8[i + 4]), false, false); q4[i] = __uint_as_float(sw[0]) + __uint_as_float(sw[1]); }
#pragma unroll
            for (int i = 0; i < 2; ++i) { const bool up = (lane & 8) != 0; const float snd = up ? q4[i] : q4[i + 2], kp = up ? q4[i + 2] : q4[i]; q2[i] = kp + __shfl_xor(snd, 8); }
            { const bool up = (lane & 4) != 0; const float snd = up ? q2[0] : q2[1], kp = up ? q2[1] : q2[0]; q1 = kp + __shfl_xor(snd, 4); }
            q1 += __shfl_xor(q1, 1); q1 += __shfl_xor(q1, 2);
            if ((lane & 3) == 0) { const int k = 16 * b + eloc; const float av = q1 * PG_SU(cur)[k]; const float gel = 0.5f * av * (1.f + erff(av * 0.70710678118654752f)); cw[k] = gel * PG_GV(cur)[k]; }
        }
        asm volatile("s_waitcnt lgkmcnt(0)" ::: "memory");
        f32x2 acc[16];
#pragma unroll
        for (int i = 0; i < 16; ++i) acc[i] = (f32x2){0.f, 0.f};
        if (lockstep) __builtin_amdgcn_s_barrier();
        TOK_FETCH(tn);
        V_ROWS(0, 32, cur)
        TOK_SORT(tn);
        V_ROWS(32, 64, cur)
        TOK_COMMIT(nxt);
        if (lockstep) __builtin_amdgcn_s_barrier();
        V_ROWS(64, 96, cur)
        TOK_XB(nxt);
        V_ROWS(96, 128 - RING, cur)
        asm volatile("s_waitcnt lgkmcnt(0)" ::: "memory");
        if (lockstep) __builtin_amdgcn_s_barrier();
#pragma unroll
        for (int j = 0; j < RING; ++j) { const int k = 128 - RING + j;
            const float cv = cw[k]; const f32x2 cc = {cv, cv};
#pragma unroll
            for (int q = 0; q < 16; ++q) acc[q] = __builtin_elementwise_fma(ROWPAIR(j, q), cc, acc[q]);
            ROWLOAD(UBp, j, PG_EW(nxt), j); }
        f32x4 xo[8]; float s3 = 0.f;
#pragma unroll
        for (int j = 0; j < 4; ++j) { const u32x4 q = __builtin_bit_cast(u32x4, PG_ST(cur)[j * 64 + lane]); xo[2 * j] = (f32x4){bf_lo(q.x), bf_hi(q.x), bf_lo(q.y), bf_hi(q.y)}; xo[2 * j + 1] = (f32x4){bf_lo(q.z), bf_hi(q.z), bf_lo(q.w), bf_hi(q.w)}; }
#pragma unroll
        for (int j = 0; j < 8; ++j)
#pragma unroll
            for (int i = 0; i < 4; ++i) { xo[j][i] += acc[2 * j + (i >> 1)][i & 1]; s3 += xo[j][i] * xo[j][i]; }
        s3 = wave_sum(s3);
        const float r3 = rsqrtf(s3 * (1.f / DM) + EPS);
        float* orow = OUT + (size_t)t * DM + 32 * lane;
#pragma unroll
        for (int j = 0; j < 8; ++j) { const f32x4 g0 = *(LAS const f32x4*)(gl + DM + 32 * lane + 4 * j); *(f32x4*)(orow + 4 * j) = xo[j] * r3 * g0; }
    }
#undef ROWLOAD
#undef ROWLOADK
#undef ROWPAIR
#undef TOK_FETCH
#undef TOK_SORT
#undef TOK_COMMIT
#undef TOK_XB
#undef V_ROWS
}

constexpr unsigned NF1 = 896;
__device__ __forceinline__ void fp8_chunk(int chunk, int wave, int lane, const float* peer_u, const float* peer_v, const float* g_ffn, unsigned char* UB, unsigned char* VB, float* SU, float* SV) {
#pragma unroll 1
    for (int r = 0; r < 2; ++r) { const int row = chunk * 16 + wave * 2 + r;
        if (row < 16384) row_to_fp6(peer_u + (size_t)row * DM, nullptr, UB + (size_t)row * ROWB, SU + row, lane);
        else row_to_fp6(peer_v + (size_t)(row - 16384) * DM, nullptr, VB + (size_t)(row - 16384) * ROWB, SV + (row - 16384), lane); }
}
constexpr int NWAVES = 8, LDS_BYTES = 163840, MISC_OFF = 159744;
constexpr int N_PHASES = 10;
struct Args { const void* in[21]; float* out; unsigned char* ws; int ph_lo, ph_hi; float inv_freq[128]; };

#define IN_x ((const float*)((const float*)args.in[0]))
#define IN_mem ((const float*)((const float*)args.in[1]))
#define IN_positions ((const int*)((const int*)args.in[2]))
#define IN_g_mix ((const float*)((const float*)args.in[3]))
#define IN_w_in ((const float*)((const float*)args.in[4]))
#define IN_sinks ((const float*)((const float*)args.in[5]))
#define IN_att_gain ((const float*)((const float*)args.in[6]))
#define IN_ret_gain ((const float*)((const float*)args.in[7]))
#define IN_w_out ((const float*)((const float*)args.in[8]))
#define IN_g_cross ((const float*)((const float*)args.in[9]))
#define IN_g_mem ((const float*)((const float*)args.in[10]))
#define IN_w_xq ((const float*)((const float*)args.in[11]))
#define IN_w_xk ((const float*)((const float*)args.in[12]))
#define IN_w_xv ((const float*)((const float*)args.in[13]))
#define IN_w_xo ((const float*)((const float*)args.in[14]))
#define IN_g_ffn ((const float*)((const float*)args.in[15]))
#define IN_w_pq ((const float*)((const float*)args.in[16]))
#define IN_subk ((const float*)((const float*)args.in[17]))
#define IN_peer_u ((const float*)((const float*)args.in[18]))
#define IN_peer_v ((const float*)((const float*)args.in[19]))
#define IN_g_fin ((const float*)((const float*)args.in[20]))
#define IN_out ((float*)(args.out))
#define WIN ((bf16_t*)((bf16_t*)(ws + WS_WIN)))
#define WOUT ((bf16_t*)((bf16_t*)(ws + WS_WOUT)))
#define WXQ ((bf16_t*)((bf16_t*)(ws + WS_WXQ)))
#define WXKV ((bf16_t*)((bf16_t*)(ws + WS_WXKV)))
#define WXO ((bf16_t*)((bf16_t*)(ws + WS_WXO)))
#define WPQ ((bf16_t*)((bf16_t*)(ws + WS_WPQ)))
#define XB ((bf16_t*)((bf16_t*)(ws + WS_XB)))
#define MEMB ((bf16_t*)((bf16_t*)(ws + WS_MEMB)))
#define COSA ((float*)((float*)(ws + WS_COSA)))
#define SINA ((float*)((float*)(ws + WS_SINA)))
#define COSR ((float*)((float*)(ws + WS_COSR)))
#define SINR ((float*)((float*)(ws + WS_SINR)))
#define SS0 ((float*)((float*)(ws + WS_SS0)))
#define SS1 ((float*)((float*)(ws + WS_SS1)))
#define SS2 ((float*)((float*)(ws + WS_SS2)))
#define SSM ((float*)((float*)(ws + WS_SSM)))
#define KX ((bf16_t*)((bf16_t*)(ws + WS_KX)))
#define VX ((bf16_t*)((bf16_t*)(ws + WS_VX)))
#define QX ((bf16_t*)((bf16_t*)(ws + WS_QX)))
#define OX ((bf16_t*)((bf16_t*)(ws + WS_OX)))
#define EXPI ((int*)((int*)(ws + WS_EXP)))
#define GATE ((float*)((float*)(ws + WS_GATE)))
#define Y ((bf16_t*)((bf16_t*)(ws + WS_Y)))
#define PQ ((bf16_t*)((bf16_t*)(ws + WS_Y)))
#define QA ((bf16_t*)((bf16_t*)(ws + WS_QA)))
#define KA ((bf16_t*)((bf16_t*)(ws + WS_KA)))
#define VA ((bf16_t*)((bf16_t*)(ws + WS_VA)))
#define QR ((bf16_t*)((bf16_t*)(ws + WS_QR)))
#define KR ((bf16_t*)((bf16_t*)(ws + WS_KR)))
#define VR ((bf16_t*)((bf16_t*)(ws + WS_VR)))
#define GR ((bf16_t*)((bf16_t*)(ws + WS_GR)))
#define UB ((unsigned char*)(ws + WS_UB))
#define VB ((unsigned char*)(ws + WS_VB))
#define SU ((float*)((float*)(ws + WS_SU)))
#define SV ((float*)((float*)(ws + WS_SV)))
__global__ void __launch_bounds__(NWAVES * 64, 2) fwd_kernel(Args args) {
    extern __shared__ __attribute__((aligned(16))) unsigned char lds_raw[];
    LAS unsigned char* lds = (LAS unsigned char*)lds_raw;
    const int tid = threadIdx.x, lane = tid & 63; const int wave = __builtin_amdgcn_readfirstlane(tid >> 6);
    const int G = gridDim.x; const int bx = blockIdx.x; const int vcu = (G % 8 == 0) ? (bx % 8) * (G / 8) + bx / 8 : bx;
    unsigned char* ws = args.ws;
    float* const out_base = args.out;
    for (int u = tid; u < (LDS_BYTES - MISC_OFF) / 4; u += NWAVES * 64) ((LAS unsigned*)(lds + MISC_OFF))[u] = 0u;
    __syncthreads();
    const int lo = args.ph_lo, hi = args.ph_hi;
    const bool use_bar = (hi - lo) > 1;
    XcdBarrier bar; bar.bar = (unsigned*)(ws + WS_CTL) + 1024; bar.x = 0; bar.st = nullptr;
    if (use_bar) bar = xcd_barrier_post((unsigned*)(ws + WS_CTL) + 1024, (volatile LAS unsigned*)(lds + MISC_OFF) + 8);
#ifdef ONLY_PHASE
#define PHASE_ON(k) ((k) == ONLY_PHASE)
#else
#define PHASE_ON(k) true
#endif
#define IN(k) (lo <= (k) && (k) < hi)
#ifdef REPEAT_PHASE
#define REP(k) for (int _rep = 0; _rep < (((k) == REPEAT_PHASE) ? 2 : 1); ++_rep)
#else
#define REP(k)
#endif
#define SEAM(k) do { if (IN(k) && IN((k) + 1)) xcd_barrier(bar); } while (0)
    const int gw = vcu * NWAVES + wave, NGW = G * NWAVES;

    REP(0) if (PHASE_ON(0) && IN(0)) {
        LAS float* scr = (LAS float*)(lds + wave * 8448);
        constexpr int I_IN = 32 * (IN_COLS / 32), I_XQ = 32 * 16;
        constexpr int NITEMS = I_IN + 2 * I_XQ;
        for (int it = gw; it < NITEMS; it += NGW) {
            int r = it;
            if (r < I_IN) { p0_transpose_item<true>(IN_w_in, IN_g_mix, DM, IN_COLS, WIN, 0, scr, r, lane); continue; } r -= I_IN;
            if (r < I_XQ) { p0_transpose_item<false>(IN_w_xk, IN_g_mem, DM, 512, WXKV, 0, scr, r, lane); continue; } r -= I_XQ;
            p0_transpose_item<false>(IN_w_xv, IN_g_mem, DM, 512, WXKV, 512, scr, r, lane);
        }
        for (int m = gw; m < T_TOK; m += 2 * NGW) row2_to_bf16(IN_x + (size_t)m * DM, XB + (size_t)m * DM, SS0 + m, (size_t)NGW, lane);
        for (int m = gw; m < MT; m += NGW) row_to_bf16(IN_mem + (size_t)m * DM, MEMB + (size_t)m * DM, SSM + m, lane);
        const int gt = vcu * (NWAVES * 64) + tid, NGT = G * NWAVES * 64;
        for (int i = gt; i < T_TOK * 128; i += NGT) { const int tok = i >> 7, f = i & 127; const float ang = (float)IN_positions[tok] * args.inv_freq[f]; float cc, sn; sincos_red(ang, cc, sn);
            COSR[i] = cc; SINR[i] = sn; }
        for (int i = gt; i < T_TOK * 32; i += NGT) { const int tok = i >> 5, f = i & 31; const float ang = (float)IN_positions[tok] * args.inv_freq[4 * f]; float cc, sn; sincos_red(ang, cc, sn);
            COSA[i] = cc; SINA[i] = sn; }
        for (int i = gt; i < T_TOK; i += NGT) { SS1[i] = 0.f; SS2[i] = 0.f; }
        __syncthreads();
    }
    SEAM(0);
    REP(1) if (PHASE_ON(1) && IN(1)) {
        pg8::Sched S; S.A = (const char*)XB; S.B = (const char*)WIN; S.nM = T_TOK / 256; S.nN = IN_COLS / 256; S.nwg = S.nM * S.nN;
        S.A2 = (const char*)MEMB; S.B2 = (const char*)WXKV; S.nM2 = MT / 256; S.nwg2 = (MT / 256) * 4; S.G = G; S.c = bx; S.WGM = WGM_P1; S.tstep = (size_t)256 * DM * 2;
        EpiP1 E{ws};
        pg8::gemm_phase<EpiP1>(lds, DM, S, E);
        unsigned* qctr = (unsigned*)(ws + WS_CTL) + 8192 + 64; volatile LAS unsigned* qw = (volatile LAS unsigned*)(lds + MISC_OFF) + 16;
        LAS float* scr = (LAS float*)(lds + wave * 8448);
        for (;;) {
            if (tid == 0) qw[0] = atomicAdd(qctr, 1u);
            __syncthreads(); const unsigned chunk = qw[0]; __syncthreads();
            if (chunk >= 640u + NF1) break;
            if (chunk < 640u) { int r = (int)chunk * 8 + wave;
                if (r < 2048) p0_transpose_item<false>(IN_w_out, nullptr, DM, DM, WOUT, 0, scr, r, lane);
                else if ((r -= 2048) < 512) p0_transpose_item<false>(IN_w_xq, IN_g_cross, DM, 512, WXQ, 0, scr, r, lane);
                else if ((r -= 512) < 512) p0_transpose_item<false>(IN_w_xo, nullptr, 512, DM, WXO, 0, scr, r, lane);
                else p0_transpose_item<false>(IN_w_pq, IN_g_ffn, DM, DM, WPQ, 0, scr, r - 512, lane);
            } else fp8_chunk((int)chunk - 640, wave, lane, IN_peer_u, IN_peer_v, IN_g_ffn, UB, VB, SU, SV);
        }
    }
    SEAM(1);
    REP(2) if (PHASE_ON(2) && IN(2)) {
        for (int u = vcu; u < 256; u += G) ret_state_unit(lds, u >> 3, u & 7, KR, VR, ret_state_base(ws, u >> 3));
        for (int u = vcu; u < 256; u += G) swa_unit(lds, u >> 5, (u >> 1) & 15, u & 1, QA, KA, VA, IN_sinks, IN_att_gain, Y);
    }
    SEAM(2);
    REP(3) if (PHASE_ON(3) && IN(3)) {
        for (int u = vcu; u < 512; u += G) { const int bh = u >> 4, n = u & 15; ret_chunk_unit(lds, bh >> 2, bh & 3, n, QR, KR, VR, GR, ret_state_base(ws, bh), IN_ret_gain, Y); }
    }
    SEAM(3);
    if (PHASE_ON(4) && IN(4)) {
        pg8::Sched S; S.A = (const char*)Y; S.B = (const char*)WOUT; S.WGM = WGM_P3; S.nM = T_TOK / 256; S.nN = DM / 256; S.nwg = S.nM * S.nN; S.A2 = nullptr; S.B2 = nullptr; S.nM2 = 1; S.nwg2 = 0; S.G = G; S.c = bx; S.tstep = (size_t)256 * DM * 2;
        EpiRes1 E{XB, SS1};
        pg8::gemm_phase<EpiRes1, false>(lds, DM, S, E);
    }
    SEAM(4);
    REP(5) if (PHASE_ON(5) && IN(5)) {
        pg8::Sched S; S.A = (const char*)XB; S.B = (const char*)WXQ; S.WGM = WGM_P4; S.nM = T_TOK / 256; S.nN = 2; S.nwg = S.nM * S.nN; S.A2 = nullptr; S.B2 = nullptr; S.nM2 = 1; S.nwg2 = 0; S.G = G; S.c = bx; S.tstep = (size_t)256 * DM * 2;
        EpiScale E{QX, 512, SS1, C3Q};
        pg8::gemm_phase<EpiScale>(lds, DM, S, E);
        unsigned* qctr = (unsigned*)(ws + WS_CTL) + 8192; volatile LAS unsigned* qw = (volatile LAS unsigned*)(lds + MISC_OFF) + 16;
        for (;;) {
            if (tid == 0) qw[0] = atomicAdd(qctr, 1u);
            __syncthreads(); const unsigned chunk = qw[0] + NF1; __syncthreads();
            if (chunk >= 2048u) break;
            fp8_chunk((int)chunk, wave, lane, IN_peer_u, IN_peer_v, IN_g_ffn, UB, VB, SU, SV);
        }
    }
    SEAM(5);
    REP(6) if (PHASE_ON(6) && IN(6)) { for (int u = vcu; u < 256; u += G) xattn_unit(lds, u >> 5, (u >> 3) & 3, u & 7, QX, KX, VX, OX); }
    SEAM(6);
    if (PHASE_ON(7) && IN(7)) {
        pg8::Sched S; S.A = (const char*)OX; S.B = (const char*)WXO; S.WGM = WGM_P6; S.nM = T_TOK / 256; S.nN = DM / 256; S.nwg = S.nM * S.nN; S.A2 = nullptr; S.B2 = nullptr; S.nM2 = 1; S.nwg2 = 0; S.G = G; S.c = bx; S.tstep = (size_t)256 * 512 * 2;
        EpiRes2 E{XB, SS2};
        pg8::gemm_phase<EpiRes2, false>(lds, 512, S, E);
    }
    SEAM(7);
    REP(8) if (PHASE_ON(8) && IN(8)) {
        pg8::Sched S; S.A = (const char*)XB; S.B = (const char*)WPQ; S.WGM = WGM_P7; S.nM = T_TOK / 256; S.nN = DM / 256; S.nwg = S.nM * S.nN; S.A2 = nullptr; S.B2 = nullptr; S.nM2 = 1; S.nwg2 = 0; S.G = G; S.c = bx; S.tstep = (size_t)256 * DM * 2;
        EpiScale E{PQ, DM, SS2, 1.f};
        pg8::gemm_phase<EpiScale>(lds, DM, S, E);
        asm volatile("s_waitcnt vmcnt(0)" ::: "memory"); __syncthreads();
        { pg8::Unit u; for (int i = 0; S.next(i, u); ++i) peer_topk_unit(lds, u.pm, u.pn, PQ, IN_subk, EXPI, GATE); }
    }
    SEAM(8);
    if (PHASE_ON(9) && IN(9)) {
        LAS float* gl = (LAS float*)(lds + 98304);
        for (int i = tid; i < DM; i += NWAVES * 64) { gl[i] = IN_g_ffn[i]; gl[DM + i] = IN_g_fin[i]; }
        __syncthreads();
        const bool lockstep = (T_TOK % NGW == 0);
        if (gw < T_TOK) peer_gather_wave(lds + wave * 12288, gl, gw, NGW, XB, UB, VB, SU, SV, EXPI, GATE, IN_out, lane, lockstep);
    }
#undef IN
#undef SEAM
}

extern "C" void kernel_launch(void* const* d_in, const int* in_sizes, int n_in, void* d_out, int out_size, void* d_ws, size_t ws_size, hipStream_t stream) {
    static int grid = 0;
    if (grid == 0) {
        if (n_in != 21 || out_size != T_TOK * DM || ws_size < WS_END) { fprintf(stderr, "kernel_launch: unexpected problem (n_in %d out %d ws %zu)\n", n_in, out_size, ws_size); grid = -1; return; }
        int dev = 0, cus = 0;
        if (hipGetDevice(&dev) != hipSuccess || hipDeviceGetAttribute(&cus, hipDeviceAttributeMultiprocessorCount, dev) != hipSuccess) { grid = -1; return; }
        if (hipFuncSetAttribute((const void*)fwd_kernel, hipFuncAttributeMaxDynamicSharedMemorySize, LDS_BYTES) != hipSuccess) { fprintf(stderr, "kernel_launch: hipFuncSetAttribute failed\n"); grid = -1; return; }
        (void)hipGetLastError();
        grid = cus;
    }
    if (grid < 0) return;
    (void)hipMemsetAsync((char*)d_ws + WS_CTL, 0, CTL_ZERO_BYTES, stream);
    Args a{};
    for (int i = 0; i < 21; ++i) a.in[i] = d_in[i];
    a.out = (float*)d_out; a.ws = (unsigned char*)d_ws;
    for (int i = 0; i < 128; ++i) a.inv_freq[i] = (float)pow(10000.0, -(double)(2 * i) / 256.0);
#ifdef MK_PER_PHASE
    for (int p = 0; p < N_PHASES; ++p) { a.ph_lo = p; a.ph_hi = p + 1;
#ifdef REPEAT_LAUNCH
        if (p == REPEAT_LAUNCH) for (int r = 0; r < 4; ++r) hipLaunchKernelGGL(fwd_kernel, dim3(grid), dim3(NWAVES * 64), LDS_BYTES, stream, a);
#endif
        hipLaunchKernelGGL(fwd_kernel, dim3(grid), dim3(NWAVES * 64), LDS_BYTES, stream, a); }
#else
    a.ph_lo = 0; a.ph_hi = N_PHASES; hipLaunchKernelGGL(fwd_kernel, dim3(grid), dim3(NWAVES * 64), LDS_BYTES, stream, a);
#endif
}
```
